# Optimizing an MI355X kernel written in HIP

```python
import math
import jax
import jax.numpy as jnp
from jax import lax
import numpy as np

D_MODEL = 1024
BATCH = 8
SEQ = 4096
DEPTH = 1

N_META = 16
D_RNN = 1024
N_RNN_BLOCKS = 8
RNN_BLOCK = D_RNN // N_RNN_BLOCKS
CONV_WIDTH = 4
LRU_C = 8.0
N_HEADS = 8
HEAD_DIM = 64
V_DIM = 2 * HEAD_DIM
D_ATTN = N_HEADS * 2 * HEAD_DIM
Q_BLOCK = 128
N_EXPERTS = 256
TOP_K = 8
N_GROUPS = 8
TOPK_GROUPS = 4
D_EXPERT = 256
D_SHARED = 256
ROUTED_SCALE = 2.5
DISPATCH_BLOCK = 128
LN_EPS = 1e-5
IN_COLS = 2 * D_RNN + 3 * D_ATTN + 2 * D_MODEL

kernel_name = 'griffin_diffattn_moe_hybrid'


def _layer_norm(x, g, b):
    xf = x.astype(jnp.float32)
    mu = jnp.mean(xf, axis=-1, keepdims=True)
    var = jnp.mean(jnp.square(xf - mu), axis=-1, keepdims=True)
    y = (xf - mu) * lax.rsqrt(var + LN_EPS)
    return (y * g.astype(jnp.float32) + b.astype(jnp.float32)).astype(x.dtype)


def _rms_norm(x, g):
    xf = x.astype(jnp.float32)
    y = xf * lax.rsqrt(jnp.mean(jnp.square(xf), axis=-1, keepdims=True) + LN_EPS)
    return (y * g.astype(jnp.float32)).astype(x.dtype)


def _causal_depthwise_conv(x, w, b):
    out = lax.conv_general_dilated(
        x, w[:, None, :], window_strides=(1,), padding=[(CONV_WIDTH - 1, 0)],
        dimension_numbers=('NWC', 'WIO', 'NWC'), feature_group_count=x.shape[-1])
    return out + b


def _block_diag(x, w, b):
    xb = x.reshape(x.shape[:-1] + (N_RNN_BLOCKS, RNN_BLOCK))
    y = jnp.einsum('btnr,nrs->btns', xb, w)
    return y.reshape(x.shape) + b


def _lin_rec_combine(left, right):
    a1, b1 = left
    a2, b2 = right
    return a1 * a2, a2 * b1 + b2


def _rg_lru(x, w_a, b_a, w_i, b_i, lam):
    f32 = jnp.float32
    r = jax.nn.sigmoid(_block_diag(x, w_a, b_a).astype(f32))
    i = jax.nn.sigmoid(_block_diag(x, w_i, b_i).astype(f32))
    log_a = -LRU_C * r * jax.nn.softplus(-lam.astype(f32))
    a = jnp.exp(log_a)
    mult = jnp.sqrt(-jnp.expm1(2.0 * log_a))
    first = (jnp.arange(x.shape[1]) == 0)[None, :, None]
    mult = jnp.where(first, 1.0, mult)
    bterm = mult * (i * x.astype(f32))
    _, h = lax.associative_scan(_lin_rec_combine, (a, bterm), axis=1)
    return h.astype(x.dtype)


def _diff_attention(q, k, v, lam, lambda_init, subln_g):
    B, T = q.shape[0], q.shape[1]
    n_qb = T // Q_BLOCK
    scale = HEAD_DIM ** -0.5
    kpos = jnp.arange(T)

    def one_block(blk):
        q0 = blk * Q_BLOCK
        qb = lax.dynamic_slice_in_dim(q, q0, Q_BLOCK, axis=1)
        s = jnp.einsum('bqhmd,bkhmd->bhmqk', qb, k).astype(jnp.float32) * scale
        qpos = q0 + jnp.arange(Q_BLOCK)
        mask = kpos[None, :] <= qpos[:, None]
        p = jax.nn.softmax(jnp.where(mask, s, -jnp.inf), axis=-1)
        wgt = p[:, :, 0] - lam * p[:, :, 1]
        return jnp.einsum('bhqk,bkhe->bqhe', wgt.astype(v.dtype), v)

    o = lax.map(one_block, jnp.arange(n_qb))
    o = jnp.moveaxis(o, 0, 1).reshape(B, T, N_HEADS, V_DIM)
    o = _rms_norm(o, subln_g) * (1.0 - lambda_init)
    return o.reshape(B, T, D_ATTN)


def _swiglu(x, wg, wu, wd):
    return (jax.nn.silu(x @ wg) * (x @ wu)) @ wd


def _route(x, router_w, router_bias):
    n = x.shape[0]
    scores = jax.nn.sigmoid((x @ router_w).astype(jnp.float32))
    sel = scores + router_bias.astype(jnp.float32)
    grp = sel.reshape(n, N_GROUPS, N_EXPERTS // N_GROUPS)
    grp_score = jnp.sum(lax.top_k(grp, 2)[0], axis=-1)
    _, gidx = lax.top_k(grp_score, TOPK_GROUPS)
    gmask = jnp.any(gidx[..., None] == jnp.arange(N_GROUPS), axis=1)
    sel = jnp.where(gmask[:, :, None], grp, -jnp.inf).reshape(n, N_EXPERTS)
    _, eidx = lax.top_k(sel, TOP_K)
    w = jnp.take_along_axis(scores, eidx, axis=-1)
    w = w / jnp.sum(w, axis=-1, keepdims=True) * ROUTED_SCALE
    return eidx, w


def _routed_experts(x, eidx, w, w_gate, w_up, w_down):
    n, d = x.shape
    n_assign = n * TOP_K
    e_flat = eidx.reshape(n_assign)
    tok_flat = jnp.repeat(jnp.arange(n, dtype=jnp.int32), TOP_K)
    w_flat = w.reshape(n_assign)
    order = jnp.argsort(e_flat)
    e_sorted = e_flat[order]
    tok_sorted = tok_flat[order]
    w_sorted = w_flat[order]
    counts = jnp.bincount(e_flat, length=N_EXPERTS)
    padded = (counts + DISPATCH_BLOCK - 1) // DISPATCH_BLOCK * DISPATCH_BLOCK
    start = jnp.cumsum(counts) - counts
    pend = jnp.cumsum(padded)
    pstart = pend - padded
    dest = pstart[e_sorted] + (jnp.arange(n_assign) - start[e_sorted])
    n_blocks = -(-n_assign // DISPATCH_BLOCK) + N_EXPERTS
    n_slots = n_blocks * DISPATCH_BLOCK
    slot_tok = jnp.full((n_slots,), n, jnp.int32).at[dest].set(tok_sorted)
    slot_w = jnp.zeros((n_slots,), jnp.float32).at[dest].set(w_sorted)
    block_start = jnp.arange(n_blocks) * DISPATCH_BLOCK
    block_exp = jnp.minimum(jnp.searchsorted(pend, block_start, side='right'), N_EXPERTS - 1)
    x_pad = jnp.concatenate([x, jnp.zeros((1, d), x.dtype)], axis=0)

    def body(acc, blk):
        e, toks, wt = blk
        xb = x_pad[toks]
        yb = _swiglu(xb, w_gate[e], w_up[e], w_down[e]) * wt[:, None].astype(x.dtype)
        return acc.at[toks].add(yb.astype(acc.dtype)), None

    acc, _ = lax.scan(body, jnp.zeros((n + 1, d), x.dtype),
                      (block_exp, slot_tok.reshape(n_blocks, DISPATCH_BLOCK),
                       slot_w.reshape(n_blocks, DISPATCH_BLOCK)))
    return acc[:n]


def setup_inputs(seed: int = 0) -> dict:
    key = jax.random.key(seed)
    keys = jax.random.split(key, 40)
    ctr = [0]

    def nk():
        ctr[0] += 1
        return keys[ctr[0] - 1]

    f32 = jnp.float32
    L = DEPTH
    beta = (8.0 * DEPTH) ** -0.25

    def nrm(shape, fan_in, scale=1.0):
        return jax.random.normal(nk(), shape, f32) * (scale * fan_in ** -0.5)

    def gain(shape):
        return 1.0 + 0.02 * jax.random.normal(nk(), shape, f32)

    def small(shape, s=0.02):
        return s * jax.random.normal(nk(), shape, f32)

    x = jax.random.normal(nk(), (BATCH, SEQ, D_MODEL), f32)
    meta_tokens = jax.random.normal(nk(), (N_META, D_MODEL), f32)
    emb_ln_g = gain((D_MODEL,))
    emb_ln_b = small((D_MODEL,))
    v_lo = 2 * D_RNN + 2 * D_ATTN
    col_scale = jnp.ones((IN_COLS,), f32).at[v_lo:v_lo + D_ATTN].set(beta)
    w_in = nrm((L, D_MODEL, IN_COLS), D_MODEL) * col_scale
    b_gate = small((L, 2 * D_MODEL), 0.1)
    conv_w = nrm((L, CONV_WIDTH, D_RNN), CONV_WIDTH)
    conv_b = small((L, D_RNN))
    lru_w_a = nrm((L, N_RNN_BLOCKS, RNN_BLOCK, RNN_BLOCK), RNN_BLOCK)
    lru_b_a = small((L, D_RNN))
    lru_w_i = nrm((L, N_RNN_BLOCKS, RNN_BLOCK, RNN_BLOCK), RNN_BLOCK)
    lru_b_i = small((L, D_RNN))
    a8 = jax.random.uniform(nk(), (L, D_RNN), f32, 0.9, 0.999)
    s = a8 ** (1.0 / LRU_C)
    lru_lambda = jnp.log(s) - jnp.log1p(-s)
    lam_q1 = small((L, HEAD_DIM), 0.1)
    lam_k1 = small((L, HEAD_DIM), 0.1)
    lam_q2 = small((L, HEAD_DIM), 0.1)
    lam_k2 = small((L, HEAD_DIM), 0.1)
    subln_g = gain((L, V_DIM))
    w_rec_proj = nrm((L, D_RNN, D_MODEL), D_RNN, beta)
    w_attn_proj = nrm((L, D_ATTN, D_MODEL), D_ATTN, beta)
    w_o = nrm((L, D_MODEL, D_MODEL), D_MODEL, beta)
    ln1_g = gain((L, D_MODEL))
    ln1_b = small((L, D_MODEL))
    router_w = nrm((L, D_MODEL, N_EXPERTS), D_MODEL)
    router_bias = small((L, N_EXPERTS), 0.01)
    w_e_gate = nrm((L, N_EXPERTS, D_MODEL, D_EXPERT), D_MODEL)
    w_e_up = nrm((L, N_EXPERTS, D_MODEL, D_EXPERT), D_MODEL)
    w_e_down = nrm((L, N_EXPERTS, D_EXPERT, D_MODEL), D_EXPERT, beta)
    w_s_gate = nrm((L, D_MODEL, D_SHARED), D_MODEL)
    w_s_up = nrm((L, D_MODEL, D_SHARED), D_MODEL)
    w_s_down = nrm((L, D_SHARED, D_MODEL), D_SHARED, beta)
    ln2_g = gain((L, D_MODEL))
    ln2_b = small((L, D_MODEL))
    return {'x': x, 'meta_tokens': meta_tokens, 'emb_ln_g': emb_ln_g, 'emb_ln_b': emb_ln_b,
            'w_in': w_in, 'b_gate': b_gate, 'conv_w': conv_w, 'conv_b': conv_b,
            'lru_w_a': lru_w_a, 'lru_b_a': lru_b_a, 'lru_w_i': lru_w_i, 'lru_b_i': lru_b_i,
            'lru_lambda': lru_lambda, 'lam_q1': lam_q1, 'lam_k1': lam_k1, 'lam_q2': lam_q2,
            'lam_k2': lam_k2, 'subln_g': subln_g, 'w_rec_proj': w_rec_proj,
            'w_attn_proj': w_attn_proj, 'w_o': w_o, 'ln1_g': ln1_g, 'ln1_b': ln1_b,
            'router_w': router_w, 'router_bias': router_bias, 'w_e_gate': w_e_gate,
            'w_e_up': w_e_up, 'w_e_down': w_e_down, 'w_s_gate': w_s_gate, 'w_s_up': w_s_up,
            'w_s_down': w_s_down, 'ln2_g': ln2_g, 'ln2_b': ln2_b}


def reference(x, meta_tokens, emb_ln_g, emb_ln_b, w_in, b_gate, conv_w, conv_b,
              lru_w_a, lru_b_a, lru_w_i, lru_b_i, lru_lambda, lam_q1, lam_k1, lam_q2,
              lam_k2, subln_g, w_rec_proj, w_attn_proj, w_o, ln1_g, ln1_b, router_w,
              router_bias, w_e_gate, w_e_up, w_e_down, w_s_gate, w_s_up, w_s_down,
              ln2_g, ln2_b):
    f32 = jnp.float32
    B, S, D = x.shape
    T = N_META + S
    T_pad = -(-T // Q_BLOCK) * Q_BLOCK
    meta = jnp.broadcast_to(meta_tokens.astype(x.dtype)[None], (B, N_META, D))
    h = jnp.concatenate([meta, x], axis=1)
    h = jnp.pad(h, ((0, 0), (0, T_pad - T), (0, 0)))
    h = _layer_norm(h, emb_ln_g, emb_ln_b)
    alpha = (2.0 * DEPTH) ** 0.25
    splits = [D_RNN, 2 * D_RNN, 2 * D_RNN + D_ATTN, 2 * D_RNN + 2 * D_ATTN, 2 * D_RNN + 3 * D_ATTN]
    for l in range(DEPTH):
        lambda_init = 0.8 - 0.6 * math.exp(-0.3 * l)
        proj = h @ w_in[l]
        xr, yr, q, k, v, g = jnp.split(proj, splits, axis=-1)
        xr = _causal_depthwise_conv(xr, conv_w[l], conv_b[l])
        rec = _rg_lru(xr, lru_w_a[l], lru_b_a[l], lru_w_i[l], lru_b_i[l], lru_lambda[l])
        rec = rec * jax.nn.gelu(yr)
        lam = (jnp.exp(jnp.sum(lam_q1[l].astype(f32) * lam_k1[l].astype(f32)))
               - jnp.exp(jnp.sum(lam_q2[l].astype(f32) * lam_k2[l].astype(f32))) + lambda_init)
        att = _diff_attention(q.reshape(B, T_pad, N_HEADS, 2, HEAD_DIM),
                              k.reshape(B, T_pad, N_HEADS, 2, HEAD_DIM),
                              v.reshape(B, T_pad, N_HEADS, V_DIM), lam, lambda_init, subln_g[l])
        gates = jax.nn.sigmoid(g + b_gate[l])
        g_rec, g_att = jnp.split(gates, 2, axis=-1)
        mix = (g_rec * (rec @ w_rec_proj[l]) + g_att * (att @ w_attn_proj[l])) @ w_o[l]
        h = _layer_norm(alpha * h + mix, ln1_g[l], ln1_b[l])
        hf = h.reshape(B * T_pad, D)
        eidx, wts = _route(hf, router_w[l], router_bias[l])
        ffn = (_routed_experts(hf, eidx, wts, w_e_gate[l], w_e_up[l], w_e_down[l])
               + _swiglu(hf, w_s_gate[l], w_s_up[l], w_s_down[l]))
        h = _layer_norm(alpha * h + ffn.reshape(B, T_pad, D), ln2_g[l], ln2_b[l])
    return h[:, N_META:N_META + S]
```

```cpp
#include <hip/hip_runtime.h>
#include <hip/hip_bf16.h>
#include <cstdio>
#include <cstdint>
#include <cmath>
namespace pg8 {
#define PG8_LAS __attribute__((address_space(3)))
typedef unsigned short bf16_t;
typedef short bf16x8 __attribute__((ext_vector_type(8)));
typedef float f32x4 __attribute__((ext_vector_type(4)));
typedef float f32x2 __attribute__((ext_vector_type(2)));
typedef unsigned u32x4 __attribute__((ext_vector_type(4)));
constexpr int BM = 256, BK = 64, HALF = 128, HTB = HALF * BK * 2  , STAGE_BYTES = 8 * HTB;

__host__ __device__ __forceinline__ int lds_byte(int r, int c) { const int st = (r >> 4) * 2 + (c >> 5), rr = r & 15, cc = c & 31, ob = rr * 64 + cc * 2; return st * 1024 + (ob ^ (((ob >> 9) & 1) << 5)); }
__host__ __device__ __forceinline__ void stage_rc(int b, int& R, int& C) { const int st = b / 1024, sb = b % 1024, swz = sb ^ (((sb >> 9) & 1) << 5); R = (st >> 1) * 16 + swz / 64; C = (st & 1) * 32 + (swz % 64) / 2; }
__host__ __device__ __forceinline__ int perm32(int rho) { const int n = rho >> 4, i = rho & 15; return 8 * (i >> 2) + 4 * n + (i & 3); }

struct Unit { int pm, pn, e, mt, nv, aux; };
struct Gemm { const bf16_t* A; const bf16_t* Bt; int K; size_t b_estride; };

__device__ __forceinline__ unsigned cvt_pk_bf16(float lo, float hi) { unsigned r; asm volatile("v_cvt_pk_bf16_f32 %0, %1, %2" : "=v"(r) : "v"(lo), "v"(hi)); return r; }
__device__ __forceinline__ float bf_lo(unsigned w) { return __builtin_bit_cast(float, w << 16); }
__device__ __forceinline__ float bf_hi(unsigned w) { return __builtin_bit_cast(float, w & 0xffff0000u); }
__device__ __forceinline__ float fast_sigmoid(float x) { return __builtin_amdgcn_rcpf(1.0f + __builtin_amdgcn_exp2f(-1.4426950408889634f * x)); }
__device__ __forceinline__ float gelu_tanh(float v) { const float y = 1.5957691216057308f * (v + 0.044715f * v * v * v); return v * fast_sigmoid(y); }

template <class Epi, class Sched, bool ALIGN_EPI, bool GATHER>
__device__ __forceinline__ void gemm_phase(PG8_LAS unsigned char* lds, const Gemm g, const Sched& S, const Epi& E) {
    const int tid = threadIdx.x, wid = __builtin_amdgcn_readfirstlane(tid >> 6), lane = tid & 63, wr = wid >> 2, wc = wid & 3, fr = lane & 15, fq = lane >> 4;
    const int K = g.K, nt = K / BK;
    unsigned voffA[2], voffB[2]; int RA[2]; unsigned CA2[2];
#pragma unroll
    for (int i = 0; i < 2; ++i) { int R, C; stage_rc(tid * 16 + i * 8192, R, C); const int Rb = Epi::PERM ? ((R & ~31) + perm32(R & 31)) : R;
        voffA[i] = (unsigned)(R * K + C) * 2u; voffB[i] = (unsigned)(Rb * K + C) * 2u; RA[i] = R; CA2[i] = (unsigned)C * 2u; }
    const size_t kstep = (size_t)(BK * 2);
    const size_t hstep = (size_t)HALF * K * 2;
    const size_t tstep = 2 * hstep;
    const unsigned ldsw = (unsigned)wid * 1024u;
    const int aoff = lds_byte(wr * 64 + fr, fq * 8), boff = lds_byte(wc * 32 + fr, fq * 8);
#define PG8_SA(b, h) (((b) * 2 + (h)) * HTB)
#define PG8_SB(b, h) ((4 + (b) * 2 + (h)) * HTB)
#define PG8_STAGE2(bufoff, gbase, v0, v1) do { \
        __builtin_amdgcn_global_load_lds((const unsigned*)((const char*)(gbase) + (v0)), (PG8_LAS unsigned*)(lds + (bufoff) + ldsw), 16, 0, 0); \
        __builtin_amdgcn_global_load_lds((const unsigned*)((const char*)(gbase) + (v1)), (PG8_LAS unsigned*)(lds + (bufoff) + ldsw + 8192), 16, 0, 0); } while (0)
#define PG8_STAGEB(bufoff, gbase) PG8_STAGE2(bufoff, gbase, voffB[0], voffB[1])
#define PG8_LDA(dst, b, h) do { _Pragma("unroll") for (int m = 0; m < 4; ++m) _Pragma("unroll") for (int k = 0; k < 2; ++k) dst[m][k] = *(const PG8_LAS bf16x8*)(lds + PG8_SA(b, h) + aoff + m * 2048 + k * 1024); } while (0)
#define PG8_LDB(dst, b, h) do { _Pragma("unroll") for (int n = 0; n < 2; ++n) _Pragma("unroll") for (int k = 0; k < 2; ++k) dst[n][k] = *(const PG8_LAS bf16x8*)(lds + PG8_SB(b, h) + boff + n * 2048 + k * 1024); } while (0)
#define PG8_MMA(ai, bj, At, Bt) do { __builtin_amdgcn_s_setprio(1); _Pragma("unroll") for (int m = 0; m < 4; ++m) _Pragma("unroll") for (int n = 0; n < 2; ++n) _Pragma("unroll") for (int k = 0; k < 2; ++k) \
        acc[ai][bj][m][n] = __builtin_amdgcn_mfma_f32_16x16x32_bf16(Bt[n][k], At[m][k], acc[ai][bj][m][n], 0, 0, 0); __builtin_amdgcn_s_setprio(0); } while (0)
#define PG8_WAIT_V(n) asm volatile("s_waitcnt vmcnt(" #n ")" ::: "memory")
#define PG8_WAIT_L(n) asm volatile("s_waitcnt lgkmcnt(" #n ")" ::: "memory")
#define PG8_BAR __builtin_amdgcn_s_barrier()
#define PG8_SCHED __builtin_amdgcn_sched_barrier(0)
    Unit cur, nxt; int ui = 0;
    if (!S.next(0, cur)) return;
    f32x4 acc[2][2][4][2];
#pragma unroll
    for (int a = 0; a < 2; ++a)
#pragma unroll
        for (int b = 0; b < 2; ++b)
#pragma unroll
            for (int m = 0; m < 4; ++m)
#pragma unroll
                for (int n = 0; n < 2; ++n) acc[a][b][m][n] = (f32x4){0.f, 0.f, 0.f, 0.f};
    bf16x8 At[4][2], B0[2][2], B1[2][2];
    const char* const gA = (const char*)g.A;
    unsigned roC[2][2], roN[2][2];
    const char* cA; const char* cB = (const char*)g.Bt + ((size_t)cur.e * g.b_estride) * 2 + (size_t)cur.pn * tstep;
    if constexpr (GATHER) {
#pragma unroll
        for (int h = 0; h < 2; ++h)
#pragma unroll
            for (int i = 0; i < 2; ++i) roC[h][i] = (unsigned)S.row_of(cur, h * HALF + RA[i]) * (unsigned)(K * 2) + CA2[i];
        cA = gA;
    } else {
#pragma unroll
        for (int h = 0; h < 2; ++h)
#pragma unroll
            for (int i = 0; i < 2; ++i) roC[h][i] = voffA[i] + (unsigned)(h * hstep);
        cA = gA + (size_t)cur.pm * tstep;
    }
    S.a_ready(cur);
    PG8_STAGEB(PG8_SB(0, 0), cB); PG8_STAGEB(PG8_SB(0, 1), cB + hstep); PG8_STAGE2(PG8_SA(0, 0), cA, roC[0][0], roC[0][1]); PG8_STAGE2(PG8_SA(0, 1), cA, roC[1][0], roC[1][1]);
    if (wr == 1) PG8_BAR;
    PG8_WAIT_V(2); PG8_BAR;
    PG8_STAGEB(PG8_SB(1, 0), cB + kstep); PG8_STAGE2(PG8_SA(1, 0), cA + kstep, roC[0][0], roC[0][1]); PG8_STAGEB(PG8_SB(1, 1), cB + hstep + kstep);
    PG8_WAIT_V(6); PG8_BAR;
    for (;;) {
        const bool has_next = S.next(ui + 1, nxt);
        const char* nA; const char* nB = has_next ? (const char*)g.Bt + ((size_t)nxt.e * g.b_estride) * 2 + (size_t)nxt.pn * tstep : cB;
        if constexpr (GATHER) {
            nA = gA;
            if (has_next) {
#pragma unroll
                for (int h = 0; h < 2; ++h)
#pragma unroll
                    for (int i = 0; i < 2; ++i) roN[h][i] = (unsigned)S.row_of(nxt, h * HALF + RA[i]) * (unsigned)(K * 2) + CA2[i];
            } else {
#pragma unroll
                for (int h = 0; h < 2; ++h)
#pragma unroll
                    for (int i = 0; i < 2; ++i) roN[h][i] = roC[h][i];
            }
        } else {
            nA = has_next ? gA + (size_t)nxt.pm * tstep : cA;
        }
#pragma clang loop unroll(disable)
        for (int t = 0; t < nt; t += 2) {
            const bool last = (t == nt - 2);
            const char* a1 = cA + (size_t)(t + 1) * kstep;
            const char* a2 = last ? nA : cA + (size_t)(t + 2) * kstep; const char* b2 = last ? nB : cB + (size_t)(t + 2) * kstep;
            const char* a3 = a2 + kstep; const char* b3 = b2 + kstep;
            unsigned s00, s01, s10, s11;
            if constexpr (GATHER) { s00 = last ? roN[0][0] : roC[0][0]; s01 = last ? roN[0][1] : roC[0][1]; s10 = last ? roN[1][0] : roC[1][0]; s11 = last ? roN[1][1] : roC[1][1]; }
            else { s00 = roC[0][0]; s01 = roC[0][1]; s10 = roC[1][0]; s11 = roC[1][1]; }
            if (last && has_next) S.a_ready(nxt);
            PG8_LDB(B0, 0, 0); PG8_LDB(B1, 0, 1); PG8_SCHED; PG8_LDA(At, 0, 0); PG8_STAGE2(PG8_SA(1, 1), a1, roC[1][0], roC[1][1]);
            PG8_WAIT_V(8); PG8_WAIT_L(0); PG8_BAR; PG8_MMA(0, 0, At, B0); PG8_MMA(0, 1, At, B1); PG8_BAR; PG8_SCHED;
            PG8_LDA(At, 0, 1); PG8_STAGEB(PG8_SB(0, 0), b2); PG8_STAGEB(PG8_SB(0, 1), b2 + hstep); PG8_STAGE2(PG8_SA(0, 0), a2, s00, s01);
            PG8_WAIT_V(8); PG8_WAIT_L(0); PG8_BAR; PG8_MMA(1, 0, At, B0); PG8_MMA(1, 1, At, B1); PG8_BAR; PG8_SCHED;
            PG8_LDB(B0, 1, 0); PG8_LDB(B1, 1, 1); PG8_SCHED; PG8_LDA(At, 1, 0); PG8_STAGE2(PG8_SA(0, 1), a2, s10, s11);
            PG8_WAIT_V(8); PG8_WAIT_L(0); PG8_BAR; PG8_MMA(0, 0, At, B0); PG8_MMA(0, 1, At, B1); PG8_BAR; PG8_SCHED;
            PG8_LDA(At, 1, 1); PG8_STAGEB(PG8_SB(1, 0), b3); PG8_STAGEB(PG8_SB(1, 1), b3 + hstep); PG8_STAGE2(PG8_SA(1, 0), a3, s00, s01);
            PG8_WAIT_V(8); PG8_WAIT_L(0); PG8_BAR; PG8_MMA(1, 0, At, B0); PG8_MMA(1, 1, At, B1); PG8_BAR; PG8_SCHED;
        }
        if constexpr (ALIGN_EPI) { if (wr == 0) PG8_BAR; }
        E(acc, cur, wr, wc, fr, fq); S.done(cur);
        if (!has_next) break;
#pragma unroll
        for (int a = 0; a < 2; ++a)
#pragma unroll
            for (int b = 0; b < 2; ++b)
#pragma unroll
                for (int m = 0; m < 4; ++m)
#pragma unroll
                    for (int n = 0; n < 2; ++n) acc[a][b][m][n] = (f32x4){0.f, 0.f, 0.f, 0.f};
        cur = nxt; cA = nA; cB = nB; ++ui;
        if constexpr (GATHER) {
#pragma unroll
            for (int h = 0; h < 2; ++h)
#pragma unroll
                for (int i = 0; i < 2; ++i) roC[h][i] = roN[h][i];
        }
        if constexpr (ALIGN_EPI) { if (wr == 1) PG8_BAR; }
    }
    PG8_WAIT_V(0);
    if constexpr (!ALIGN_EPI) { if (wr == 0) PG8_BAR; }
    PG8_BAR;
#undef PG8_SA
#undef PG8_SB
#undef PG8_STAGE2
#undef PG8_STAGEB
#undef PG8_LDA
#undef PG8_LDB
#undef PG8_MMA
#undef PG8_WAIT_V
#undef PG8_WAIT_L
#undef PG8_BAR
#undef PG8_SCHED
}
}
#include <hip/hip_bf16.h>
#include <cmath>
namespace attn_body {
using bf16=__hip_bfloat16;
using bf16x8=__attribute__((ext_vector_type(8)))short;
using s16x4=__attribute__((ext_vector_type(4)))short;
using f32x16=__attribute__((ext_vector_type(16)))float;
using u32x4=__attribute__((ext_vector_type(4)))unsigned;
constexpr int BATCH=8,NHEAD=16,SEQ=4352,D=64,DM=NHEAD*D;
constexpr int NW=8,QBLK=32,QB=QBLK*NW,KVBLK=64,NQB=SEQ/QB;
constexpr int ATTN_PITCH=DM, ATTN_UNIT_ROWS=QB;
__device__ __forceinline__ int crow(int r,int hi){return (r&3)+8*(r>>2)+4*hi;}
#define SBAR() __builtin_amdgcn_sched_barrier(0)
__device__ __forceinline__ void cmask(f32x16&p0,f32x16&p1,int jb,int qrel,int hi){
  const float NEG=-INFINITY; int kb=64*jb+4*hi;
  #pragma unroll
  for(int r=0;r<16;++r){int kv=kb+(r&3)+8*(r>>2); if(kv>qrel)p0[r]=NEG; if(kv+32>qrel)p1[r]=NEG;}
}

constexpr int NSLOT=3, SLOTB=8192;
constexpr int LDS_K=0, LDS_V=NSLOT*SLOTB, LDS_WS=2*NSLOT*SLOTB, LDS_OST=LDS_WS+NW*64*4, LDS_BYTES=LDS_OST+NW*4096;
constexpr float C2=0.125f*1.4426950408889634f;
__device__ __forceinline__ void glds16(const void*gsrc,unsigned lds_dst){unsigned keep;
  asm volatile("s_mov_b32 %0, m0\n\ts_mov_b32 m0, %2\n\ts_nop 0\n\tglobal_load_lds_dwordx4 %1, off\n\ts_mov_b32 m0, %0":"=&s"(keep):"v"(gsrc),"s"(lds_dst):"memory");}
__device__ __forceinline__ float max3f(float a,float b,float c){float r;asm("v_max3_f32 %0, %1, %2, %3":"=v"(r):"v"(a),"v"(b),"v"(c));return r;}
__device__ __forceinline__ float max2f(float a,float b){float r;asm("v_max_f32_e32 %0, %1, %2":"=v"(r):"v"(a),"v"(b));return r;}
__device__ __forceinline__ float fadd_s(float a,float b){float r;asm("v_add_f32_e32 %0, %1, %2":"=v"(r):"v"(a),"v"(b));return r;}
__device__ __forceinline__ float fsub_s(float a,float b){float r;asm("v_sub_f32_e32 %0, %1, %2":"=v"(r):"v"(a),"v"(b));return r;}
typedef float f32x2_t __attribute__((ext_vector_type(2))); typedef __bf16 bf16x2_t __attribute__((ext_vector_type(2)));
__device__ __forceinline__ unsigned cvtpk_s(float lo,float hi){f32x2_t v={lo,hi};bf16x2_t b=__builtin_convertvector(v,bf16x2_t);return __builtin_bit_cast(unsigned,b);}
#define WAIT_BAR(N) asm volatile("s_waitcnt vmcnt(" #N ") lgkmcnt(0)\n\ts_barrier":::"memory")

__device__ __forceinline__ void qkt(f32x16&p0,f32x16&p1,const char*Kslot,const bf16x8*qr,const f32x16&negm,int r32,int hi){
  const char*kb=Kslot+hi*1024+r32*16;
  #pragma unroll
  for(int d0=0;d0<4;++d0){
    const bf16x8 b0=*reinterpret_cast<const bf16x8*>(kb+d0*2048);
    const bf16x8 b1=*reinterpret_cast<const bf16x8*>(kb+d0*2048+512);
    if(d0==0){p0=__builtin_amdgcn_mfma_f32_32x32x16_bf16(b0,qr[0],negm,0,0,0);p1=__builtin_amdgcn_mfma_f32_32x32x16_bf16(b1,qr[0],negm,0,0,0);}
    else{p0=__builtin_amdgcn_mfma_f32_32x32x16_bf16(b0,qr[d0],p0,0,0,0);p1=__builtin_amdgcn_mfma_f32_32x32x16_bf16(b1,qr[d0],p1,0,0,0);}}
}
typedef __attribute__((address_space(3))) const char* lds_cptr;
typedef short v4i16_t __attribute__((ext_vector_type(4)));
__device__ __forceinline__ void kload8(bf16x8*kf,lds_cptr kp){
  kf[0]=*(const __attribute__((address_space(3))) bf16x8*)(kp);      kf[1]=*(const __attribute__((address_space(3))) bf16x8*)(kp+512);
  kf[2]=*(const __attribute__((address_space(3))) bf16x8*)(kp+2048); kf[3]=*(const __attribute__((address_space(3))) bf16x8*)(kp+2560);
  kf[4]=*(const __attribute__((address_space(3))) bf16x8*)(kp+4096); kf[5]=*(const __attribute__((address_space(3))) bf16x8*)(kp+4608);
  kf[6]=*(const __attribute__((address_space(3))) bf16x8*)(kp+6144); kf[7]=*(const __attribute__((address_space(3))) bf16x8*)(kp+6656);
}
__device__ __forceinline__ void kload2(bf16x8*kf,lds_cptr kp,int j){ kf[2*j]=*(const __attribute__((address_space(3))) bf16x8*)(kp+j*2048); kf[2*j+1]=*(const __attribute__((address_space(3))) bf16x8*)(kp+j*2048+512); }
__device__ __forceinline__ s16x4 vtr(lds_cptr p){ return __builtin_bit_cast(s16x4,__builtin_amdgcn_ds_read_tr16_b64_v4i16((__attribute__((address_space(3))) v4i16_t*)p)); }
__device__ __forceinline__ float rowmax(const f32x16&p0,const f32x16&p1){
  float a=max3f(p0[0],p0[1],p1[0]),b=max3f(p0[2],p0[3],p1[1]);a=max3f(a,p1[2],p1[3]);
  #pragma unroll
  for(int r=4;r<16;r+=4){a=max3f(a,p0[r],p0[r+1]);b=max3f(b,p0[r+2],p0[r+3]);a=max3f(a,p1[r],p1[r+1]);b=max3f(b,p1[r+2],p1[r+3]);}
  const float m=max2f(a,b);
  auto rr=__builtin_amdgcn_permlane32_swap(__float_as_uint(m),__float_as_uint(m),false,false);
  return max2f(__uint_as_float(rr[0]),__uint_as_float(rr[1]));
}
__device__ __forceinline__ void pv(f32x16*o,int vb,bf16x8 pa0,bf16x8 pa1,bf16x8 pa2,bf16x8 pa3){
  #pragma unroll
  for(int d0=0;d0<2;++d0){s16x4 lo[4],hi[4];
    #pragma unroll
    for(int ks=0;ks<4;++ks){
      asm volatile("ds_read_b64_tr_b16 %0,%1 offset:%c2":"=&v"(lo[ks]):"v"(vb),"i"(d0*4096+ks*1024):"memory");
      asm volatile("ds_read_b64_tr_b16 %0,%1 offset:%c2":"=&v"(hi[ks]):"v"(vb),"i"(d0*4096+ks*1024+512):"memory");}
    asm volatile("s_waitcnt lgkmcnt(0)":::"memory");SBAR();
    #define PK(k) (bf16x8){lo[k][0],lo[k][1],lo[k][2],lo[k][3],hi[k][0],hi[k][1],hi[k][2],hi[k][3]}
    o[d0]=__builtin_amdgcn_mfma_f32_32x32x16_bf16(pa0,PK(0),o[d0],0,0,0);
    o[d0]=__builtin_amdgcn_mfma_f32_32x32x16_bf16(pa1,PK(1),o[d0],0,0,0);
    o[d0]=__builtin_amdgcn_mfma_f32_32x32x16_bf16(pa2,PK(2),o[d0],0,0,0);
    o[d0]=__builtin_amdgcn_mfma_f32_32x32x16_bf16(pa3,PK(3),o[d0],0,0,0);
    #undef PK
  }
}

#ifndef ATTN_STORE16
#define ATTN_STORE16(p,v) (*(u32x4*)(p)=(v))
#endif
template<int THRL> __device__ __forceinline__ void attn_unit(int b,int h,int hv,int qb,const bf16*Q,const bf16*__restrict__ K,const bf16*__restrict__ V,bf16*O,char*shm){
  const int tid=threadIdx.x,lane=tid&63,r32=lane&31,hi=lane>>5; const int wid=__builtin_amdgcn_readfirstlane(tid>>6);
  const long rowbase=(long)b*SEQ; const int q0=qb*QB;
  const bf16*Qw=Q+(rowbase+q0+wid*QBLK)*DM+h*D;
  const bf16*Kh=K+rowbase*DM+h*D,*Vh=V+rowbase*DM+hv*D;
  const unsigned lds0=(unsigned)(uintptr_t)shm;
  float*wsf=(float*)(shm+LDS_WS)+wid*64;
  const bf16*ksrc=Kh+(long)lane*DM+wid*8;
  const bf16*vsrc=Vh+(long)(16*(wid&3)+(lane>>2))*DM+(wid>>2)*32+(lane&3)*8;
  const unsigned kdst=lds0+LDS_K+wid*1024, vdst=lds0+LDS_V+wid*1024;
  #define DMA_K(t,slot) glds16(ksrc+(long)(t)*KVBLK*DM,(unsigned)__builtin_amdgcn_readfirstlane(kdst+(slot)))
  #define DMA_V(t,slot) glds16(vsrc+(long)(t)*KVBLK*DM,(unsigned)__builtin_amdgcn_readfirstlane(vdst+(slot)))
  const int vb0=(int)(lds0+LDS_V)+((lane>>4)&1)*32+(lane&3)*8+(4*hi+((lane&15)>>2))*64;
  const char*Kbase=shm+LDS_K; bf16x8 kf[8];
  const lds_cptr shm3=(lds_cptr)shm; const lds_cptr kp0=shm3+LDS_K+hi*1024+r32*16; const lds_cptr vp0=shm3+LDS_V+((lane>>4)&1)*32+(lane&3)*8+(4*hi+((lane&15)>>2))*64;
  const int NT=(q0+QB)/KVBLK;
  DMA_K(0,0);DMA_V(0,0);DMA_K(1,SLOTB);
  bf16x8 qr[4];
  #pragma unroll
  for(int d0=0;d0<4;++d0)qr[d0]=*reinterpret_cast<const bf16x8*>(&Qw[(long)r32*DM+d0*16+hi*8]);
  float mhat=0.f,l_reg=0.f;f32x16 o[2];o[0]=f32x16{};o[1]=f32x16{};f32x16 negm=f32x16{};asm volatile("":"+v"(negm));
  const int qrel=wid*QBLK+r32;
  #define CMASK(P0,P1,t) do{int jb_=(t)-(NT-4); if(jb_>=0)cmask(P0,P1,jb_,qrel,hi);}while(0)
  bool resc=false;
  #define START(P0,P1) do{ const float rm=rowmax(P0,P1); resc=false; \
    { const float dl=rm; mhat=fadd_s(mhat,dl); \
      _Pragma("unroll") for(int r=0;r<16;++r){P0[r]=fsub_s(P0[r],dl);P1[r]=fsub_s(P1[r],dl);} \
      _Pragma("unroll") for(int r=0;r<16;++r)negm[r]=-mhat; asm volatile("":"+v"(negm)); } \
    _Pragma("unroll") for(int r=0;r<16;++r)P0[r]=__builtin_amdgcn_exp2f(P0[r]); }while(0)
  #define RESC() do{ if(resc){ asm volatile("s_waitcnt lgkmcnt(0)":::"memory"); \
      _Pragma("unroll") for(int d_=0;d_<2;++d_) _Pragma("unroll") for(int r=0;r<16;++r)o[d_][r]*=wsf[crow(r,hi)]; } }while(0)
  f32x16 pA0,pA1,pB0,pB1;
  int sl_prev=0,sl_cur=0,sl_next=SLOTB;
  #define ROT() do{sl_prev=sl_cur;sl_cur=sl_next;sl_next=(sl_next==(NSLOT-1)*SLOTB)?0:sl_next+SLOTB;}while(0)
  DMA_K(2,2*SLOTB);
  WAIT_BAR(3);
  qkt(pA0,pA1,Kbase,qr,negm,r32,hi);asm volatile("s_nop 15\n\ts_nop 7":"+v"(pA0),"+v"(pA1));CMASK(pA0,pA1,0);
  START(pA0,pA1);
  _Pragma("unroll") for(int r=0;r<16;++r)pA1[r]=__builtin_amdgcn_exp2f(pA1[r]);
  WAIT_BAR(0);
  DMA_K(3,0);DMA_V(1,SLOTB);
  ROT();
  kload8(kf,kp0+sl_cur);
  WAIT_BAR(2);
  s16x4 vlo[8],vhi[8]; u32x4 pw0,pw1,pw2,pw3;
  #define PKW(P,B) cvtpk_s(P[B],P[B+1])
  #define PAF(k) __builtin_bit_cast(bf16x8,pw##k)
  #define VFR(i) (bf16x8){vlo[i][0],vlo[i][1],vlo[i][2],vlo[i][3],vhi[i][0],vhi[i][1],vhi[i][2],vhi[i][3]}
  #define PIN(x) asm volatile("":"+v"(x))
  #define MX3(a,b,c) __builtin_fmaxf(__builtin_fmaxf((a),(b)),(c))
  #define GAPA(MF,A0,A1,A2,A3,W0,W1,PW) do{ MF; sacc+=A0; sacc+=A1; sacc+=A2; sacc+=A3; PIN(sacc); W0; W1; PIN(PW); SBAR(); }while(0)
  #define EX(v) __builtin_amdgcn_exp2f(v)
  #define GAPB(MF,X,B) do{ MF; X[B]=EX(X[B]); X[B+1]=EX(X[B+1]); X[B+2]=EX(X[B+2]); X[B+3]=EX(X[B+3]); PIN(X); SBAR(); }while(0)
  #define VRD(i) do{ vlo[i]=vtr(vp_+(((i)>>2)*4096+((i)&3)*1024)); vhi[i]=vtr(vp_+(((i)>>2)*4096+((i)&3)*1024+512)); }while(0)
  #define KRD(G,j) do{ if(G){ kload2(kf,kp0+sl_next,j); SBAR(); } }while(0)
  #define STEP(C0,C1,P0,P1,t,GK,GV,GL) do{ SBAR(); \
    const lds_cptr vp_=vp0+sl_prev; \
    VRD(0); SBAR(); float sacc=(P0[0]+P0[1]); \
    GAPA(C0=__builtin_amdgcn_mfma_f32_32x32x16_bf16(kf[0],qr[0],negm,0,0,0), P0[2],P0[3],P0[4],P0[5],     pw0[0]=PKW(P0,0), pw0[1]=PKW(P0,2), pw0); \
    VRD(4); SBAR(); GAPA(C1=__builtin_amdgcn_mfma_f32_32x32x16_bf16(kf[1],qr[0],negm,0,0,0), P0[6],P0[7],P0[8],P0[9],     pw0[2]=PKW(P0,4), pw0[3]=PKW(P0,6), pw0); \
    VRD(1); SBAR(); GAPA(C0=__builtin_amdgcn_mfma_f32_32x32x16_bf16(kf[2],qr[1],C0,0,0,0),   P0[10],P0[11],P0[12],P0[13], pw1[0]=PKW(P0,8), pw1[1]=PKW(P0,10), pw1); \
    VRD(5); SBAR(); GAPA(C1=__builtin_amdgcn_mfma_f32_32x32x16_bf16(kf[3],qr[1],C1,0,0,0),   P0[14],P0[15],P1[0],P1[1],   pw1[2]=PKW(P0,12),pw1[3]=PKW(P0,14), pw1); \
    VRD(2); SBAR(); GAPA(C0=__builtin_amdgcn_mfma_f32_32x32x16_bf16(kf[4],qr[2],C0,0,0,0),   P1[2],P1[3],P1[4],P1[5],     pw2[0]=PKW(P1,0), pw2[1]=PKW(P1,2), pw2); \
    VRD(6); SBAR(); GAPA(C1=__builtin_amdgcn_mfma_f32_32x32x16_bf16(kf[5],qr[2],C1,0,0,0),   P1[6],P1[7],P1[8],P1[9],     pw2[2]=PKW(P1,4), pw2[3]=PKW(P1,6), pw2); \
    VRD(3); SBAR(); GAPA(C0=__builtin_amdgcn_mfma_f32_32x32x16_bf16(kf[6],qr[3],C0,0,0,0),   P1[10],P1[11],P1[12],P1[13], pw3[0]=PKW(P1,8), pw3[1]=PKW(P1,10), pw3); \
    VRD(7); SBAR(); GAPA(C1=__builtin_amdgcn_mfma_f32_32x32x16_bf16(kf[7],qr[3],C1,0,0,0),   P1[14],P1[15],0.f,0.f,       pw3[2]=PKW(P1,12),pw3[3]=PKW(P1,14), pw3); \
    l_reg+=sacc; \
    if(GK){DMA_K((t)+3,sl_cur);} if(GV){DMA_V((t)+1,sl_next);} \
    CMASK(C0,C1,t); \
    { float a=MX3(C0[0],C0[1],C1[0]),b=MX3(C0[2],C0[3],C1[1]); a=MX3(a,C1[2],C1[3]); \
      _Pragma("unroll") for(int r=4;r<16;r+=4){a=MX3(a,C0[r],C0[r+1]);b=MX3(b,C0[r+2],C0[r+3]);a=MX3(a,C1[r],C1[r+1]);b=MX3(b,C1[r+2],C1[r+3]);} \
      float rm=__builtin_fmaxf(a,b); { auto rr=__builtin_amdgcn_permlane32_swap(__float_as_uint(rm),__float_as_uint(rm),false,false); rm=__builtin_fmaxf(__uint_as_float(rr[0]),__uint_as_float(rr[1])); } \
      resc=false; \
      if(__builtin_expect(__any(rm>(float)THRL),0)){ const float dl=__builtin_fmaxf(rm,0.f); mhat+=dl; \
        _Pragma("unroll") for(int r=0;r<16;++r){C0[r]-=dl;C1[r]-=dl;} \
        _Pragma("unroll") for(int r=0;r<16;++r)negm[r]=-mhat; asm volatile("":"+v"(negm)); \
        const float f=__builtin_amdgcn_exp2f(-dl); l_reg*=f; if(hi==0)wsf[r32]=f; resc=true; } } \
    SBAR(); \
    GAPB(o[0]=__builtin_amdgcn_mfma_f32_32x32x16_bf16(PAF(0),VFR(0),o[0],0,0,0), C0,0); \
    GAPB(o[1]=__builtin_amdgcn_mfma_f32_32x32x16_bf16(PAF(0),VFR(4),o[1],0,0,0), C0,4); \
    KRD(GL,0); GAPB(o[0]=__builtin_amdgcn_mfma_f32_32x32x16_bf16(PAF(1),VFR(1),o[0],0,0,0), C0,8); \
    KRD(GL,1); GAPB(o[1]=__builtin_amdgcn_mfma_f32_32x32x16_bf16(PAF(1),VFR(5),o[1],0,0,0), C0,12); \
    KRD(GL,2); GAPB(o[0]=__builtin_amdgcn_mfma_f32_32x32x16_bf16(PAF(2),VFR(2),o[0],0,0,0), C1,0); \
    KRD(GL,3); GAPB(o[1]=__builtin_amdgcn_mfma_f32_32x32x16_bf16(PAF(2),VFR(6),o[1],0,0,0), C1,4); \
    GAPB(o[0]=__builtin_amdgcn_mfma_f32_32x32x16_bf16(PAF(3),VFR(3),o[0],0,0,0), C1,8); \
    GAPB(o[1]=__builtin_amdgcn_mfma_f32_32x32x16_bf16(PAF(3),VFR(7),o[1],0,0,0), C1,12); \
    }while(0)
  int t=1;
  #undef CMASK
  #define CMASK(P0,P1,t) do{}while(0)
  for(;t+5<NT;t+=2){
    STEP(pB0,pB1,pA0,pA1,t,true,true,true);     WAIT_BAR(2); RESC(); ROT();
    STEP(pA0,pA1,pB0,pB1,t+1,true,true,true);   WAIT_BAR(2); RESC(); ROT();
  }
  #undef CMASK
  #define CMASK(P0,P1,t) do{int jb_=(t)-(NT-4); if(jb_>=0)cmask(P0,P1,jb_,qrel,hi);}while(0)
  #define ENDW(tt) do{ if((tt)+3<NT){WAIT_BAR(2);} else if((tt)+2<NT){WAIT_BAR(1);} else {WAIT_BAR(0);} }while(0)
  for(;t+1<NT;t+=2){
    STEP(pB0,pB1,pA0,pA1,t,(t+3<NT),(t+1<NT),(t+1<NT));       ENDW(t);   RESC(); ROT();
    STEP(pA0,pA1,pB0,pB1,t+1,(t+4<NT),(t+2<NT),(t+2<NT));     ENDW(t+1); RESC(); ROT();
  }
  STEP(pB0,pB1,pA0,pA1,NT-1,false,false,false); RESC();
  { float sacc=pB0[0]+pB0[1]; _Pragma("unroll") for(int r=2;r<16;++r)sacc+=pB0[r]; _Pragma("unroll") for(int r=0;r<16;++r)sacc+=pB1[r]; l_reg+=sacc;
    pw0=(u32x4){PKW(pB0,0),PKW(pB0,2),PKW(pB0,4),PKW(pB0,6)};pw1=(u32x4){PKW(pB0,8),PKW(pB0,10),PKW(pB0,12),PKW(pB0,14)};pw2=(u32x4){PKW(pB1,0),PKW(pB1,2),PKW(pB1,4),PKW(pB1,6)};pw3=(u32x4){PKW(pB1,8),PKW(pB1,10),PKW(pB1,12),PKW(pB1,14)};
    SBAR(); pv(o,vb0+sl_cur,PAF(0),PAF(1),PAF(2),PAF(3)); }
  #undef PKW
  #undef PAF
  #undef VFR
  #undef PIN
  #undef MX3
  #undef GAPA
  #undef GAPB
  #undef EX
  #undef VRD
  #undef KRD
  #undef STEP
  #undef ENDW
  {auto rr=__builtin_amdgcn_permlane32_swap(__float_as_uint(l_reg),__float_as_uint(l_reg),false,false);l_reg=__uint_as_float(rr[0])+__uint_as_float(rr[1]);}
  if(hi==0)wsf[32+r32]=l_reg;asm volatile("s_waitcnt lgkmcnt(0)":::"memory");
  float rli[16];
  #pragma unroll
  for(int r=0;r<16;++r)rli[r]=__builtin_amdgcn_rcpf(wsf[32+crow(r,hi)]);
  bf16*Ow=O+(rowbase+q0+wid*QBLK)*DM+hv*D;
  { bf16*stg=(bf16*)(shm+LDS_OST)+wid*2048;
    #pragma unroll
    for(int r=0;r<16;++r){const int orow=crow(r,hi);
      #pragma unroll
      for(int d0=0;d0<2;++d0)stg[orow*64+d0*32+r32]=__float2bfloat16(o[d0][r]*rli[r]);}
    asm volatile("s_waitcnt lgkmcnt(0)":::"memory");
    #pragma unroll
    for(int i=0;i<4;++i){const int row=i*8+(lane>>3),ch=lane&7; const u32x4 v=*(const u32x4*)(stg+row*64+ch*8); ATTN_STORE16(Ow+(long)row*DM+ch*8,v);} }
  asm volatile("s_waitcnt lgkmcnt(0)\n\ts_barrier":::"memory");
  #undef DMA_K
  #undef DMA_V
  #undef CMASK
  #undef START
  #undef RESC
  #undef ROT
}
constexpr int ATTN_LDS_BYTES=LDS_BYTES;
struct AttnTensors { const bf16* Q; const bf16* K; const bf16* V; bf16* O; };
struct AttnUnit { int b; int hq; int hv; int qb; };
struct FixedOrder {
  int b, hq, hv;
  __device__ __forceinline__ bool next(int i,AttnUnit&u)const{ if(i>=NQB)return false; u.b=b; u.hq=hq; u.hv=hv; u.qb=NQB-1-i; return true; }
};
template<class Sched,int THRL=8> __device__ __forceinline__ void attn_phase(char*lds,const AttnTensors&T,const Sched&S){
  AttnUnit u;
  for(int i=0;S.next(i,u);++i){ attn_unit<THRL>(u.b,u.hq,u.hv,u.qb,T.Q,T.K,T.V,T.O,lds); }
}
#undef SBAR
#undef WAIT_BAR
}

constexpr int NWAVES = 8;
#ifndef MK_N_LAUNCHES
#define MK_N_LAUNCHES 1
#endif
#ifndef MK_DIAG
#define MK_DIAG 0
#endif
constexpr int NPHASE = 14;
constexpr int N_LAUNCHES = MK_N_LAUNCHES;

constexpr int NB = 8, SEQ = 4096, NMETA = 16, TV = NMETA + SEQ, TA = 4352, MA = NB * TA, D = 1024;
constexpr int NIN = 7168, NE = 256, TOPK = 8, DE = 256;
constexpr int NCHUNK = 33;
constexpr float LN_EPS = 1e-5f, ALPHA = 1.189207115002721f;
constexpr float ROUTED_SCALE = 2.5f, LAMBDA_INIT = 0.2f;
constexpr int CAP = 32768;
constexpr int NVALID = NB * SEQ;
constexpr int YSHARED = NVALID * TOPK, YDUMMY = NVALID * (TOPK + 1);

constexpr size_t MiB = 1u << 20;
constexpr size_t SLOTB = 68 * MiB;
static_assert((size_t)MA * D * 2 == SLOTB, "slot size");
constexpr size_t WS_CTL = 0, CTL_ZERO_BYTES = 1 * MiB;
constexpr size_t WS_ROWSTAT = 1 * MiB;
constexpr size_t WS_SCANSUM = 1 * MiB + 320 * 1024;
constexpr size_t WS_LRUWT = 4 * MiB - 512 * 1024;
constexpr size_t WS_S0 = 26 * MiB;
#define WS_SLOT(i) (WS_S0 + (size_t)(i) * SLOTB)
constexpr size_t WS_XN = WS_SLOT(0), WS_XR = WS_SLOT(1), WS_YG = WS_SLOT(2), WS_Q = WS_SLOT(3), WS_K = WS_SLOT(4), WS_V = WS_SLOT(5), WS_GR = WS_SLOT(6), WS_GA = WS_SLOT(7),
                 WS_REC = WS_SLOT(8), WS_O0 = WS_SLOT(9), WS_O1 = WS_SLOT(10), WS_ATT = WS_SLOT(11);
constexpr size_t WS_T1 = WS_SLOT(0), WS_U = WS_SLOT(1), WS_Z = WS_SLOT(2)  , WS_LOGITS = WS_SLOT(5);
constexpr size_t WS_LIST = 262 * MiB;
constexpr size_t WS_WGU = 4 * MiB;
constexpr size_t WS_WD = 596 * MiB;
constexpr size_t WS_ACT = 725 * MiB;
constexpr size_t WS_H1B = 905 * MiB;
constexpr size_t WS_TOKSLOT = 973 * MiB;
constexpr size_t WS_TOKW = 975 * MiB + 256 * 1024;
constexpr size_t WS_WIN = 978 * MiB, WS_WR = 992 * MiB, WS_WA = 994 * MiB, WS_WO = 996 * MiB, WS_WROUT = 998 * MiB;
constexpr size_t WS_Y = 4 * MiB;
constexpr size_t WS_END = 1000 * MiB;
constexpr int MAXTILES = 1408;
static_assert(WS_Y + ((size_t)NVALID * 9 + 1) * D * 2 <= WS_WD && WS_WD + (size_t)257 * 1024 * 256 * 2 <= WS_ACT && WS_ACT + (size_t)MAXTILES * 256 * 256 * 2 <= WS_H1B, "moe map");
static_assert(WS_WGU + (size_t)257 * 512 * 1024 * 2 <= WS_LIST && WS_LIST + (size_t)NE * CAP * 4 <= WS_SLOT(4), "moe map 2");
static_assert(WS_SLOT(12) <= WS_H1B && WS_TOKW + (size_t)MA * 16 * 4 <= WS_WIN, "map 3");
constexpr int CW_TMO = 0, CW_CODE = 1;
constexpr int CW_BAR = 4096;
constexpr int CW_CNT = 16384;
constexpr int CW_DIAG = 20480;

constexpr int RING_OFF = 0, RING_BYTES = 131072;
constexpr int LDSCTL_OFF = RING_BYTES, MISC_OFF = LDSCTL_OFF + 320;
constexpr int TT_OFF = LDSCTL_OFF + 1024;
constexpr int UB_OFF = TT_OFF + MAXTILES * 4;
constexpr int LDS_BYTES = 147456;
constexpr int CN_OFF = UB_OFF + 260 * 4, TB_OFF = CN_OFF + 260 * 4;
static_assert(TB_OFF + 260 * 4 <= LDS_BYTES, "LDS map");

#define GAS __attribute__((address_space(1)))
#define LAS __attribute__((address_space(3)))
typedef unsigned short bf16;
typedef unsigned v4u __attribute__((ext_vector_type(4)));
typedef float f32x4 __attribute__((ext_vector_type(4)));
typedef short bf16x8 __attribute__((ext_vector_type(8)));
typedef GAS unsigned gu32;
typedef GAS unsigned long long gu64;
#define RLX_AGENT __ATOMIC_RELAXED, __HIP_MEMORY_SCOPE_AGENT
#define LDS_WAIT() asm volatile("s_waitcnt lgkmcnt(0)" ::: "memory")
#define VM_WAIT() asm volatile("s_waitcnt vmcnt(0)" ::: "memory")
__device__ __forceinline__ unsigned long long rt() { return __builtin_amdgcn_s_memrealtime(); }
__device__ __forceinline__ unsigned f2bf(float f) { unsigned u = __builtin_bit_cast(unsigned, f); return (u + 0x7fffu + ((u >> 16) & 1u)) >> 16; }
__device__ __forceinline__ unsigned pk2(float lo, float hi) { return f2bf(lo) | (f2bf(hi) << 16); }

#define XB_TMO      128
#define XB_XCNT(j)  (256  + 64 * (j))
#define XB_XSUB(j)  (1280 + 64 * (j))
#define XB_XGEN(j)  (2304 + 64 * (j))
#define XB_TOP      3328
#define XB_TOPGEN   3392
#define XCD_BAR_WORDS 3456
#define XB_SPIN_CAP (1u << 18)

__device__ __forceinline__ unsigned xb_ld(unsigned* p)              { return __hip_atomic_load(p, __ATOMIC_RELAXED, __HIP_MEMORY_SCOPE_AGENT); }
__device__ __forceinline__ unsigned xb_add(unsigned* p, unsigned v) { return __hip_atomic_fetch_add(p, v, __ATOMIC_RELAXED, __HIP_MEMORY_SCOPE_AGENT); }
__device__ __forceinline__ unsigned xb_xcc_id() { return (unsigned)__builtin_amdgcn_s_getreg((3 << 11) | 20) & 0xFu; }
#define XB_SPIN(cond, bar) do { unsigned _sp = 0; while (cond) { __builtin_amdgcn_s_sleep(1); \
    if ((++_sp & 255u) == 0u) { if (xb_ld(&(bar)[XB_TMO])) break; if (_sp > XB_SPIN_CAP) { atomicAdd(&(bar)[XB_TMO], 1u); break; } } } } while (0)

struct XcdBarrier {
    unsigned* bar; unsigned x;
    volatile LAS unsigned* st;
};

__device__ __forceinline__ XcdBarrier xcd_barrier_post(unsigned* bar, volatile LAS unsigned* st) {
    XcdBarrier b; b.bar = bar; b.x = xb_xcc_id(); b.st = st;
    if (threadIdx.x == 0) (void)xb_add(&bar[XB_XCNT(b.x)], 1u);
    return b;
}
__device__ __forceinline__ void xcd_barrier_complete(unsigned* bar, unsigned x, unsigned& nloc, unsigned& nx) {
    const unsigned G = gridDim.x * gridDim.y * gridDim.z;
    unsigned sum, cnt, mine, sp = 0u;
    for (;;) {
        sum = 0u; cnt = 0u; mine = 0u;
#pragma unroll
        for (unsigned j = 0; j < 16; ++j) { const unsigned c = xb_ld(&bar[XB_XCNT(j)]); sum += c; cnt += (c > 0u) ? 1u : 0u; mine = (j == x) ? c : mine; }
        if (sum == G) break;
        __builtin_amdgcn_s_sleep(1);
        if ((++sp & 255u) == 0u) { if (xb_ld(&bar[XB_TMO])) break; if (sp > XB_SPIN_CAP) { atomicAdd(&bar[XB_TMO], 1u); break; } }
    }
    nloc = mine > 0u ? mine : 1u; nx = cnt > 0u ? cnt : 1u;
}

__device__ __forceinline__ void xcd_barrier(const XcdBarrier& b) {
    asm volatile("s_waitcnt vmcnt(0)" ::: "memory");
    __syncthreads();
    if (threadIdx.x == 0) {
        unsigned* bar = b.bar;
        __builtin_amdgcn_s_waitcnt(0);
        unsigned nloc = b.st[0], nx = b.st[1];
        if (nloc == 0u) { xcd_barrier_complete(bar, b.x, nloc, nx); b.st[0] = nloc; b.st[1] = nx; }
        const unsigned old = xb_add(&bar[XB_XSUB(b.x)], 1u);
        const unsigned gen = old / nloc;
        if (old + 1u == (gen + 1u) * nloc) {
            __builtin_amdgcn_fence(__ATOMIC_RELEASE, "agent");
            asm volatile("s_waitcnt vmcnt(0)" ::: "memory");
            const unsigned og = xb_add(&bar[XB_TOP], 1u);
            const unsigned tg = og / nx;
            if (og + 1u == (tg + 1u) * nx) xb_add(&bar[XB_TOPGEN], 1u);
            else XB_SPIN(xb_ld(&bar[XB_TOPGEN]) == tg, bar);
            __builtin_amdgcn_fence(__ATOMIC_ACQUIRE, "agent");
            xb_add(&bar[XB_XGEN(b.x)], 1u);
            asm volatile("s_waitcnt vmcnt(0)" ::: "memory");
        } else {
            XB_SPIN(xb_ld(&bar[XB_XGEN(b.x)]) == gen, bar);
            __builtin_amdgcn_fence(__ATOMIC_ACQUIRE, "agent");
            asm volatile("s_waitcnt vmcnt(0)" ::: "memory");
        }
    }
    __syncthreads();
}


__device__ __forceinline__ float wave_sum(float v) {
#pragma unroll
    for (int o = 1; o < 64; o <<= 1) v += __shfl_xor(v, o);
    return v;
}
__device__ __forceinline__ float bfl(unsigned w) { return __builtin_bit_cast(float, w << 16); }
__device__ __forceinline__ float bfh(unsigned w) { return __builtin_bit_cast(float, w & 0xffff0000u); }
__device__ __forceinline__ float bf1(bf16 h) { return __builtin_bit_cast(float, (unsigned)h << 16); }

struct DenseOrder {
    int nM, nN, nwg, G, c;
    __device__ void init(int M, int N, int G_, int c_) { nM = M / 256; nN = N / 256; nwg = nM * nN; G = G_; c = c_; }
    __device__ bool next(int i, pg8::Unit& u) const {
        const long L = (long)i * G + c; if (L >= nwg) return false;
        int wgid = (int)L; { const int q = nwg / 8, r = nwg % 8, xcd = wgid % 8, off = wgid / 8; wgid = (xcd < r ? xcd * (q + 1) : r * (q + 1) + (xcd - r) * q) + off; }
        const int WGM = 8; const int nig = WGM * nN, gid = wgid / nig, fm = gid * WGM, gsz = (nM - fm) < WGM ? (nM - fm) : WGM;
        u.pm = fm + ((wgid % nig) % gsz); u.pn = (wgid % nig) / gsz; u.e = 0; u.mt = 0; u.nv = 256; u.aux = 0; return true;
    }
    __device__ __forceinline__ int row_of(const pg8::Unit&, int) const { return 0; }
    __device__ __forceinline__ void a_ready(const pg8::Unit&) const {}
    __device__ __forceinline__ void done(const pg8::Unit&) const {}
};
template <int NPN> struct MoeOrder {
    int ntiles, G, vcu; volatile LAS unsigned* TT; volatile LAS int* UB; volatile LAS int* CN; const int* list; int* tokslot; int write_slots;
    __device__ bool next(int i, pg8::Unit& u) const {
        const long L = (long)i * G + vcu; if (L >= (long)ntiles * NPN) return false;
        const int tile = (int)(L / NPN); u.pn = (int)(L % NPN); u.pm = tile;
        const unsigned tt = __builtin_amdgcn_readfirstlane(TT[tile]); u.e = (int)(tt & 0xffffu); u.mt = (int)(tt >> 16);
        const int ce = __builtin_amdgcn_readfirstlane(CN[u.e]);
        const int rem = ce - u.mt * 256; u.nv = rem < 256 ? rem : 256;
        u.aux = __builtin_amdgcn_readfirstlane(UB[u.e]) + u.mt * 256; return true;
    }
    __device__ __forceinline__ int row_of(const pg8::Unit& u, int r) const {
        if (u.e == NE) { const int p = u.mt * 256 + r; return (p >> 12) * TA + NMETA + (p & 4095); }
        return (r < u.nv) ? (list[(size_t)u.e * CAP + u.mt * 256 + r] >> 4) : 0;
    }
    __device__ __forceinline__ void a_ready(const pg8::Unit&) const {}
    __device__ __forceinline__ void done(const pg8::Unit& u) const {
        if (write_slots && u.pn == 0 && u.e < NE) { const int r = threadIdx.x; if (r < u.nv) { const int en = list[(size_t)u.e * CAP + u.mt * 256 + r]; tokslot[(size_t)(en >> 4) * 16 + (en & 15)] = u.aux + r; } }
    }
};

using pg8::u32x4;
typedef unsigned u32x2v __attribute__((ext_vector_type(2)));
struct EpiIn {
    static constexpr bool PERM = true;
    bf16* base0; const float* b_gate; float qscale;
    __device__ __forceinline__ void operator()(const f32x4 (&acc)[2][2][4][2], const pg8::Unit& u, int wr, int wc, int fr, int fq) const {
        const int colt = u.pn * 256, t = colt >> 10, colw = colt & 1023;
        bf16* base = base0 + (size_t)t * (SLOTB / 2);
        const int row0 = u.pm * 256 + wr * 64 + fr, col0 = colw + wc * 32 + 8 * fq;
        f32x4 bv[2][2];
#pragma unroll
        for (int bj = 0; bj < 2; ++bj)
#pragma unroll
            for (int n = 0; n < 2; ++n) bv[bj][n] = (t >= 5) ? *(const f32x4*)(b_gate + (t - 5) * 1024 + col0 + bj * 128 + 4 * n) : (f32x4){0.f, 0.f, 0.f, 0.f};
#pragma unroll
        for (int ai = 0; ai < 2; ++ai)
#pragma unroll
            for (int m = 0; m < 4; ++m) { bf16* rowp = base + (size_t)(row0 + ai * 128 + m * 16) * D + col0;
#pragma unroll
                for (int bj = 0; bj < 2; ++bj) { f32x4 v0 = acc[ai][bj][m][0], v1 = acc[ai][bj][m][1];
                    if (t == 1) {
#pragma unroll
                        for (int j = 0; j < 4; ++j) { v0[j] = pg8::gelu_tanh(v0[j]); v1[j] = pg8::gelu_tanh(v1[j]); }
                    } else if (t == 2) { v0 = v0 * qscale; v1 = v1 * qscale; }
                    else if (t >= 5) { v0 = v0 + bv[bj][0]; v1 = v1 + bv[bj][1];
#pragma unroll
                        for (int j = 0; j < 4; ++j) { v0[j] = pg8::fast_sigmoid(v0[j]); v1[j] = pg8::fast_sigmoid(v1[j]); } }
                    u32x4 w; w.x = pg8::cvt_pk_bf16(v0[0], v0[1]); w.y = pg8::cvt_pk_bf16(v0[2], v0[3]); w.z = pg8::cvt_pk_bf16(v1[0], v1[1]); w.w = pg8::cvt_pk_bf16(v1[2], v1[3]);
                    *(u32x4*)(rowp + bj * 128) = w; } }
    }
};
struct EpiGate {
    static constexpr bool PERM = true;
    const bf16* gate; const bf16* add; bf16* out;
    __device__ __forceinline__ void operator()(const f32x4 (&acc)[2][2][4][2], const pg8::Unit& u, int wr, int wc, int fr, int fq) const {
        const int row0 = u.pm * 256 + wr * 64 + fr, col0 = u.pn * 256 + wc * 32 + 8 * fq;
#pragma unroll
        for (int ai = 0; ai < 2; ++ai)
#pragma unroll
            for (int m = 0; m < 4; ++m) { const size_t off = (size_t)(row0 + ai * 128 + m * 16) * D + col0;
#pragma unroll
                for (int bj = 0; bj < 2; ++bj) { const f32x4 a0 = acc[ai][bj][m][0], a1 = acc[ai][bj][m][1];
                    const u32x4 gw = *(const u32x4*)(gate + off + bj * 128);
                    u32x4 aw = (u32x4){0u, 0u, 0u, 0u}; if (add) aw = *(const u32x4*)(add + off + bj * 128);
                    const float r0 = bfl(aw.x) + bfl(gw.x) * a0[0], r1 = bfh(aw.x) + bfh(gw.x) * a0[1], r2 = bfl(aw.y) + bfl(gw.y) * a0[2], r3 = bfh(aw.y) + bfh(gw.y) * a0[3];
                    const float r4 = bfl(aw.z) + bfl(gw.z) * a1[0], r5 = bfh(aw.z) + bfh(gw.z) * a1[1], r6 = bfl(aw.w) + bfl(gw.w) * a1[2], r7 = bfh(aw.w) + bfh(gw.w) * a1[3];
                    u32x4 w; w.x = pg8::cvt_pk_bf16(r0, r1); w.y = pg8::cvt_pk_bf16(r2, r3); w.z = pg8::cvt_pk_bf16(r4, r5); w.w = pg8::cvt_pk_bf16(r6, r7);
                    *(u32x4*)(out + off + bj * 128) = w; } }
    }
};
struct EpiZ {
    static constexpr bool PERM = false;
    const float* x; const float* meta; const float* g0; const float* b0; const float* rowstat; float* Z;
    __device__ __forceinline__ void operator()(const f32x4 (&acc)[2][2][4][2], const pg8::Unit& u, int wr, int wc, int fr, int fq) const {
        const int col0 = u.pn * 256 + wc * 32 + 4 * fq;
        f32x4 gv[2][2], bv[2][2];
#pragma unroll
        for (int bj = 0; bj < 2; ++bj)
#pragma unroll
            for (int n = 0; n < 2; ++n) { gv[bj][n] = *(const f32x4*)(g0 + col0 + bj * 128 + n * 16); bv[bj][n] = *(const f32x4*)(b0 + col0 + bj * 128 + n * 16); }
#pragma unroll
        for (int ai = 0; ai < 2; ++ai)
#pragma unroll
            for (int m = 0; m < 4; ++m) { const int row = u.pm * 256 + ai * 128 + wr * 64 + m * 16 + fr; const int b = row / TA, t = row - b * TA;
                const float* xr = (t < NMETA) ? meta + (size_t)t * D : x + ((size_t)b * SEQ + (t - NMETA)) * D;
                const bool valid = t < TV; const float mean = valid ? rowstat[2 * row] : 0.f, rstd = valid ? rowstat[2 * row + 1] : 0.f;
#pragma unroll
                for (int bj = 0; bj < 2; ++bj)
#pragma unroll
                    for (int n = 0; n < 2; ++n) { const int c = col0 + bj * 128 + n * 16; f32x4 xv = (f32x4){0.f, 0.f, 0.f, 0.f}; if (valid) xv = *(const f32x4*)(xr + c);
                        const f32x4 h0 = (xv - mean) * rstd * gv[bj][n] + bv[bj][n];
                        *(f32x4*)(Z + (size_t)row * D + c) = h0 * ALPHA + acc[ai][bj][m][n]; } }
    }
};
struct EpiF32 {
    static constexpr bool PERM = false;
    float* out; int ldc;
    __device__ __forceinline__ void operator()(const f32x4 (&acc)[2][2][4][2], const pg8::Unit& u, int wr, int wc, int fr, int fq) const {
        const int col0 = u.pn * 256 + wc * 32 + 4 * fq;
#pragma unroll
        for (int ai = 0; ai < 2; ++ai)
#pragma unroll
            for (int m = 0; m < 4; ++m) { const int row = u.pm * 256 + ai * 128 + wr * 64 + m * 16 + fr;
#pragma unroll
                for (int bj = 0; bj < 2; ++bj)
#pragma unroll
                    for (int n = 0; n < 2; ++n) *(f32x4*)(out + (size_t)row * ldc + col0 + bj * 128 + n * 16) = acc[ai][bj][m][n]; }
    }
};
struct EpiAct {
    static constexpr bool PERM = true;
    bf16* act;
    __device__ __forceinline__ void operator()(const f32x4 (&acc)[2][2][4][2], const pg8::Unit& u, int wr, int wc, int fr, int fq) const {
        const int row0 = u.pm * 256 + wr * 64 + fr, col0 = u.pn * 128 + wc * 32 + 8 * fq;
#pragma unroll
        for (int ai = 0; ai < 2; ++ai)
#pragma unroll
            for (int m = 0; m < 4; ++m) { float r[8];
#pragma unroll
                for (int n = 0; n < 2; ++n)
#pragma unroll
                    for (int j = 0; j < 4; ++j) { const float gte = acc[ai][0][m][n][j], up = acc[ai][1][m][n][j]; r[n * 4 + j] = gte * pg8::fast_sigmoid(gte) * up; }
                u32x4 w; w.x = pg8::cvt_pk_bf16(r[0], r[1]); w.y = pg8::cvt_pk_bf16(r[2], r[3]); w.z = pg8::cvt_pk_bf16(r[4], r[5]); w.w = pg8::cvt_pk_bf16(r[6], r[7]);
                *(u32x4*)(act + (size_t)(row0 + ai * 128 + m * 16) * DE + col0) = w; }
    }
};
struct EpiY {
    static constexpr bool PERM = true;
    bf16* Y;
    __device__ __forceinline__ void operator()(const f32x4 (&acc)[2][2][4][2], const pg8::Unit& u, int wr, int wc, int fr, int fq) const {
        const int r0 = wr * 64 + fr, col0 = u.pn * 256 + wc * 32 + 8 * fq;
#pragma unroll
        for (int ai = 0; ai < 2; ++ai)
#pragma unroll
            for (int m = 0; m < 4; ++m) { const int r = r0 + ai * 128 + m * 16; const int yr = (r < u.nv) ? (u.aux + r) : YDUMMY;
                bf16* rowp = Y + (size_t)yr * D + col0;
#pragma unroll
                for (int bj = 0; bj < 2; ++bj) { const f32x4 v0 = acc[ai][bj][m][0], v1 = acc[ai][bj][m][1];
                    u32x4 w; w.x = pg8::cvt_pk_bf16(v0[0], v0[1]); w.y = pg8::cvt_pk_bf16(v0[2], v0[3]); w.z = pg8::cvt_pk_bf16(v1[0], v1[1]); w.w = pg8::cvt_pk_bf16(v1[2], v1[3]);
                    *(u32x4*)(rowp + bj * 128) = w; } }
    }
};

__device__ __forceinline__ void transpose_item(const float* W, int K, int N, bf16* WT, int row_base, int gu, LAS float* scr, int item, int lane) {
    const int nblk = N / 32, kb = item / nblk, nb = item % nblk, k0 = 64 * kb, n0 = 32 * nb;
    const int r0 = row_base + (gu ? ((n0 >> 7) * 256 + (n0 & 127)) : n0);
#pragma unroll 8
    for (int i = 0; i < 32; ++i) { const int kk = 2 * i + (lane >> 5); scr[kk * 33 + (lane & 31)] = W[(size_t)(k0 + kk) * N + n0 + (lane & 31)]; }
    LDS_WAIT(); asm volatile("" ::: "memory");
    const int c = lane & 7;
#pragma unroll
    for (int j = 0; j < 4; ++j) { const int n = (lane >> 3) + 8 * j; const LAS float* s = scr + (8 * c) * 33 + n;
        v4u o; o.x = pk2(s[0 * 33], s[1 * 33]); o.y = pk2(s[2 * 33], s[3 * 33]); o.z = pk2(s[4 * 33], s[5 * 33]); o.w = pk2(s[6 * 33], s[7 * 33]);
        *(GAS v4u*)(WT + (size_t)(r0 + n) * K + k0 + 8 * c) = o; }
    LDS_WAIT(); asm volatile("" ::: "memory");
}
__device__ __forceinline__ void ln_row_to_bf16(const float* xrow, const float* g, const float* b, bf16* orow, float* stat, int lane) {
    const GAS f32x4* xr = (const GAS f32x4*)xrow + lane;
    f32x4 v[4]; float s = 0.f;
#pragma unroll
    for (int j = 0; j < 4; ++j) { v[j] = xr[64 * j]; s += (v[j].x + v[j].y) + (v[j].z + v[j].w); }
    const float mean = wave_sum(s) * (1.f / D); float s2 = 0.f;
#pragma unroll
    for (int j = 0; j < 4; ++j) { v[j] = v[j] - mean; s2 += (v[j].x * v[j].x + v[j].y * v[j].y) + (v[j].z * v[j].z + v[j].w * v[j].w); }
    const float rstd = 1.f / sqrtf(wave_sum(s2) * (1.f / D) + LN_EPS);
    if (stat && lane == 0) { stat[0] = mean; stat[1] = rstd; }
    GAS unsigned long long* o8 = (GAS unsigned long long*)orow + lane;
#pragma unroll
    for (int j = 0; j < 4; ++j) { const f32x4 gg = *((const f32x4*)g + lane + 64 * j), bb = *((const f32x4*)b + lane + 64 * j); const f32x4 y = v[j] * rstd * gg + bb;
        o8[64 * j] = (unsigned long long)pk2(y.x, y.y) | ((unsigned long long)pk2(y.z, y.w) << 32); }
}

__device__ __forceinline__ int crow16(int r, int hi) { return (r & 3) + 8 * (r >> 2) + 4 * hi; }
typedef float f32x16 __attribute__((ext_vector_type(16)));
struct ScanArgs { const bf16* XR; const bf16* YG; bf16* REC; const float* conv_w; const float* conv_b; const bf16* lruwt; const float* b_a; const float* b_i; const float* lam; float* scansum; };
template <bool FINAL>
__device__ __forceinline__ void scan_item(const ScanArgs& A, LAS unsigned char* lds, int b, int nb, int ck) {
    const int tid = threadIdx.x, lane = tid & 63, wid = __builtin_amdgcn_readfirstlane(tid >> 6);
    constexpr int XP = 136;
    LAS bf16* XCB = (LAS bf16*)lds;
    LAS float* COMP = (LAS float*)(lds + 36864);
    LAS float* HIN = (LAS float*)(lds + 36864 + 32768);
    const int t0 = ck * 128; const size_t rowb = (size_t)b * TA;
    {
        const int r = tid >> 2, cq = tid & 3, t = t0 + r;
#pragma unroll
        for (int j = 0; j < 4; ++j) { const int c = cq * 32 + j * 8, C = nb * 128 + c;
            float o[8];
            { const f32x4 cb0 = *(const f32x4*)(A.conv_b + C), cb1 = *(const f32x4*)(A.conv_b + C + 4); o[0] = cb0.x; o[1] = cb0.y; o[2] = cb0.z; o[3] = cb0.w; o[4] = cb1.x; o[5] = cb1.y; o[6] = cb1.z; o[7] = cb1.w; }
#pragma unroll
            for (int k = 0; k < 4; ++k) { const int tt = t - 3 + k;
                if (tt >= 0) { const v4u xv = *(const v4u*)(A.XR + (rowb + tt) * D + C); const f32x4 w0 = *(const f32x4*)(A.conv_w + k * D + C), w1 = *(const f32x4*)(A.conv_w + k * D + C + 4);
                    o[0] += w0.x * bfl(xv.x); o[1] += w0.y * bfh(xv.x); o[2] += w0.z * bfl(xv.y); o[3] += w0.w * bfh(xv.y);
                    o[4] += w1.x * bfl(xv.z); o[5] += w1.y * bfh(xv.z); o[6] += w1.z * bfl(xv.w); o[7] += w1.w * bfh(xv.w); } }
            v4u w; w.x = pk2(o[0], o[1]); w.y = pk2(o[2], o[3]); w.z = pk2(o[4], o[5]); w.w = pk2(o[6], o[7]);
            *(LAS v4u*)(XCB + r * XP + c) = w; }
    }
    __syncthreads();
    const int rb = wid >> 1, chh = wid & 1, l31 = lane & 31, hi = lane >> 5;
    f32x16 acc[2][2];
#pragma unroll
    for (int gt = 0; gt < 2; ++gt)
#pragma unroll
        for (int cb = 0; cb < 2; ++cb) acc[gt][cb] = f32x16{};
#pragma unroll
    for (int s = 0; s < 8; ++s) {
        const bf16x8 af = *(const LAS bf16x8*)(XCB + (32 * rb + l31) * XP + 16 * s + 8 * hi);
#pragma unroll
        for (int gt = 0; gt < 2; ++gt)
#pragma unroll
            for (int cb = 0; cb < 2; ++cb) { const bf16x8 bfv = *(const bf16x8*)(A.lruwt + ((size_t)((gt * 8 + nb) * 128 + 64 * chh + 32 * cb + l31)) * 128 + 16 * s + 8 * hi);
                acc[gt][cb] = __builtin_amdgcn_mfma_f32_32x32x16_bf16(af, bfv, acc[gt][cb], 0, 0, 0); }
    }
    float av[2][16], bt[2][16];
#pragma unroll
    for (int cb = 0; cb < 2; ++cb) { const int c = 64 * chh + 32 * cb + l31, C = nb * 128 + c;
        const float ba = A.b_a[C], bi = A.b_i[C], lm = A.lam[C];
        const float sp = (-lm > 20.f) ? -lm : log1pf(__expf(-lm));
        const float k8 = -8.0f * sp * 1.4426950408889634f;
#pragma unroll
        for (int r = 0; r < 16; ++r) { const int row = 32 * rb + crow16(r, hi);
            const float rg = pg8::fast_sigmoid(acc[0][cb][r] + ba), ig = pg8::fast_sigmoid(acc[1][cb][r] + bi);
            const float a = __builtin_amdgcn_exp2f(k8 * rg); float mult = sqrtf(fmaxf(1.0f - a * a, 0.f));
            if (t0 + row == 0) mult = 1.0f;
            const float xc = bf1(XCB[row * XP + c]);
            av[cb][r] = a; bt[cb][r] = mult * ig * xc; }
#pragma unroll
        for (int j = 0; j < 4; ++j) { float Ag = av[cb][4 * j], Bg = bt[cb][4 * j];
#pragma unroll
            for (int q = 1; q < 4; ++q) { Bg = av[cb][4 * j + q] * Bg + bt[cb][4 * j + q]; Ag *= av[cb][4 * j + q]; }
            const int G = 8 * rb + 2 * j + hi; COMP[(G * 128 + c) * 2] = Ag; COMP[(G * 128 + c) * 2 + 1] = Bg; }
    }
    __syncthreads();
    if (tid < 128) { const int c = tid, C = nb * 128 + c; float h = 0.f, Ap = 1.f;
        if (FINAL) { for (int j = 0; j < ck; ++j) { const float* sm = A.scansum + ((size_t)(b * NCHUNK + j) * D + C) * 2; h = sm[0] * h + sm[1]; } }
#pragma unroll 8
        for (int G = 0; G < 32; ++G) { HIN[G * 128 + c] = h; const float Ag = COMP[(G * 128 + c) * 2], Bg = COMP[(G * 128 + c) * 2 + 1]; h = Ag * h + Bg; Ap *= Ag; }
        if (!FINAL) { float* sm = A.scansum + ((size_t)(b * NCHUNK + ck) * D + C) * 2; sm[0] = Ap; sm[1] = h; }
    }
    if (FINAL) {
        __syncthreads();
#pragma unroll
        for (int cb = 0; cb < 2; ++cb) { const int c = 64 * chh + 32 * cb + l31, C = nb * 128 + c;
#pragma unroll
            for (int j = 0; j < 4; ++j) { float h = HIN[(8 * rb + 2 * j + hi) * 128 + c];
#pragma unroll
                for (int q = 0; q < 4; ++q) { const int r = 4 * j + q; h = av[cb][r] * h + bt[cb][r]; const size_t off = (rowb + t0 + 32 * rb + crow16(r, hi)) * D + C;
                    A.REC[off] = (bf16)f2bf(h * bf1(A.YG[off])); } } }
    }
    __syncthreads();
}

__device__ __forceinline__ void route_token(const float* logits, const float* rbias, int row, unsigned* cnt, int* list, float* tokw, int lane) {
    const f32x4 lg = *((const f32x4*)(logits + (size_t)row * NE) + lane); const f32x4 rb = *((const f32x4*)rbias + lane);
    float sc[4], sel[4];
#pragma unroll
    for (int j = 0; j < 4; ++j) { sc[j] = 1.0f / (1.0f + expf(-lg[j])); sel[j] = sc[j] + rb[j]; }
    float m1 = fmaxf(sel[0], sel[1]), m2 = fminf(sel[0], sel[1]);
#pragma unroll
    for (int j = 2; j < 4; ++j) { const float v = sel[j]; m2 = fmaxf(m2, fminf(m1, v)); m1 = fmaxf(m1, v); }
#pragma unroll
    for (int o = 1; o < 8; o <<= 1) { const float o1 = __shfl_xor(m1, o), o2 = __shfl_xor(m2, o); m2 = fmaxf(fminf(m1, o1), fmaxf(m2, o2)); m1 = fmaxf(m1, o1); }
    const float gs = m1 + m2; const int g = lane >> 3; int rank = 0;
#pragma unroll
    for (int gg = 0; gg < 8; ++gg) { const float og = __shfl(gs, gg * 8); rank += (og > gs || (og == gs && gg < g)) ? 1 : 0; }
    const bool gsel = rank < 4;
#pragma unroll
    for (int j = 0; j < 4; ++j) if (!gsel) sel[j] = -INFINITY;
    float wk = 0.f; int ek = 0; float ssum = 0.f;
#pragma unroll 1
    for (int k = 0; k < TOPK; ++k) {
        float bv = sel[0]; int bi = 4 * lane;
#pragma unroll
        for (int j = 1; j < 4; ++j) if (sel[j] > bv) { bv = sel[j]; bi = 4 * lane + j; }
#pragma unroll
        for (int o = 1; o < 64; o <<= 1) { const float ov = __shfl_xor(bv, o); const int oi = __shfl_xor(bi, o); if (ov > bv || (ov == bv && oi < bi)) { bv = ov; bi = oi; } }
        const int own = bi >> 2, jj = bi & 3;
        float s = 0.f;
        if (lane == own) {
#pragma unroll
            for (int j = 0; j < 4; ++j) if (j == jj) { s = sc[j]; sel[j] = -INFINITY; } }
        s = __shfl(s, own);
        ssum += s; if (lane == k) { wk = s; ek = bi; }
    }
    if (lane < TOPK) { const float w = wk / ssum * ROUTED_SCALE; const unsigned pos = atomicAdd(cnt + ek, 1u); if (pos < (unsigned)CAP) list[(size_t)ek * CAP + pos] = (row << 4) | lane; tokw[(size_t)row * 16 + lane] = w; }
}

struct Args { const float* in[33]; float* out; unsigned char* ws; int ph_lo, ph_hi, li, pad; };
__global__ void __launch_bounds__(NWAVES * 64, 2) mega_fwd(Args args) {
    extern __shared__ __attribute__((aligned(16))) unsigned char lds[];
    LAS unsigned char* L = (LAS unsigned char*)lds;
    volatile LAS unsigned* MISC = (volatile LAS unsigned*)(L + MISC_OFF);
    const int tid = threadIdx.x, lane = tid & 63, wave = __builtin_amdgcn_readfirstlane(tid >> 6);
    const int G = gridDim.x; const int bx = blockIdx.x; const int vcu = (G % 8 == 0) ? (bx % 8) * (G / 8) + bx / 8 : bx;
    unsigned char* ws = args.ws;
    gu32* ctl = (gu32*)(ws + WS_CTL);
    for (int u = tid; u < (LDS_BYTES - LDSCTL_OFF) / 4; u += NWAVES * 64) ((LAS unsigned*)(L + LDSCTL_OFF))[u] = 0u;
    __syncthreads();
    XcdBarrier bar; bar.bar = (unsigned*)(ctl + CW_BAR); bar.x = 0; bar.st = nullptr;
    if (N_LAUNCHES == 1) bar = xcd_barrier_post((unsigned*)(ctl + CW_BAR), MISC + 8);
#define GRID_BAR() do { if (N_LAUNCHES == 1) xcd_barrier(bar); } while (0)
    const int lo = args.ph_lo, hi = args.ph_hi;
#ifndef MK_PHASE_MASK
#define MK_PHASE_MASK 0xffff
#endif
#define IN(k) ((((MK_PHASE_MASK) >> (k)) & 1) && lo <= (k) && (k) < hi)
#define BOTH(k) (IN(k) && IN((k) + 1))
    const int gw = vcu * NWAVES + wave, NGW = G * NWAVES;
    const float* x = args.in[0]; const float* meta = args.in[1];

    if (IN(0)) {
        LAS float* scr = (LAS float*)(L + RING_OFF + wave * 16384);
        constexpr int I_IN = 16 * (NIN / 32), I_SQ = 16 * 32, I_RT = 16 * 8, I_LRU = 2 * 8 * 2 * 4;
        constexpr int NITEMS = I_IN + 3 * I_SQ + I_RT + I_LRU;
        for (int it = gw; it < NITEMS; it += NGW) {
            int r = it;
            if (r < I_IN) { transpose_item(args.in[4], D, NIN, (bf16*)(ws + WS_WIN), 0, 0, scr, r, lane); continue; } r -= I_IN;
            if (r < I_SQ) { transpose_item(args.in[18], D, D, (bf16*)(ws + WS_WR), 0, 0, scr, r, lane); continue; } r -= I_SQ;
            if (r < I_SQ) { transpose_item(args.in[19], D, D, (bf16*)(ws + WS_WA), 0, 0, scr, r, lane); continue; } r -= I_SQ;
            if (r < I_SQ) { transpose_item(args.in[20], D, D, (bf16*)(ws + WS_WO), 0, 0, scr, r, lane); continue; } r -= I_SQ;
            if (r < I_RT) { transpose_item(args.in[23], D, NE, (bf16*)(ws + WS_WROUT), 0, 0, scr, r, lane); continue; } r -= I_RT;
            { const int m = r >> 3, it2 = r & 7, gt = m >> 3, blk = m & 7;
              transpose_item(args.in[gt ? 10 : 8] + (size_t)blk * 128 * 128, 128, 128, (bf16*)(ws + WS_LRUWT) + (size_t)(gt * 8 + blk) * 128 * 128, 0, 0, scr, it2, lane); }
        }
        for (int m = gw; m < MA; m += NGW) { const int b = m / TA, t = m - b * TA; bf16* orow = (bf16*)(ws + WS_XN) + (size_t)m * D;
            if (t < TV) { const float* xr = (t < NMETA) ? meta + (size_t)t * D : x + ((size_t)b * SEQ + (t - NMETA)) * D;
                ln_row_to_bf16(xr, args.in[2], args.in[3], orow, (float*)(ws + WS_ROWSTAT) + 2 * (size_t)m, lane); }
            else { GAS unsigned long long* o8 = (GAS unsigned long long*)orow + lane;
#pragma unroll
                for (int j = 0; j < 4; ++j) o8[64 * j] = 0ull; } }
        if (BOTH(0)) GRID_BAR();
    }
    if (IN(1)) {
        pg8::Gemm g{(const bf16*)(ws + WS_XN), (const bf16*)(ws + WS_WIN), D, 0}; DenseOrder S; S.init(MA, NIN, G, bx);
        EpiIn E{(bf16*)(ws + WS_XR), args.in[5], 0.125f * 1.4426950408889634f};
        pg8::gemm_phase<EpiIn, DenseOrder, true, false>(L + RING_OFF, g, S, E);
        if (BOTH(1)) GRID_BAR();
    }
    ScanArgs SA{(const bf16*)(ws + WS_XR), (const bf16*)(ws + WS_YG), (bf16*)(ws + WS_REC), args.in[6], args.in[7], (const bf16*)(ws + WS_LRUWT), args.in[9], args.in[11], args.in[12], (float*)(ws + WS_SCANSUM)};
    if (IN(2)) {
        for (int it = vcu; it < NB * 8 * NCHUNK; it += G) { const int ck = it % NCHUNK, bn = it / NCHUNK; scan_item<false>(SA, L + RING_OFF, bn >> 3, bn & 7, ck); }
        if (BOTH(2)) GRID_BAR();
    }
    if (IN(3)) {
        for (int it = vcu; it < NB * 8 * NCHUNK; it += G) { const int ck = it % NCHUNK, bn = it / NCHUNK; scan_item<true>(SA, L + RING_OFF, bn >> 3, bn & 7, ck); }
        { const int bh = vcu >> 2, sub = vcu & 3, m = sub >> 1, half = sub & 1, b = bh >> 3, h = bh & 7;
          if (bh < NB * 8) {
              const attn_body::AttnTensors AT{(const attn_body::bf16*)(ws + WS_Q), (const attn_body::bf16*)(ws + WS_K), (const attn_body::bf16*)(ws + WS_V), (attn_body::bf16*)(ws + (m ? WS_O1 : WS_O0))};
              const attn_body::FixedOrder AS{b, 2 * h + m, 2 * h + half};
              attn_body::attn_phase<attn_body::FixedOrder>((char*)lds + RING_OFF, AT, AS);
          } }
        if (BOTH(3)) GRID_BAR();
    }
    if (IN(4)) {
        const float lamq = wave_sum(args.in[13][lane] * args.in[14][lane]), lamq2 = wave_sum(args.in[15][lane] * args.in[16][lane]);
        const float lam = expf(lamq) - expf(lamq2) + LAMBDA_INIT;
        const bf16* O0 = (const bf16*)(ws + WS_O0); const bf16* O1 = (const bf16*)(ws + WS_O1); bf16* ATT = (bf16*)(ws + WS_ATT);
        for (int m = gw; m < MA; m += NGW) {
#pragma unroll
            for (int j = 0; j < 2; ++j) { const int c = j * 512 + lane * 8; const v4u a = *(const v4u*)(O0 + (size_t)m * D + c), bq = *(const v4u*)(O1 + (size_t)m * D + c);
                float d[8]; d[0] = bfl(a.x) - lam * bfl(bq.x); d[1] = bfh(a.x) - lam * bfh(bq.x); d[2] = bfl(a.y) - lam * bfl(bq.y); d[3] = bfh(a.y) - lam * bfh(bq.y);
                d[4] = bfl(a.z) - lam * bfl(bq.z); d[5] = bfh(a.z) - lam * bfh(bq.z); d[6] = bfl(a.w) - lam * bfl(bq.w); d[7] = bfh(a.w) - lam * bfh(bq.w);
                float ss = 0.f;
#pragma unroll
                for (int q = 0; q < 8; ++q) ss += d[q] * d[q];
                ss += __shfl_xor(ss, 1); ss += __shfl_xor(ss, 2); ss += __shfl_xor(ss, 4); ss += __shfl_xor(ss, 8);
                const float rs = (1.0f - LAMBDA_INIT) / sqrtf(ss * (1.0f / 128.f) + LN_EPS);
                const int e0 = c & 127; const f32x4 g0 = *(const f32x4*)(args.in[17] + e0), g1 = *(const f32x4*)(args.in[17] + e0 + 4);
                v4u w; w.x = pk2(d[0] * rs * g0.x, d[1] * rs * g0.y); w.y = pk2(d[2] * rs * g0.z, d[3] * rs * g0.w); w.z = pk2(d[4] * rs * g1.x, d[5] * rs * g1.y); w.w = pk2(d[6] * rs * g1.z, d[7] * rs * g1.w);
                *(v4u*)(ATT + (size_t)m * D + c) = w; } }
        if (BOTH(4)) GRID_BAR();
    }
    if (IN(5)) {
        pg8::Gemm g{(const bf16*)(ws + WS_REC), (const bf16*)(ws + WS_WR), D, 0}; DenseOrder S; S.init(MA, D, G, bx);
        EpiGate E{(const bf16*)(ws + WS_GR), nullptr, (bf16*)(ws + WS_T1)};
        pg8::gemm_phase<EpiGate, DenseOrder, true, false>(L + RING_OFF, g, S, E);
        if (BOTH(5)) GRID_BAR();
    }
    if (IN(6)) {
        pg8::Gemm g{(const bf16*)(ws + WS_ATT), (const bf16*)(ws + WS_WA), D, 0}; DenseOrder S; S.init(MA, D, G, bx);
        EpiGate E{(const bf16*)(ws + WS_GA), (const bf16*)(ws + WS_T1), (bf16*)(ws + WS_U)};
        pg8::gemm_phase<EpiGate, DenseOrder, true, false>(L + RING_OFF, g, S, E);
        if (BOTH(6)) GRID_BAR();
    }
    if (IN(7)) {
        pg8::Gemm g{(const bf16*)(ws + WS_U), (const bf16*)(ws + WS_WO), D, 0}; DenseOrder S; S.init(MA, D, G, bx);
        EpiZ E{x, meta, args.in[2], args.in[3], (const float*)(ws + WS_ROWSTAT), (float*)(ws + WS_Z)};
        pg8::gemm_phase<EpiZ, DenseOrder, true, false>(L + RING_OFF, g, S, E);
        if (BOTH(7)) GRID_BAR();
    }
    if (IN(8)) {
        for (int m = gw; m < MA; m += NGW) ln_row_to_bf16((const float*)(ws + WS_Z) + (size_t)m * D, args.in[21], args.in[22], (bf16*)(ws + WS_H1B) + (size_t)m * D, nullptr, lane);
        if (BOTH(8)) GRID_BAR();
    }
    if (IN(9)) {
        { pg8::Gemm g{(const bf16*)(ws + WS_H1B), (const bf16*)(ws + WS_WROUT), D, 0}; DenseOrder S; S.init(MA, NE, G, bx);
          EpiF32 E{(float*)(ws + WS_LOGITS), NE};
          pg8::gemm_phase<EpiF32, DenseOrder, false, false>(L + RING_OFF, g, S, E); }
        LAS float* scr = (LAS float*)(L + RING_OFF + wave * 16384);
        constexpr int IPE = 128;
        for (int it = gw; it < 257 * 3 * IPE; it += NGW) { const int e = it / (3 * IPE), r = it - e * 3 * IPE, which = r / IPE, i2 = r - which * IPE;
            if (which < 2) { const float* W = (e < NE) ? args.in[25 + which] + (size_t)e * D * DE : args.in[28 + which];
                transpose_item(W, D, DE, (bf16*)(ws + WS_WGU), e * 512 + which * 128, 1, scr, i2, lane); }
            else { const float* W = (e < NE) ? args.in[27] + (size_t)e * DE * D : args.in[30];
                transpose_item(W, DE, D, (bf16*)(ws + WS_WD) + (size_t)e * D * DE, 0, 0, scr, i2, lane); } }
        if (BOTH(9)) GRID_BAR();
    }
    if (IN(10)) {
        for (int p = gw; p < NVALID; p += NGW) { const int row = (p >> 12) * TA + NMETA + (p & 4095);
            route_token((const float*)(ws + WS_LOGITS), args.in[24], row, (unsigned*)(ctl + CW_CNT), (int*)(ws + WS_LIST), (float*)(ws + WS_TOKW), lane); }
        if (BOTH(10)) GRID_BAR();
    }
    if (IN(11) || IN(12)) {
        volatile LAS unsigned* TT = (volatile LAS unsigned*)(L + TT_OFF); volatile LAS int* UB = (volatile LAS int*)(L + UB_OFF);
        const unsigned* cnt = (const unsigned*)(ctl + CW_CNT);
        volatile LAS int* CN = (volatile LAS int*)(L + CN_OFF); volatile LAS int* TB = (volatile LAS int*)(L + TB_OFF);
        if (tid <= NE) { int c = (tid == NE) ? NVALID : (int)__hip_atomic_load(cnt + tid, RLX_AGENT); if (c > CAP) c = CAP; CN[tid] = c; }
        __syncthreads();
        if (tid == 0) { int tb = 0, ub = 0;
            for (int e = 0; e <= NE; ++e) { const int c = CN[e]; int ntl = (c + 255) >> 8; if (tb + ntl > MAXTILES) ntl = MAXTILES - tb; UB[e] = ub; TB[e] = tb; ub += c; tb += ntl; }
            TB[NE + 1] = tb; MISC[16] = (unsigned)tb; }
        __syncthreads();
        if (tid <= NE) { const int t0 = TB[tid], t1 = TB[tid + 1]; for (int t = t0; t < t1; ++t) TT[t] = (unsigned)tid | ((unsigned)(t - t0) << 16); }
        __syncthreads();
        const int ntiles = (int)MISC[16];
        if (IN(11)) {
            pg8::Gemm g{(const bf16*)(ws + WS_H1B), (const bf16*)(ws + WS_WGU), D, (size_t)512 * D};
            MoeOrder<2> S{ntiles, G, vcu, TT, UB, CN, (const int*)(ws + WS_LIST), (int*)(ws + WS_TOKSLOT), 1};
            EpiAct E{(bf16*)(ws + WS_ACT)};
            pg8::gemm_phase<EpiAct, MoeOrder<2>, true, true>(L + RING_OFF, g, S, E);
            if (BOTH(11)) GRID_BAR();
        }
        if (IN(12)) {
            pg8::Gemm g{(const bf16*)(ws + WS_ACT), (const bf16*)(ws + WS_WD), DE, (size_t)D * DE};
            MoeOrder<4> S{ntiles, G, vcu, TT, UB, CN, (const int*)(ws + WS_LIST), (int*)(ws + WS_TOKSLOT), 0};
            EpiY E{(bf16*)(ws + WS_Y)};
            pg8::gemm_phase<EpiY, MoeOrder<4>, true, false>(L + RING_OFF, g, S, E);
            if (BOTH(12)) GRID_BAR();
        }
    }
    if (IN(13)) {
        const bf16* H1 = (const bf16*)(ws + WS_H1B); const bf16* Y = (const bf16*)(ws + WS_Y); const int* tokslot = (const int*)(ws + WS_TOKSLOT); const float* tokw = (const float*)(ws + WS_TOKW);
        unsigned poison = __hip_atomic_load(ctl + CW_BAR + XB_TMO, RLX_AGENT) != 0u;
        for (int p = gw; p < NVALID; p += NGW) { const int row = (p >> 12) * TA + NMETA + (p & 4095);
            float z[2][8];
#pragma unroll
            for (int j = 0; j < 2; ++j) { const int c = j * 512 + lane * 8; const v4u a = *(const v4u*)(H1 + (size_t)row * D + c);
                z[j][0] = ALPHA * bfl(a.x); z[j][1] = ALPHA * bfh(a.x); z[j][2] = ALPHA * bfl(a.y); z[j][3] = ALPHA * bfh(a.y); z[j][4] = ALPHA * bfl(a.z); z[j][5] = ALPHA * bfh(a.z); z[j][6] = ALPHA * bfl(a.w); z[j][7] = ALPHA * bfh(a.w); }
#pragma unroll
            for (int k = 0; k <= TOPK; ++k) { const int yr = (k < TOPK) ? tokslot[(size_t)row * 16 + k] : YSHARED + p; const float w = (k < TOPK) ? tokw[(size_t)row * 16 + k] : 1.0f;
#pragma unroll
                for (int j = 0; j < 2; ++j) { const int c = j * 512 + lane * 8; const v4u a = *(const v4u*)(Y + (size_t)yr * D + c);
                    z[j][0] += w * bfl(a.x); z[j][1] += w * bfh(a.x); z[j][2] += w * bfl(a.y); z[j][3] += w * bfh(a.y); z[j][4] += w * bfl(a.z); z[j][5] += w * bfh(a.z); z[j][6] += w * bfl(a.w); z[j][7] += w * bfh(a.w); } }
            float s = 0.f;
#pragma unroll
            for (int j = 0; j < 2; ++j)
#pragma unroll
                for (int q = 0; q < 8; ++q) s += z[j][q];
            const float mean = wave_sum(s) * (1.f / D); float s2 = 0.f;
#pragma unroll
            for (int j = 0; j < 2; ++j)
#pragma unroll
                for (int q = 0; q < 8; ++q) { z[j][q] -= mean; s2 += z[j][q] * z[j][q]; }
            const float rstd = 1.f / sqrtf(wave_sum(s2) * (1.f / D) + LN_EPS);
            float* orow = args.out + (size_t)p * D;
#pragma unroll
            for (int j = 0; j < 2; ++j) { const int c = j * 512 + lane * 8;
#pragma unroll
                for (int q4 = 0; q4 < 2; ++q4) { const f32x4 gg = *(const f32x4*)(args.in[31] + c + 4 * q4), bb = *(const f32x4*)(args.in[32] + c + 4 * q4);
                    f32x4 o; o.x = z[j][4 * q4] * rstd * gg.x + bb.x; o.y = z[j][4 * q4 + 1] * rstd * gg.y + bb.y; o.z = z[j][4 * q4 + 2] * rstd * gg.z + bb.z; o.w = z[j][4 * q4 + 3] * rstd * gg.w + bb.w;
                    if (poison) o = (f32x4){__builtin_nanf(""), __builtin_nanf(""), __builtin_nanf(""), __builtin_nanf("")};
                    *(f32x4*)(orow + c + 4 * q4) = o; } } }
    }
#undef IN
#undef BOTH
#undef GRID_BAR
}

extern "C" void kernel_launch(void* const* d_in, const int* in_sizes, int n_in, void* d_out, int out_size, void* d_ws, size_t ws_size, hipStream_t stream) {
    static int grid = 0;
    if (grid == 0) {
        if (n_in != 33 || in_sizes[0] != NB * SEQ * D || out_size != NB * SEQ * D || ws_size < WS_END) { fprintf(stderr, "kernel_launch: unexpected shapes / workspace (n_in %d, in0 %d, out %d, ws %zu < %zu); nothing launched\n", n_in, n_in > 0 ? in_sizes[0] : -1, out_size, ws_size, (size_t)WS_END); grid = -1; return; }
        int dev = 0, cus = 0;
        if (hipGetDevice(&dev) != hipSuccess || hipDeviceGetAttribute(&cus, hipDeviceAttributeMultiprocessorCount, dev) != hipSuccess) { grid = -1; return; }
        if (hipFuncSetAttribute((const void*)mega_fwd, hipFuncAttributeMaxDynamicSharedMemorySize, LDS_BYTES) != hipSuccess) { fprintf(stderr, "kernel_launch: hipFuncSetAttribute failed\n"); grid = -1; return; }
        int per_cu = 0;
        if (hipOccupancyMaxActiveBlocksPerMultiprocessor(&per_cu, (const void*)mega_fwd, NWAVES * 64, LDS_BYTES) != hipSuccess || per_cu < 1) fprintf(stderr, "kernel_launch: occupancy query says %d\n", per_cu);
        (void)hipGetLastError();
        grid = cus;
    }
    if (grid < 0) return;
    if (hipMemsetAsync((char*)d_ws + WS_CTL, 0, CTL_ZERO_BYTES, stream) != hipSuccess) return;
    Args a{};
    for (int i = 0; i < 33; ++i) a.in[i] = (const float*)d_in[i];
    a.out = (float*)d_out; a.ws = (unsigned char*)d_ws;
    if (N_LAUNCHES == 1) { a.ph_lo = 0; a.ph_hi = NPHASE; a.li = 0; hipLaunchKernelGGL(mega_fwd, dim3(grid), dim3(NWAVES * 64), LDS_BYTES, stream, a); }
    else for (int li = 0; li < NPHASE; ++li) { a.ph_lo = li; a.ph_hi = li + 1; a.li = li; hipLaunchKernelGGL(mega_fwd, dim3(grid), dim3(NWAVES * 64), LDS_BYTES, stream, a); }
}
```

```cpp
#include <hip/hip_runtime.h>
#include <hip/hip_bf16.h>
#include <cstdio>
#include <cstdint>
#include <cmath>
namespace pg8 {
#define PG8_LAS __attribute__((address_space(3)))
typedef unsigned short bf16_t;
typedef short bf16x8 __attribute__((ext_vector_type(8)));
typedef float f32x4 __attribute__((ext_vector_type(4)));
typedef float f32x2 __attribute__((ext_vector_type(2)));
typedef unsigned u32x4 __attribute__((ext_vector_type(4)));
constexpr int BM = 256, BK = 64, HALF = 128, HTB = HALF * BK * 2  , STAGE_BYTES = 8 * HTB;

__host__ __device__ __forceinline__ int lds_byte(int r, int c) { const int st = (r >> 4) * 2 + (c >> 5), rr = r & 15, cc = c & 31, ob = rr * 64 + cc * 2; return st * 1024 + (ob ^ (((ob >> 9) & 1) << 5)); }
__host__ __device__ __forceinline__ void stage_rc(int b, int& R, int& C) { const int st = b / 1024, sb = b % 1024, swz = sb ^ (((sb >> 9) & 1) << 5); R = (st >> 1) * 16 + swz / 64; C = (st & 1) * 32 + (swz % 64) / 2; }
__host__ __device__ __forceinline__ int perm32(int rho) { const int n = rho >> 4, i = rho & 15; return 8 * (i >> 2) + 4 * n + (i & 3); }

struct Unit { int pm, pn, e, mt, nv, aux, ar; };
struct Gemm { const bf16_t* A; const bf16_t* Bt; int K; size_t b_estride; };

__device__ __forceinline__ unsigned cvt_pk_bf16(float lo, float hi) { unsigned r; asm volatile("v_cvt_pk_bf16_f32 %0, %1, %2" : "=v"(r) : "v"(lo), "v"(hi)); return r; }
__device__ __forceinline__ float bf_lo(unsigned w) { return __builtin_bit_cast(float, w << 16); }
__device__ __forceinline__ float bf_hi(unsigned w) { return __builtin_bit_cast(float, w & 0xffff0000u); }
__device__ __forceinline__ float fast_sigmoid(float x) { return __builtin_amdgcn_rcpf(1.0f + __builtin_amdgcn_exp2f(-1.4426950408889634f * x)); }
__device__ __forceinline__ float gelu_tanh(float v) { const float y = 1.5957691216057308f * (v + 0.044715f * v * v * v); return v * fast_sigmoid(y); }

template <class Epi, class Sched, bool ALIGN_EPI, bool GATHER>
__device__ __forceinline__ void gemm_phase(PG8_LAS unsigned char* lds, const Gemm g, const Sched& S, const Epi& E) {
    const int tid = threadIdx.x, wid = __builtin_amdgcn_readfirstlane(tid >> 6), lane = tid & 63, wr = wid >> 2, wc = wid & 3, fr = lane & 15, fq = lane >> 4;
    const int K = g.K, nt = K / BK;
    unsigned voffA[2], voffB[2]; int RA[2]; unsigned CA2[2];
#pragma unroll
    for (int i = 0; i < 2; ++i) { int R, C; stage_rc(tid * 16 + i * 8192, R, C); const int Rb = Epi::PERM ? ((R & ~31) + perm32(R & 31)) : R;
        voffA[i] = (unsigned)(R * K + C) * 2u; voffB[i] = (unsigned)(Rb * K + C) * 2u; RA[i] = R; CA2[i] = (unsigned)C * 2u; }
    const size_t kstep = (size_t)(BK * 2);
    const size_t hstep = (size_t)HALF * K * 2;
    const size_t tstep = 2 * hstep;
    const unsigned ldsw = (unsigned)wid * 1024u;
    const int aoff = lds_byte(wr * 64 + fr, fq * 8), boff = lds_byte(wc * 32 + fr, fq * 8);
#define PG8_SA(b, h) (((b) * 2 + (h)) * HTB)
#define PG8_SB(b, h) ((4 + (b) * 2 + (h)) * HTB)
#define PG8_STAGE2(bufoff, gbase, v0, v1) do { \
        __builtin_amdgcn_global_load_lds((const unsigned*)((const char*)(gbase) + (v0)), (PG8_LAS unsigned*)(lds + (bufoff) + ldsw), 16, 0, 0); \
        __builtin_amdgcn_global_load_lds((const unsigned*)((const char*)(gbase) + (v1)), (PG8_LAS unsigned*)(lds + (bufoff) + ldsw + 8192), 16, 0, 0); } while (0)
#define PG8_STAGEB(bufoff, gbase) PG8_STAGE2(bufoff, gbase, voffB[0], voffB[1])
#define PG8_LDA(dst, b, h) do { _Pragma("unroll") for (int m = 0; m < 4; ++m) _Pragma("unroll") for (int k = 0; k < 2; ++k) dst[m][k] = *(const PG8_LAS bf16x8*)(lds + PG8_SA(b, h) + aoff + m * 2048 + k * 1024); } while (0)
#define PG8_LDB(dst, b, h) do { _Pragma("unroll") for (int n = 0; n < 2; ++n) _Pragma("unroll") for (int k = 0; k < 2; ++k) dst[n][k] = *(const PG8_LAS bf16x8*)(lds + PG8_SB(b, h) + boff + n * 2048 + k * 1024); } while (0)
#define PG8_MMA(ai, bj, At, Bt) do { __builtin_amdgcn_s_setprio(1); _Pragma("unroll") for (int m = 0; m < 4; ++m) _Pragma("unroll") for (int n = 0; n < 2; ++n) _Pragma("unroll") for (int k = 0; k < 2; ++k) \
        acc[ai][bj][m][n] = __builtin_amdgcn_mfma_f32_16x16x32_bf16(Bt[n][k], At[m][k], acc[ai][bj][m][n], 0, 0, 0); __builtin_amdgcn_s_setprio(0); } while (0)
#define PG8_WAIT_V(n) asm volatile("s_waitcnt vmcnt(" #n ")" ::: "memory")
#define PG8_WAIT_L(n) asm volatile("s_waitcnt lgkmcnt(" #n ")" ::: "memory")
#define PG8_BAR __builtin_amdgcn_s_barrier()
#define PG8_SCHED __builtin_amdgcn_sched_barrier(0)
    Unit cur, nxt; int ui = 0;
    if (!S.next(0, cur)) return;
    f32x4 acc[2][2][4][2];
#pragma unroll
    for (int a = 0; a < 2; ++a)
#pragma unroll
        for (int b = 0; b < 2; ++b)
#pragma unroll
            for (int m = 0; m < 4; ++m)
#pragma unroll
                for (int n = 0; n < 2; ++n) acc[a][b][m][n] = (f32x4){0.f, 0.f, 0.f, 0.f};
    bf16x8 At[4][2], B0[2][2], B1[2][2];
    const char* const gA = (const char*)g.A;
    unsigned roC[2][2], roN[2][2];
    const char* cA; const char* cB = (const char*)g.Bt + ((size_t)cur.e * g.b_estride) * 2 + (size_t)cur.pn * tstep;
    if constexpr (GATHER) {
#pragma unroll
        for (int h = 0; h < 2; ++h)
#pragma unroll
            for (int i = 0; i < 2; ++i) roC[h][i] = (unsigned)S.row_of(cur, h * HALF + RA[i]) * (unsigned)(K * 2) + CA2[i];
        cA = gA;
    } else {
#pragma unroll
        for (int h = 0; h < 2; ++h)
#pragma unroll
            for (int i = 0; i < 2; ++i) roC[h][i] = voffA[i] + (unsigned)(h * hstep);
        cA = gA + (size_t)cur.ar * (size_t)(K * 2);
    }
    S.a_ready(cur);
    PG8_STAGEB(PG8_SB(0, 0), cB); PG8_STAGEB(PG8_SB(0, 1), cB + hstep); PG8_STAGE2(PG8_SA(0, 0), cA, roC[0][0], roC[0][1]); PG8_STAGE2(PG8_SA(0, 1), cA, roC[1][0], roC[1][1]);
    if (wr == 1) PG8_BAR;
    PG8_WAIT_V(2); PG8_BAR;
    PG8_STAGEB(PG8_SB(1, 0), cB + kstep); PG8_STAGE2(PG8_SA(1, 0), cA + kstep, roC[0][0], roC[0][1]); PG8_STAGEB(PG8_SB(1, 1), cB + hstep + kstep);
    PG8_WAIT_V(6); PG8_BAR;
    for (;;) {
        const bool has_next = S.next(ui + 1, nxt);
        const char* nA; const char* nB = has_next ? (const char*)g.Bt + ((size_t)nxt.e * g.b_estride) * 2 + (size_t)nxt.pn * tstep : cB;
        if constexpr (GATHER) {
            nA = gA;
            if (has_next) {
#pragma unroll
                for (int h = 0; h < 2; ++h)
#pragma unroll
                    for (int i = 0; i < 2; ++i) roN[h][i] = (unsigned)S.row_of(nxt, h * HALF + RA[i]) * (unsigned)(K * 2) + CA2[i];
            } else {
#pragma unroll
                for (int h = 0; h < 2; ++h)
#pragma unroll
                    for (int i = 0; i < 2; ++i) roN[h][i] = roC[h][i];
            }
        } else {
            nA = has_next ? gA + (size_t)nxt.ar * (size_t)(K * 2) : cA;
        }
#pragma clang loop unroll(disable)
        for (int t = 0; t < nt; t += 2) {
            const bool last = (t == nt - 2);
            const char* a1 = cA + (size_t)(t + 1) * kstep;
            const char* a2 = last ? nA : cA + (size_t)(t + 2) * kstep; const char* b2 = last ? nB : cB + (size_t)(t + 2) * kstep;
            const char* a3 = a2 + kstep; const char* b3 = b2 + kstep;
            unsigned s00, s01, s10, s11;
            if constexpr (GATHER) { s00 = last ? roN[0][0] : roC[0][0]; s01 = last ? roN[0][1] : roC[0][1]; s10 = last ? roN[1][0] : roC[1][0]; s11 = last ? roN[1][1] : roC[1][1]; }
            else { s00 = roC[0][0]; s01 = roC[0][1]; s10 = roC[1][0]; s11 = roC[1][1]; }
            if (last && has_next) S.a_ready(nxt);
            PG8_LDB(B0, 0, 0); PG8_LDB(B1, 0, 1); PG8_SCHED; PG8_LDA(At, 0, 0); PG8_STAGE2(PG8_SA(1, 1), a1, roC[1][0], roC[1][1]);
            PG8_WAIT_V(8); PG8_WAIT_L(0); PG8_BAR; PG8_MMA(0, 0, At, B0); PG8_MMA(0, 1, At, B1); PG8_BAR; PG8_SCHED;
            PG8_LDA(At, 0, 1); PG8_STAGEB(PG8_SB(0, 0), b2); PG8_STAGEB(PG8_SB(0, 1), b2 + hstep); PG8_STAGE2(PG8_SA(0, 0), a2, s00, s01);
            PG8_WAIT_V(8); PG8_WAIT_L(0); PG8_BAR; PG8_MMA(1, 0, At, B0); PG8_MMA(1, 1, At, B1); PG8_BAR; PG8_SCHED;
            PG8_LDB(B0, 1, 0); PG8_LDB(B1, 1, 1); PG8_SCHED; PG8_LDA(At, 1, 0); PG8_STAGE2(PG8_SA(0, 1), a2, s10, s11);
            PG8_WAIT_V(8); PG8_WAIT_L(0); PG8_BAR; PG8_MMA(0, 0, At, B0); PG8_MMA(0, 1, At, B1); PG8_BAR; PG8_SCHED;
            PG8_LDA(At, 1, 1); PG8_STAGEB(PG8_SB(1, 0), b3); PG8_STAGEB(PG8_SB(1, 1), b3 + hstep); PG8_STAGE2(PG8_SA(1, 0), a3, s00, s01);
            PG8_WAIT_V(8); PG8_WAIT_L(0); PG8_BAR; PG8_MMA(1, 0, At, B0); PG8_MMA(1, 1, At, B1); PG8_BAR; PG8_SCHED;
        }
        if constexpr (ALIGN_EPI) { if (wr == 0) PG8_BAR; }
        E(acc, cur, wr, wc, fr, fq); S.done(cur);
        if (!has_next) break;
#pragma unroll
        for (int a = 0; a < 2; ++a)
#pragma unroll
            for (int b = 0; b < 2; ++b)
#pragma unroll
                for (int m = 0; m < 4; ++m)
#pragma unroll
                    for (int n = 0; n < 2; ++n) acc[a][b][m][n] = (f32x4){0.f, 0.f, 0.f, 0.f};
        cur = nxt; cA = nA; cB = nB; ++ui;
        if constexpr (GATHER) {
#pragma unroll
            for (int h = 0; h < 2; ++h)
#pragma unroll
                for (int i = 0; i < 2; ++i) roC[h][i] = roN[h][i];
        }
        if constexpr (ALIGN_EPI) { if (wr == 1) PG8_BAR; }
    }
    PG8_WAIT_V(0);
    if constexpr (!ALIGN_EPI) { if (wr == 0) PG8_BAR; }
    PG8_BAR;
#undef PG8_SA
#undef PG8_SB
#undef PG8_STAGE2
#undef PG8_STAGEB
#undef PG8_LDA
#undef PG8_LDB
#undef PG8_MMA
#undef PG8_WAIT_V
#undef PG8_WAIT_L
#undef PG8_BAR
#undef PG8_SCHED
}
}
#include <hip/hip_bf16.h>
#include <cmath>
namespace attn_body {
using bf16=__hip_bfloat16;
using bf16x8=__attribute__((ext_vector_type(8)))short;
using s16x4=__attribute__((ext_vector_type(4)))short;
using f32x16=__attribute__((ext_vector_type(16)))float;
using u32x4=__attribute__((ext_vector_type(4)))unsigned;
constexpr int BATCH=8,NHEAD=16,SEQ=4352,D=64,DM=NHEAD*D;
constexpr int NW=8,QBLK=32,QB=QBLK*NW,KVBLK=64,NQB=SEQ/QB;
constexpr int ATTN_PITCH=DM, ATTN_UNIT_ROWS=QB;
__device__ __forceinline__ int crow(int r,int hi){return (r&3)+8*(r>>2)+4*hi;}
#define SBAR() __builtin_amdgcn_sched_barrier(0)
__device__ __forceinline__ void cmask(f32x16&p0,f32x16&p1,int jb,int qrel,int hi){
  const float NEG=-INFINITY; int kb=64*jb+4*hi;
  #pragma unroll
  for(int r=0;r<16;++r){int kv=kb+(r&3)+8*(r>>2); if(kv>qrel)p0[r]=NEG; if(kv+32>qrel)p1[r]=NEG;}
}

constexpr int NSLOT=3, SLOTB=8192;
constexpr int LDS_K=0, LDS_V=NSLOT*SLOTB, LDS_WS=2*NSLOT*SLOTB, LDS_OST=LDS_WS+NW*64*4, LDS_BYTES=LDS_OST+NW*4096;
constexpr float C2=0.125f*1.4426950408889634f;
__device__ __forceinline__ void glds16(const void*gsrc,unsigned lds_dst){unsigned keep;
  asm volatile("s_mov_b32 %0, m0\n\ts_mov_b32 m0, %2\n\ts_nop 0\n\tglobal_load_lds_dwordx4 %1, off\n\ts_mov_b32 m0, %0":"=&s"(keep):"v"(gsrc),"s"(lds_dst):"memory");}
__device__ __forceinline__ float max3f(float a,float b,float c){float r;asm("v_max3_f32 %0, %1, %2, %3":"=v"(r):"v"(a),"v"(b),"v"(c));return r;}
__device__ __forceinline__ float max2f(float a,float b){float r;asm("v_max_f32_e32 %0, %1, %2":"=v"(r):"v"(a),"v"(b));return r;}
__device__ __forceinline__ float fadd_s(float a,float b){float r;asm("v_add_f32_e32 %0, %1, %2":"=v"(r):"v"(a),"v"(b));return r;}
__device__ __forceinline__ float fsub_s(float a,float b){float r;asm("v_sub_f32_e32 %0, %1, %2":"=v"(r):"v"(a),"v"(b));return r;}
typedef float f32x2_t __attribute__((ext_vector_type(2))); typedef __bf16 bf16x2_t __attribute__((ext_vector_type(2)));
__device__ __forceinline__ unsigned cvtpk_s(float lo,float hi){f32x2_t v={lo,hi};bf16x2_t b=__builtin_convertvector(v,bf16x2_t);return __builtin_bit_cast(unsigned,b);}
#define WAIT_BAR(N) asm volatile("s_waitcnt vmcnt(" #N ") lgkmcnt(0)\n\ts_barrier":::"memory")

__device__ __forceinline__ void qkt(f32x16&p0,f32x16&p1,const char*Kslot,const bf16x8*qr,const f32x16&negm,int r32,int hi){
  const char*kb=Kslot+hi*1024+r32*16;
  #pragma unroll
  for(int d0=0;d0<4;++d0){
    const bf16x8 b0=*reinterpret_cast<const bf16x8*>(kb+d0*2048);
    const bf16x8 b1=*reinterpret_cast<const bf16x8*>(kb+d0*2048+512);
    if(d0==0){p0=__builtin_amdgcn_mfma_f32_32x32x16_bf16(b0,qr[0],negm,0,0,0);p1=__builtin_amdgcn_mfma_f32_32x32x16_bf16(b1,qr[0],negm,0,0,0);}
    else{p0=__builtin_amdgcn_mfma_f32_32x32x16_bf16(b0,qr[d0],p0,0,0,0);p1=__builtin_amdgcn_mfma_f32_32x32x16_bf16(b1,qr[d0],p1,0,0,0);}}
}
typedef __attribute__((address_space(3))) const char* lds_cptr;
typedef short v4i16_t __attribute__((ext_vector_type(4)));
__device__ __forceinline__ void kload8(bf16x8*kf,lds_cptr kp){
  kf[0]=*(const __attribute__((address_space(3))) bf16x8*)(kp);      kf[1]=*(const __attribute__((address_space(3))) bf16x8*)(kp+512);
  kf[2]=*(const __attribute__((address_space(3))) bf16x8*)(kp+2048); kf[3]=*(const __attribute__((address_space(3))) bf16x8*)(kp+2560);
  kf[4]=*(const __attribute__((address_space(3))) bf16x8*)(kp+4096); kf[5]=*(const __attribute__((address_space(3))) bf16x8*)(kp+4608);
  kf[6]=*(const __attribute__((address_space(3))) bf16x8*)(kp+6144); kf[7]=*(const __attribute__((address_space(3))) bf16x8*)(kp+6656);
}
__device__ __forceinline__ void kload2(bf16x8*kf,lds_cptr kp,int j){ kf[2*j]=*(const __attribute__((address_space(3))) bf16x8*)(kp+j*2048); kf[2*j+1]=*(const __attribute__((address_space(3))) bf16x8*)(kp+j*2048+512); }
__device__ __forceinline__ s16x4 vtr(lds_cptr p){ return __builtin_bit_cast(s16x4,__builtin_amdgcn_ds_read_tr16_b64_v4i16((__attribute__((address_space(3))) v4i16_t*)p)); }
__device__ __forceinline__ float rowmax(const f32x16&p0,const f32x16&p1){
  float a=max3f(p0[0],p0[1],p1[0]),b=max3f(p0[2],p0[3],p1[1]);a=max3f(a,p1[2],p1[3]);
  #pragma unroll
  for(int r=4;r<16;r+=4){a=max3f(a,p0[r],p0[r+1]);b=max3f(b,p0[r+2],p0[r+3]);a=max3f(a,p1[r],p1[r+1]);b=max3f(b,p1[r+2],p1[r+3]);}
  const float m=max2f(a,b);
  auto rr=__builtin_amdgcn_permlane32_swap(__float_as_uint(m),__float_as_uint(m),false,false);
  return max2f(__uint_as_float(rr[0]),__uint_as_float(rr[1]));
}
__device__ __forceinline__ void pv(f32x16*o,int vb,bf16x8 pa0,bf16x8 pa1,bf16x8 pa2,bf16x8 pa3){
  #pragma unroll
  for(int d0=0;d0<2;++d0){s16x4 lo[4],hi[4];
    #pragma unroll
    for(int ks=0;ks<4;++ks){
      asm volatile("ds_read_b64_tr_b16 %0,%1 offset:%c2":"=&v"(lo[ks]):"v"(vb),"i"(d0*4096+ks*1024):"memory");
      asm volatile("ds_read_b64_tr_b16 %0,%1 offset:%c2":"=&v"(hi[ks]):"v"(vb),"i"(d0*4096+ks*1024+512):"memory");}
    asm volatile("s_waitcnt lgkmcnt(0)":::"memory");SBAR();
    #define PK(k) (bf16x8){lo[k][0],lo[k][1],lo[k][2],lo[k][3],hi[k][0],hi[k][1],hi[k][2],hi[k][3]}
    o[d0]=__builtin_amdgcn_mfma_f32_32x32x16_bf16(pa0,PK(0),o[d0],0,0,0);
    o[d0]=__builtin_amdgcn_mfma_f32_32x32x16_bf16(pa1,PK(1),o[d0],0,0,0);
    o[d0]=__builtin_amdgcn_mfma_f32_32x32x16_bf16(pa2,PK(2),o[d0],0,0,0);
    o[d0]=__builtin_amdgcn_mfma_f32_32x32x16_bf16(pa3,PK(3),o[d0],0,0,0);
    #undef PK
  }
}

#ifndef ATTN_STORE16
#define ATTN_STORE16(p,v) (*(u32x4*)(p)=(v))
#endif
template<int THRL> __device__ __forceinline__ void attn_unit(int b,int h,int hv,int qb,const bf16*Q,const bf16*__restrict__ K,const bf16*__restrict__ V,bf16*O,char*shm){
  const int tid=threadIdx.x,lane=tid&63,r32=lane&31,hi=lane>>5; const int wid=__builtin_amdgcn_readfirstlane(tid>>6);
  const long rowbase=(long)b*SEQ; const int q0=qb*QB;
  const bf16*Qw=Q+(rowbase+q0+wid*QBLK)*DM+h*D;
  const bf16*Kh=K+rowbase*DM+h*D,*Vh=V+rowbase*DM+hv*D;
  const unsigned lds0=(unsigned)(uintptr_t)shm;
  float*wsf=(float*)(shm+LDS_WS)+wid*64;
  const bf16*ksrc=Kh+(long)lane*DM+wid*8;
  const bf16*vsrc=Vh+(long)(16*(wid&3)+(lane>>2))*DM+(wid>>2)*32+(lane&3)*8;
  const unsigned kdst=lds0+LDS_K+wid*1024, vdst=lds0+LDS_V+wid*1024;
  #define DMA_K(t,slot) glds16(ksrc+(long)(t)*KVBLK*DM,(unsigned)__builtin_amdgcn_readfirstlane(kdst+(slot)))
  #define DMA_V(t,slot) glds16(vsrc+(long)(t)*KVBLK*DM,(unsigned)__builtin_amdgcn_readfirstlane(vdst+(slot)))
  const int vb0=(int)(lds0+LDS_V)+((lane>>4)&1)*32+(lane&3)*8+(4*hi+((lane&15)>>2))*64;
  const char*Kbase=shm+LDS_K; bf16x8 kf[8];
  const lds_cptr shm3=(lds_cptr)shm; const lds_cptr kp0=shm3+LDS_K+hi*1024+r32*16; const lds_cptr vp0=shm3+LDS_V+((lane>>4)&1)*32+(lane&3)*8+(4*hi+((lane&15)>>2))*64;
  const int NT=(q0+QB)/KVBLK;
  DMA_K(0,0);DMA_V(0,0);DMA_K(1,SLOTB);
  bf16x8 qr[4];
  #pragma unroll
  for(int d0=0;d0<4;++d0)qr[d0]=*reinterpret_cast<const bf16x8*>(&Qw[(long)r32*DM+d0*16+hi*8]);
  float mhat=0.f,l_reg=0.f;f32x16 o[2];o[0]=f32x16{};o[1]=f32x16{};f32x16 negm=f32x16{};asm volatile("":"+v"(negm));
  const int qrel=wid*QBLK+r32;
  #define CMASK(P0,P1,t) do{int jb_=(t)-(NT-4); if(jb_>=0)cmask(P0,P1,jb_,qrel,hi);}while(0)
  bool resc=false;
  #define START(P0,P1) do{ const float rm=rowmax(P0,P1); resc=false; \
    { const float dl=rm; mhat=fadd_s(mhat,dl); \
      _Pragma("unroll") for(int r=0;r<16;++r){P0[r]=fsub_s(P0[r],dl);P1[r]=fsub_s(P1[r],dl);} \
      _Pragma("unroll") for(int r=0;r<16;++r)negm[r]=-mhat; asm volatile("":"+v"(negm)); } \
    _Pragma("unroll") for(int r=0;r<16;++r)P0[r]=__builtin_amdgcn_exp2f(P0[r]); }while(0)
  #define RESC() do{ if(resc){ asm volatile("s_waitcnt lgkmcnt(0)":::"memory"); \
      _Pragma("unroll") for(int d_=0;d_<2;++d_) _Pragma("unroll") for(int r=0;r<16;++r)o[d_][r]*=wsf[crow(r,hi)]; } }while(0)
  f32x16 pA0,pA1,pB0,pB1;
  int sl_prev=0,sl_cur=0,sl_next=SLOTB;
  #define ROT() do{sl_prev=sl_cur;sl_cur=sl_next;sl_next=(sl_next==(NSLOT-1)*SLOTB)?0:sl_next+SLOTB;}while(0)
  DMA_K(2,2*SLOTB);
  WAIT_BAR(3);
  qkt(pA0,pA1,Kbase,qr,negm,r32,hi);asm volatile("s_nop 15\n\ts_nop 7":"+v"(pA0),"+v"(pA1));CMASK(pA0,pA1,0);
  START(pA0,pA1);
  _Pragma("unroll") for(int r=0;r<16;++r)pA1[r]=__builtin_amdgcn_exp2f(pA1[r]);
  WAIT_BAR(0);
  DMA_K(3,0);DMA_V(1,SLOTB);
  ROT();
  kload8(kf,kp0+sl_cur);
  WAIT_BAR(2);
  s16x4 vlo[8],vhi[8]; u32x4 pw0,pw1,pw2,pw3;
  #define PKW(P,B) cvtpk_s(P[B],P[B+1])
  #define PAF(k) __builtin_bit_cast(bf16x8,pw##k)
  #define VFR(i) (bf16x8){vlo[i][0],vlo[i][1],vlo[i][2],vlo[i][3],vhi[i][0],vhi[i][1],vhi[i][2],vhi[i][3]}
  #define PIN(x) asm volatile("":"+v"(x))
  #define MX3(a,b,c) __builtin_fmaxf(__builtin_fmaxf((a),(b)),(c))
  #define GAPA(MF,A0,A1,A2,A3,W0,W1,PW) do{ MF; sacc+=A0; sacc+=A1; sacc+=A2; sacc+=A3; PIN(sacc); W0; W1; PIN(PW); SBAR(); }while(0)
  #define EX(v) __builtin_amdgcn_exp2f(v)
  #define GAPB(MF,X,B) do{ MF; X[B]=EX(X[B]); X[B+1]=EX(X[B+1]); X[B+2]=EX(X[B+2]); X[B+3]=EX(X[B+3]); PIN(X); SBAR(); }while(0)
  #define VRD(i) do{ vlo[i]=vtr(vp_+(((i)>>2)*4096+((i)&3)*1024)); vhi[i]=vtr(vp_+(((i)>>2)*4096+((i)&3)*1024+512)); }while(0)
  #define KRD(G,j) do{ if(G){ kload2(kf,kp0+sl_next,j); SBAR(); } }while(0)
  #define STEP(C0,C1,P0,P1,t,GK,GV,GL) do{ SBAR(); \
    const lds_cptr vp_=vp0+sl_prev; \
    VRD(0); SBAR(); float sacc=(P0[0]+P0[1]); \
    GAPA(C0=__builtin_amdgcn_mfma_f32_32x32x16_bf16(kf[0],qr[0],negm,0,0,0), P0[2],P0[3],P0[4],P0[5],     pw0[0]=PKW(P0,0), pw0[1]=PKW(P0,2), pw0); \
    VRD(4); SBAR(); GAPA(C1=__builtin_amdgcn_mfma_f32_32x32x16_bf16(kf[1],qr[0],negm,0,0,0), P0[6],P0[7],P0[8],P0[9],     pw0[2]=PKW(P0,4), pw0[3]=PKW(P0,6), pw0); \
    VRD(1); SBAR(); GAPA(C0=__builtin_amdgcn_mfma_f32_32x32x16_bf16(kf[2],qr[1],C0,0,0,0),   P0[10],P0[11],P0[12],P0[13], pw1[0]=PKW(P0,8), pw1[1]=PKW(P0,10), pw1); \
    VRD(5); SBAR(); GAPA(C1=__builtin_amdgcn_mfma_f32_32x32x16_bf16(kf[3],qr[1],C1,0,0,0),   P0[14],P0[15],P1[0],P1[1],   pw1[2]=PKW(P0,12),pw1[3]=PKW(P0,14), pw1); \
    VRD(2); SBAR(); GAPA(C0=__builtin_amdgcn_mfma_f32_32x32x16_bf16(kf[4],qr[2],C0,0,0,0),   P1[2],P1[3],P1[4],P1[5],     pw2[0]=PKW(P1,0), pw2[1]=PKW(P1,2), pw2); \
    VRD(6); SBAR(); GAPA(C1=__builtin_amdgcn_mfma_f32_32x32x16_bf16(kf[5],qr[2],C1,0,0,0),   P1[6],P1[7],P1[8],P1[9],     pw2[2]=PKW(P1,4), pw2[3]=PKW(P1,6), pw2); \
    VRD(3); SBAR(); GAPA(C0=__builtin_amdgcn_mfma_f32_32x32x16_bf16(kf[6],qr[3],C0,0,0,0),   P1[10],P1[11],P1[12],P1[13], pw3[0]=PKW(P1,8), pw3[1]=PKW(P1,10), pw3); \
    VRD(7); SBAR(); GAPA(C1=__builtin_amdgcn_mfma_f32_32x32x16_bf16(kf[7],qr[3],C1,0,0,0),   P1[14],P1[15],0.f,0.f,       pw3[2]=PKW(P1,12),pw3[3]=PKW(P1,14), pw3); \
    l_reg+=sacc; \
    if(GK){DMA_K((t)+3,sl_cur);} if(GV){DMA_V((t)+1,sl_next);} \
    CMASK(C0,C1,t); \
    { float a=MX3(C0[0],C0[1],C1[0]),b=MX3(C0[2],C0[3],C1[1]); a=MX3(a,C1[2],C1[3]); \
      _Pragma("unroll") for(int r=4;r<16;r+=4){a=MX3(a,C0[r],C0[r+1]);b=MX3(b,C0[r+2],C0[r+3]);a=MX3(a,C1[r],C1[r+1]);b=MX3(b,C1[r+2],C1[r+3]);} \
      float rm=__builtin_fmaxf(a,b); { auto rr=__builtin_amdgcn_permlane32_swap(__float_as_uint(rm),__float_as_uint(rm),false,false); rm=__builtin_fmaxf(__uint_as_float(rr[0]),__uint_as_float(rr[1])); } \
      resc=false; \
      if(__builtin_expect(__any(rm>(float)THRL),0)){ const float dl=__builtin_fmaxf(rm,0.f); mhat+=dl; \
        _Pragma("unroll") for(int r=0;r<16;++r){C0[r]-=dl;C1[r]-=dl;} \
        _Pragma("unroll") for(int r=0;r<16;++r)negm[r]=-mhat; asm volatile("":"+v"(negm)); \
        const float f=__builtin_amdgcn_exp2f(-dl); l_reg*=f; if(hi==0)wsf[r32]=f; resc=true; } } \
    SBAR(); \
    GAPB(o[0]=__builtin_amdgcn_mfma_f32_32x32x16_bf16(PAF(0),VFR(0),o[0],0,0,0), C0,0); \
    GAPB(o[1]=__builtin_amdgcn_mfma_f32_32x32x16_bf16(PAF(0),VFR(4),o[1],0,0,0), C0,4); \
    KRD(GL,0); GAPB(o[0]=__builtin_amdgcn_mfma_f32_32x32x16_bf16(PAF(1),VFR(1),o[0],0,0,0), C0,8); \
    KRD(GL,1); GAPB(o[1]=__builtin_amdgcn_mfma_f32_32x32x16_bf16(PAF(1),VFR(5),o[1],0,0,0), C0,12); \
    KRD(GL,2); GAPB(o[0]=__builtin_amdgcn_mfma_f32_32x32x16_bf16(PAF(2),VFR(2),o[0],0,0,0), C1,0); \
    KRD(GL,3); GAPB(o[1]=__builtin_amdgcn_mfma_f32_32x32x16_bf16(PAF(2),VFR(6),o[1],0,0,0), C1,4); \
    GAPB(o[0]=__builtin_amdgcn_mfma_f32_32x32x16_bf16(PAF(3),VFR(3),o[0],0,0,0), C1,8); \
    GAPB(o[1]=__builtin_amdgcn_mfma_f32_32x32x16_bf16(PAF(3),VFR(7),o[1],0,0,0), C1,12); \
    }while(0)
  int t=1;
  #undef CMASK
  #define CMASK(P0,P1,t) do{}while(0)
  for(;t+5<NT;t+=2){
    STEP(pB0,pB1,pA0,pA1,t,true,true,true);     WAIT_BAR(2); RESC(); ROT();
    STEP(pA0,pA1,pB0,pB1,t+1,true,true,true);   WAIT_BAR(2); RESC(); ROT();
  }
  #undef CMASK
  #define CMASK(P0,P1,t) do{int jb_=(t)-(NT-4); if(jb_>=0)cmask(P0,P1,jb_,qrel,hi);}while(0)
  #define ENDW(tt) do{ if((tt)+3<NT){WAIT_BAR(2);} else if((tt)+2<NT){WAIT_BAR(1);} else {WAIT_BAR(0);} }while(0)
  for(;t+1<NT;t+=2){
    STEP(pB0,pB1,pA0,pA1,t,(t+3<NT),(t+1<NT),(t+1<NT));       ENDW(t);   RESC(); ROT();
    STEP(pA0,pA1,pB0,pB1,t+1,(t+4<NT),(t+2<NT),(t+2<NT));     ENDW(t+1); RESC(); ROT();
  }
  STEP(pB0,pB1,pA0,pA1,NT-1,false,false,false); RESC();
  { float sacc=pB0[0]+pB0[1]; _Pragma("unroll") for(int r=2;r<16;++r)sacc+=pB0[r]; _Pragma("unroll") for(int r=0;r<16;++r)sacc+=pB1[r]; l_reg+=sacc;
    pw0=(u32x4){PKW(pB0,0),PKW(pB0,2),PKW(pB0,4),PKW(pB0,6)};pw1=(u32x4){PKW(pB0,8),PKW(pB0,10),PKW(pB0,12),PKW(pB0,14)};pw2=(u32x4){PKW(pB1,0),PKW(pB1,2),PKW(pB1,4),PKW(pB1,6)};pw3=(u32x4){PKW(pB1,8),PKW(pB1,10),PKW(pB1,12),PKW(pB1,14)};
    SBAR(); pv(o,vb0+sl_cur,PAF(0),PAF(1),PAF(2),PAF(3)); }
  #undef PKW
  #undef PAF
  #undef VFR
  #undef PIN
  #undef MX3
  #undef GAPA
  #undef GAPB
  #undef EX
  #undef VRD
  #undef KRD
  #undef STEP
  #undef ENDW
  {auto rr=__builtin_amdgcn_permlane32_swap(__float_as_uint(l_reg),__float_as_uint(l_reg),false,false);l_reg=__uint_as_float(rr[0])+__uint_as_float(rr[1]);}
  if(hi==0)wsf[32+r32]=l_reg;asm volatile("s_waitcnt lgkmcnt(0)":::"memory");
  float rli[16];
  #pragma unroll
  for(int r=0;r<16;++r)rli[r]=__builtin_amdgcn_rcpf(wsf[32+crow(r,hi)]);
  bf16*Ow=O+(rowbase+q0+wid*QBLK)*DM+hv*D;
  { bf16*stg=(bf16*)(shm+LDS_OST)+wid*2048;
    #pragma unroll
    for(int r=0;r<16;++r){const int orow=crow(r,hi);
      #pragma unroll
      for(int d0=0;d0<2;++d0)stg[orow*64+d0*32+r32]=__float2bfloat16(o[d0][r]*rli[r]);}
    asm volatile("s_waitcnt lgkmcnt(0)":::"memory");
    #pragma unroll
    for(int i=0;i<4;++i){const int row=i*8+(lane>>3),ch=lane&7; const u32x4 v=*(const u32x4*)(stg+row*64+ch*8); ATTN_STORE16(Ow+(long)row*DM+ch*8,v);} }
  asm volatile("s_waitcnt lgkmcnt(0)\n\ts_barrier":::"memory");
  #undef DMA_K
  #undef DMA_V
  #undef CMASK
  #undef START
  #undef RESC
  #undef ROT
}
constexpr int ATTN_LDS_BYTES=LDS_BYTES;
struct AttnTensors { const bf16* Q; const bf16* K; const bf16* V; bf16* O; };
struct AttnUnit { int b; int hq; int hv; int qb; };
struct FixedOrder {
  int b, hq, hv;
  __device__ __forceinline__ bool next(int i,AttnUnit&u)const{ if(i>=NQB)return false; u.b=b; u.hq=hq; u.hv=hv; u.qb=NQB-1-i; return true; }
};
template<class Sched,int THRL=8> __device__ __forceinline__ void attn_phase(char*lds,const AttnTensors&T,const Sched&S){
  AttnUnit u;
  for(int i=0;S.next(i,u);++i){ attn_unit<THRL>(u.b,u.hq,u.hv,u.qb,T.Q,T.K,T.V,T.O,lds); }
}
#undef SBAR
#undef WAIT_BAR
}

constexpr int NWAVES = 8;
#ifndef MK_N_LAUNCHES
#define MK_N_LAUNCHES 1
#endif
#ifndef MK_DIAG
#define MK_DIAG 0
#endif
constexpr int NPHASE = 14;
constexpr int N_LAUNCHES = MK_N_LAUNCHES;

constexpr int NB = 8, SEQ = 4096, NMETA = 16, TV = NMETA + SEQ, TA = 4352, MA = NB * TA, D = 1024;
constexpr int NIN = 7168, NE = 256, TOPK = 8, DE = 256;
constexpr int NCHUNK = 33;
constexpr float LN_EPS = 1e-5f, ALPHA = 1.189207115002721f;
constexpr float ROUTED_SCALE = 2.5f, LAMBDA_INIT = 0.2f;
constexpr int CAP = 32768;
constexpr int NVALID = NB * SEQ;
constexpr int YSHARED = NVALID * TOPK, YDUMMY = NVALID * (TOPK + 1);

constexpr size_t MiB = 1u << 20;
constexpr size_t SLOTB = 68 * MiB;
static_assert((size_t)MA * D * 2 == SLOTB, "slot size");
constexpr size_t WS_CTL = 0, CTL_ZERO_BYTES = 1 * MiB;
constexpr size_t WS_ROWSTAT = 1 * MiB;
constexpr size_t WS_SCANSUM = 1 * MiB + 320 * 1024;
constexpr size_t WS_LRUWT = 4 * MiB - 512 * 1024;
constexpr size_t WS_S0 = 26 * MiB;
#define WS_SLOT(i) (WS_S0 + (size_t)(i) * SLOTB)
constexpr size_t WS_XN = WS_SLOT(0), WS_XR = WS_SLOT(1), WS_YG = WS_SLOT(2), WS_Q = WS_SLOT(3), WS_K = WS_SLOT(4), WS_V = WS_SLOT(5), WS_GR = WS_SLOT(6), WS_GA = WS_SLOT(7),
                 WS_REC = WS_SLOT(8), WS_O0 = WS_SLOT(9), WS_O1 = WS_SLOT(10), WS_ATT = WS_SLOT(11);
constexpr size_t WS_T1 = WS_SLOT(0), WS_U = WS_SLOT(1), WS_Z = WS_SLOT(2)  , WS_LOGITS = WS_SLOT(5);
constexpr size_t WS_LIST = 262 * MiB;
constexpr size_t WS_WGU = 4 * MiB;
constexpr size_t WS_WD = 596 * MiB;
constexpr size_t WS_ACT = 725 * MiB;
constexpr size_t WS_H1B = 905 * MiB;
constexpr size_t WS_TOKSLOT = 973 * MiB;
constexpr size_t WS_TOKW = 975 * MiB + 256 * 1024;
constexpr size_t WS_WIN = 978 * MiB, WS_WR = 992 * MiB, WS_WA = 994 * MiB, WS_WO = 996 * MiB, WS_WROUT = 998 * MiB;
constexpr size_t WS_Y = 4 * MiB;
constexpr size_t WS_END = 1000 * MiB;
constexpr int MAXTILES = 1408;
static_assert(WS_Y + ((size_t)NVALID * 9 + 1) * D * 2 <= WS_WD && WS_WD + (size_t)257 * 1024 * 256 * 2 <= WS_ACT && WS_ACT + (size_t)MAXTILES * 256 * 256 * 2 <= WS_H1B, "moe map");
static_assert(WS_WGU + (size_t)257 * 512 * 1024 * 2 <= WS_LIST && WS_LIST + (size_t)NE * CAP * 4 <= WS_SLOT(4), "moe map 2");
static_assert(WS_SLOT(12) <= WS_H1B && WS_TOKW + (size_t)MA * 16 * 4 <= WS_WIN, "map 3");
constexpr int CW_TMO = 0, CW_CODE = 1;
constexpr int CW_BAR = 4096;
constexpr int CW_CNT = 16384;
constexpr int CW_DIAG = 20480;

constexpr int RING_OFF = 0, RING_BYTES = 131072;
constexpr int LDSCTL_OFF = RING_BYTES, MISC_OFF = LDSCTL_OFF + 320;
constexpr int TT_OFF = LDSCTL_OFF + 1024;
constexpr int UB_OFF = TT_OFF + MAXTILES * 4;
constexpr int LDS_BYTES = 147456;
constexpr int CN_OFF = UB_OFF + 260 * 4, TB_OFF = CN_OFF + 260 * 4;
static_assert(TB_OFF + 260 * 4 <= LDS_BYTES, "LDS map");

#define GAS __attribute__((address_space(1)))
#define LAS __attribute__((address_space(3)))
typedef unsigned short bf16;
typedef unsigned v4u __attribute__((ext_vector_type(4)));
typedef float f32x4 __attribute__((ext_vector_type(4)));
typedef short bf16x8 __attribute__((ext_vector_type(8)));
typedef GAS unsigned gu32;
typedef GAS unsigned long long gu64;
#define RLX_AGENT __ATOMIC_RELAXED, __HIP_MEMORY_SCOPE_AGENT
#define LDS_WAIT() asm volatile("s_waitcnt lgkmcnt(0)" ::: "memory")
#define VM_WAIT() asm volatile("s_waitcnt vmcnt(0)" ::: "memory")
__device__ __forceinline__ unsigned long long rt() { return __builtin_amdgcn_s_memrealtime(); }
__device__ __forceinline__ unsigned f2bf(float f) { unsigned u = __builtin_bit_cast(unsigned, f); return (u + 0x7fffu + ((u >> 16) & 1u)) >> 16; }
__device__ __forceinline__ unsigned pk2(float lo, float hi) { return f2bf(lo) | (f2bf(hi) << 16); }

#define XB_TMO      128
#define XB_XCNT(j)  (256  + 64 * (j))
#define XB_XSUB(j)  (1280 + 64 * (j))
#define XB_XGEN(j)  (2304 + 64 * (j))
#define XB_TOP      3328
#define XB_TOPGEN   3392
#define XCD_BAR_WORDS 3456
#define XB_SPIN_CAP (1u << 18)

__device__ __forceinline__ unsigned xb_ld(unsigned* p)              { return __hip_atomic_load(p, __ATOMIC_RELAXED, __HIP_MEMORY_SCOPE_AGENT); }
__device__ __forceinline__ unsigned xb_add(unsigned* p, unsigned v) { return __hip_atomic_fetch_add(p, v, __ATOMIC_RELAXED, __HIP_MEMORY_SCOPE_AGENT); }
__device__ __forceinline__ unsigned xb_xcc_id() { return (unsigned)__builtin_amdgcn_s_getreg((3 << 11) | 20) & 0xFu; }
#define XB_SPIN(cond, bar) do { unsigned _sp = 0; while (cond) { __builtin_amdgcn_s_sleep(1); \
    if ((++_sp & 255u) == 0u) { if (xb_ld(&(bar)[XB_TMO])) break; if (_sp > XB_SPIN_CAP) { atomicAdd(&(bar)[XB_TMO], 1u); break; } } } } while (0)

struct XcdBarrier {
    unsigned* bar; unsigned x;
    volatile LAS unsigned* st;
};

__device__ __forceinline__ XcdBarrier xcd_barrier_post(unsigned* bar, volatile LAS unsigned* st) {
    XcdBarrier b; b.bar = bar; b.x = xb_xcc_id(); b.st = st;
    if (threadIdx.x == 0) (void)xb_add(&bar[XB_XCNT(b.x)], 1u);
    return b;
}
__device__ __forceinline__ void xcd_barrier_complete(unsigned* bar, unsigned x, unsigned& nloc, unsigned& nx) {
    const unsigned G = gridDim.x * gridDim.y * gridDim.z;
    unsigned sum, cnt, mine, sp = 0u;
    for (;;) {
        sum = 0u; cnt = 0u; mine = 0u;
#pragma unroll
        for (unsigned j = 0; j < 16; ++j) { const unsigned c = xb_ld(&bar[XB_XCNT(j)]); sum += c; cnt += (c > 0u) ? 1u : 0u; mine = (j == x) ? c : mine; }
        if (sum == G) break;
        __builtin_amdgcn_s_sleep(1);
        if ((++sp & 255u) == 0u) { if (xb_ld(&bar[XB_TMO])) break; if (sp > XB_SPIN_CAP) { atomicAdd(&bar[XB_TMO], 1u); break; } }
    }
    nloc = mine > 0u ? mine : 1u; nx = cnt > 0u ? cnt : 1u;
}

__device__ __forceinline__ void xcd_barrier(const XcdBarrier& b) {
    asm volatile("s_waitcnt vmcnt(0)" ::: "memory");
    __syncthreads();
    if (threadIdx.x == 0) {
        unsigned* bar = b.bar;
        __builtin_amdgcn_s_waitcnt(0);
        unsigned nloc = b.st[0], nx = b.st[1];
        if (nloc == 0u) { xcd_barrier_complete(bar, b.x, nloc, nx); b.st[0] = nloc; b.st[1] = nx; }
        const unsigned old = xb_add(&bar[XB_XSUB(b.x)], 1u);
        const unsigned gen = old / nloc;
        if (old + 1u == (gen + 1u) * nloc) {
            __builtin_amdgcn_fence(__ATOMIC_RELEASE, "agent");
            asm volatile("s_waitcnt vmcnt(0)" ::: "memory");
            const unsigned og = xb_add(&bar[XB_TOP], 1u);
            const unsigned tg = og / nx;
            if (og + 1u == (tg + 1u) * nx) xb_add(&bar[XB_TOPGEN], 1u);
            else XB_SPIN(xb_ld(&bar[XB_TOPGEN]) == tg, bar);
            __builtin_amdgcn_fence(__ATOMIC_ACQUIRE, "agent");
            xb_add(&bar[XB_XGEN(b.x)], 1u);
            asm volatile("s_waitcnt vmcnt(0)" ::: "memory");
        } else {
            XB_SPIN(xb_ld(&bar[XB_XGEN(b.x)]) == gen, bar);
            __builtin_amdgcn_fence(__ATOMIC_ACQUIRE, "agent");
            asm volatile("s_waitcnt vmcnt(0)" ::: "memory");
        }
    }
    __syncthreads();
}


__device__ __forceinline__ float wave_sum(float v) {
#pragma unroll
    for (int o = 1; o < 64; o <<= 1) v += __shfl_xor(v, o);
    return v;
}
__device__ __forceinline__ float bfl(unsigned w) { return __builtin_bit_cast(float, w << 16); }
__device__ __forceinline__ float bfh(unsigned w) { return __builtin_bit_cast(float, w & 0xffff0000u); }
__device__ __forceinline__ float bf1(bf16 h) { return __builtin_bit_cast(float, (unsigned)h << 16); }

struct DenseOrder {
    int nM, nN, nwg, G, c, valid;
    __device__ void init(int M, int N, int G_, int c_, int valid_ = 0) { nM = M / 256; nN = N / 256; nwg = nM * nN; G = G_; c = c_; valid = valid_; }
    __device__ bool next(int i, pg8::Unit& u) const {
        const long L = (long)i * G + c; if (L >= nwg) return false;
        int wgid = (int)L; { const int q = nwg / 8, r = nwg % 8, xcd = wgid % 8, off = wgid / 8; wgid = (xcd < r ? xcd * (q + 1) : r * (q + 1) + (xcd - r) * q) + off; }
        const int WGM = 8; const int nig = WGM * nN, gid = wgid / nig, fm = gid * WGM, gsz = (nM - fm) < WGM ? (nM - fm) : WGM;
        u.pm = fm + ((wgid % nig) % gsz); u.pn = (wgid % nig) / gsz; u.e = 0; u.mt = 0; u.nv = 256; u.aux = 0;
        u.ar = valid ? (u.pm >> 4) * TA + NMETA + (u.pm & 15) * 256 : u.pm * 256; return true;
    }
    __device__ __forceinline__ int row_of(const pg8::Unit&, int) const { return 0; }
    __device__ __forceinline__ void a_ready(const pg8::Unit&) const {}
    __device__ __forceinline__ void done(const pg8::Unit&) const {}
};
template <int NPN> struct MoeOrder {
    int ntiles, G, vcu; volatile LAS unsigned* TT; volatile LAS int* UB; volatile LAS int* CN; const int* list; int* tokslot; int write_slots;
    __device__ bool next(int i, pg8::Unit& u) const {
        const long L = (long)i * G + vcu; if (L >= (long)ntiles * NPN) return false;
        const int tile = (int)(L / NPN); u.pn = (int)(L % NPN); u.pm = tile;
        const unsigned tt = __builtin_amdgcn_readfirstlane(TT[tile]); u.e = (int)(tt & 0xffffu); u.mt = (int)(tt >> 16);
        const int ce = __builtin_amdgcn_readfirstlane(CN[u.e]);
        const int rem = ce - u.mt * 256; u.nv = rem < 256 ? rem : 256;
        u.aux = __builtin_amdgcn_readfirstlane(UB[u.e]) + u.mt * 256; u.ar = tile * 256; return true;
    }
    __device__ __forceinline__ int row_of(const pg8::Unit& u, int r) const {
        if (u.e == NE) return u.mt * 256 + r;
        return (r < u.nv) ? (list[(size_t)u.e * CAP + u.mt * 256 + r] >> 4) : 0;
    }
    __device__ __forceinline__ void a_ready(const pg8::Unit&) const {}
    __device__ __forceinline__ void done(const pg8::Unit& u) const {
        if (write_slots && u.pn == 0 && u.e < NE) { const int r = threadIdx.x; if (r < u.nv) { const int en = list[(size_t)u.e * CAP + u.mt * 256 + r]; tokslot[(size_t)(en >> 4) * 16 + (en & 15)] = u.aux + r; } }
    }
};

using pg8::u32x4;
typedef unsigned u32x2v __attribute__((ext_vector_type(2)));
typedef float f32x2v __attribute__((ext_vector_type(2)));
struct EpiIn {
    static constexpr bool PERM = true;
    bf16* base0; const float* b_gate; float qscale;
    __device__ __forceinline__ void operator()(const f32x4 (&acc)[2][2][4][2], const pg8::Unit& u, int wr, int wc, int fr, int fq) const {
        const int colt = u.pn * 256, t = colt >> 10, colw = colt & 1023;
        bf16* base = base0 + (size_t)t * (SLOTB / 2);
        const int row0 = u.pm * 256 + wr * 64 + fr, col0 = colw + wc * 32 + 8 * fq;
        f32x4 bv[2][2];
#pragma unroll
        for (int bj = 0; bj < 2; ++bj)
#pragma unroll
            for (int n = 0; n < 2; ++n) bv[bj][n] = (t >= 5) ? *(const f32x4*)(b_gate + (t - 5) * 1024 + col0 + bj * 128 + 4 * n) : (f32x4){0.f, 0.f, 0.f, 0.f};
#pragma unroll
        for (int ai = 0; ai < 2; ++ai)
#pragma unroll
            for (int m = 0; m < 4; ++m) { bf16* rowp = base + (size_t)(row0 + ai * 128 + m * 16) * D + col0;
#pragma unroll
                for (int bj = 0; bj < 2; ++bj) { f32x4 v0 = acc[ai][bj][m][0], v1 = acc[ai][bj][m][1];
                    if (t == 1) {
#pragma unroll
                        for (int j = 0; j < 4; ++j) { v0[j] = pg8::gelu_tanh(v0[j]); v1[j] = pg8::gelu_tanh(v1[j]); }
                    } else if (t == 2) { v0 = v0 * qscale; v1 = v1 * qscale; }
                    else if (t >= 5) { v0 = v0 + bv[bj][0]; v1 = v1 + bv[bj][1];
#pragma unroll
                        for (int j = 0; j < 4; ++j) { v0[j] = pg8::fast_sigmoid(v0[j]); v1[j] = pg8::fast_sigmoid(v1[j]); } }
                    u32x4 w; w.x = pg8::cvt_pk_bf16(v0[0], v0[1]); w.y = pg8::cvt_pk_bf16(v0[2], v0[3]); w.z = pg8::cvt_pk_bf16(v1[0], v1[1]); w.w = pg8::cvt_pk_bf16(v1[2], v1[3]);
                    *(u32x4*)(rowp + bj * 128) = w; } }
    }
};
struct EpiGate {
    static constexpr bool PERM = true;
    const bf16* gate; const bf16* add; bf16* out;
    __device__ __forceinline__ void operator()(const f32x4 (&acc)[2][2][4][2], const pg8::Unit& u, int wr, int wc, int fr, int fq) const {
        const int rl = wr * 64 + fr, col0 = u.pn * 256 + wc * 32 + 8 * fq;
#pragma unroll
        for (int ai = 0; ai < 2; ++ai)
#pragma unroll
            for (int m = 0; m < 4; ++m) { const int r = rl + ai * 128 + m * 16; const size_t off = (size_t)(u.pm * 256 + r) * D + col0, goff = (size_t)(u.ar + r) * D + col0;
#pragma unroll
                for (int bj = 0; bj < 2; ++bj) { const f32x4 a0 = acc[ai][bj][m][0], a1 = acc[ai][bj][m][1];
                    const u32x4 gw = *(const u32x4*)(gate + goff + bj * 128);
                    u32x4 aw = (u32x4){0u, 0u, 0u, 0u}; if (add) aw = *(const u32x4*)(add + off + bj * 128);
                    const float r0 = bfl(aw.x) + bfl(gw.x) * a0[0], r1 = bfh(aw.x) + bfh(gw.x) * a0[1], r2 = bfl(aw.y) + bfl(gw.y) * a0[2], r3 = bfh(aw.y) + bfh(gw.y) * a0[3];
                    const float r4 = bfl(aw.z) + bfl(gw.z) * a1[0], r5 = bfh(aw.z) + bfh(gw.z) * a1[1], r6 = bfl(aw.w) + bfl(gw.w) * a1[2], r7 = bfh(aw.w) + bfh(gw.w) * a1[3];
                    u32x4 w; w.x = pg8::cvt_pk_bf16(r0, r1); w.y = pg8::cvt_pk_bf16(r2, r3); w.z = pg8::cvt_pk_bf16(r4, r5); w.w = pg8::cvt_pk_bf16(r6, r7);
                    *(u32x4*)(out + off + bj * 128) = w; } }
    }
};
struct EpiZ {
    static constexpr bool PERM = false;
    const float* x; const float* g0; const float* b0; const float* rowstat; float* Z;
    __device__ __forceinline__ void operator()(const f32x4 (&acc)[2][2][4][2], const pg8::Unit& u, int wr, int wc, int fr, int fq) const {
        const int col0 = u.pn * 256 + wc * 32 + 4 * fq;
        f32x4 gv[2][2], bv[2][2];
#pragma unroll
        for (int bj = 0; bj < 2; ++bj)
#pragma unroll
            for (int n = 0; n < 2; ++n) { gv[bj][n] = *(const f32x4*)(g0 + col0 + bj * 128 + n * 16); bv[bj][n] = *(const f32x4*)(b0 + col0 + bj * 128 + n * 16); }
#pragma unroll
        for (int ai = 0; ai < 2; ++ai)
#pragma unroll
            for (int m = 0; m < 4; ++m) { const int r = ai * 128 + wr * 64 + m * 16 + fr; const int p = u.pm * 256 + r, rt = (p >> 12) * TA + NMETA + (p & 4095);
                const float* xr = x + (size_t)p * D; const float mean = rowstat[2 * rt], rstd = rowstat[2 * rt + 1];
#pragma unroll
                for (int bj = 0; bj < 2; ++bj)
#pragma unroll
                    for (int n = 0; n < 2; ++n) { const int c = col0 + bj * 128 + n * 16; const f32x4 xv = *(const f32x4*)(xr + c);
                        const f32x4 h0 = (xv - mean) * rstd * gv[bj][n] + bv[bj][n];
                        *(f32x4*)(Z + (size_t)p * D + c) = h0 * ALPHA + acc[ai][bj][m][n]; } }
    }
};
struct EpiF32 {
    static constexpr bool PERM = false;
    float* out; int ldc;
    __device__ __forceinline__ void operator()(const f32x4 (&acc)[2][2][4][2], const pg8::Unit& u, int wr, int wc, int fr, int fq) const {
        const int col0 = u.pn * 256 + wc * 32 + 4 * fq;
#pragma unroll
        for (int ai = 0; ai < 2; ++ai)
#pragma unroll
            for (int m = 0; m < 4; ++m) { const int row = u.pm * 256 + ai * 128 + wr * 64 + m * 16 + fr;
#pragma unroll
                for (int bj = 0; bj < 2; ++bj)
#pragma unroll
                    for (int n = 0; n < 2; ++n) *(f32x4*)(out + (size_t)row * ldc + col0 + bj * 128 + n * 16) = acc[ai][bj][m][n]; }
    }
};
struct EpiAct {
    static constexpr bool PERM = true;
    bf16* act;
    __device__ __forceinline__ void operator()(const f32x4 (&acc)[2][2][4][2], const pg8::Unit& u, int wr, int wc, int fr, int fq) const {
        const int row0 = u.pm * 256 + wr * 64 + fr, col0 = u.pn * 128 + wc * 32 + 8 * fq;
#pragma unroll
        for (int ai = 0; ai < 2; ++ai)
#pragma unroll
            for (int m = 0; m < 4; ++m) { float r[8];
#pragma unroll
                for (int n = 0; n < 2; ++n)
#pragma unroll
                    for (int j = 0; j < 4; ++j) { const float gte = acc[ai][0][m][n][j], up = acc[ai][1][m][n][j]; r[n * 4 + j] = gte * pg8::fast_sigmoid(gte) * up; }
                u32x4 w; w.x = pg8::cvt_pk_bf16(r[0], r[1]); w.y = pg8::cvt_pk_bf16(r[2], r[3]); w.z = pg8::cvt_pk_bf16(r[4], r[5]); w.w = pg8::cvt_pk_bf16(r[6], r[7]);
                *(u32x4*)(act + (size_t)(row0 + ai * 128 + m * 16) * DE + col0) = w; }
    }
};
struct EpiY {
    static constexpr bool PERM = true;
    bf16* Y;
    __device__ __forceinline__ void operator()(const f32x4 (&acc)[2][2][4][2], const pg8::Unit& u, int wr, int wc, int fr, int fq) const {
        const int r0 = wr * 64 + fr, col0 = u.pn * 256 + wc * 32 + 8 * fq;
#pragma unroll
        for (int ai = 0; ai < 2; ++ai)
#pragma unroll
            for (int m = 0; m < 4; ++m) { const int r = r0 + ai * 128 + m * 16; const int yr = (r < u.nv) ? (u.aux + r) : YDUMMY;
                bf16* rowp = Y + (size_t)yr * D + col0;
#pragma unroll
                for (int bj = 0; bj < 2; ++bj) { const f32x4 v0 = acc[ai][bj][m][0], v1 = acc[ai][bj][m][1];
                    u32x4 w; w.x = pg8::cvt_pk_bf16(v0[0], v0[1]); w.y = pg8::cvt_pk_bf16(v0[2], v0[3]); w.z = pg8::cvt_pk_bf16(v1[0], v1[1]); w.w = pg8::cvt_pk_bf16(v1[2], v1[3]);
                    *(u32x4*)(rowp + bj * 128) = w; } }
    }
};

__device__ __forceinline__ void transpose_item(const float* W, int K, int N, bf16* WT, int row_base, int gu, LAS float* scr, int item, int lane) {
    const int nblk = N / 32, kb = item / nblk, nb = item % nblk, k0 = 64 * kb, n0 = 32 * nb;
    const int r0 = row_base + (gu ? ((n0 >> 7) * 256 + (n0 & 127)) : n0);
#pragma unroll 8
    for (int i = 0; i < 32; ++i) { const int kk = 2 * i + (lane >> 5); scr[kk * 33 + (lane & 31)] = W[(size_t)(k0 + kk) * N + n0 + (lane & 31)]; }
    LDS_WAIT(); asm volatile("" ::: "memory");
    const int c = lane & 7;
#pragma unroll
    for (int j = 0; j < 4; ++j) { const int n = (lane >> 3) + 8 * j; const LAS float* s = scr + (8 * c) * 33 + n;
        v4u o; o.x = pk2(s[0 * 33], s[1 * 33]); o.y = pk2(s[2 * 33], s[3 * 33]); o.z = pk2(s[4 * 33], s[5 * 33]); o.w = pk2(s[6 * 33], s[7 * 33]);
        *(GAS v4u*)(WT + (size_t)(r0 + n) * K + k0 + 8 * c) = o; }
    LDS_WAIT(); asm volatile("" ::: "memory");
}
__device__ __forceinline__ void ln_row_to_bf16(const float* xrow, const float* g, const float* b, bf16* orow, float* stat, int lane) {
    const GAS f32x4* xr = (const GAS f32x4*)xrow + lane;
    f32x4 v[4]; float s = 0.f;
#pragma unroll
    for (int j = 0; j < 4; ++j) { v[j] = xr[64 * j]; s += (v[j].x + v[j].y) + (v[j].z + v[j].w); }
    const float mean = wave_sum(s) * (1.f / D); float s2 = 0.f;
#pragma unroll
    for (int j = 0; j < 4; ++j) { v[j] = v[j] - mean; s2 += (v[j].x * v[j].x + v[j].y * v[j].y) + (v[j].z * v[j].z + v[j].w * v[j].w); }
    const float rstd = 1.f / sqrtf(wave_sum(s2) * (1.f / D) + LN_EPS);
    if (stat && lane == 0) { stat[0] = mean; stat[1] = rstd; }
    GAS unsigned long long* o8 = (GAS unsigned long long*)orow + lane;
#pragma unroll
    for (int j = 0; j < 4; ++j) { const f32x4 gg = *((const f32x4*)g + lane + 64 * j), bb = *((const f32x4*)b + lane + 64 * j); const f32x4 y = v[j] * rstd * gg + bb;
        o8[64 * j] = (unsigned long long)pk2(y.x, y.y) | ((unsigned long long)pk2(y.z, y.w) << 32); }
}

__device__ __forceinline__ int crow16(int r, int hi) { return (r & 3) + 8 * (r >> 2) + 4 * hi; }
typedef float f32x16 __attribute__((ext_vector_type(16)));
struct ScanArgs { const bf16* XR; const bf16* YG; bf16* REC; const float* conv_w; const float* conv_b; const bf16* lruwt; const float* b_a; const float* b_i; const float* lam; float* scansum; };
template <bool FINAL>
__device__ __forceinline__ void scan_item(const ScanArgs& A, LAS unsigned char* lds, int b, int nb, int ck) {
    const int tid = threadIdx.x, lane = tid & 63, wid = __builtin_amdgcn_readfirstlane(tid >> 6);
    constexpr int XP = 136;
    LAS bf16* XCB = (LAS bf16*)lds;
    LAS float* COMP = (LAS float*)(lds + 36864);
    LAS float* HIN = (LAS float*)(lds + 36864 + 32768);
    LAS bf16* YGL = (LAS bf16*)(lds + 86016);
    LAS float* CW = (LAS float*)(lds + 120832);
    LAS float* PART = (LAS float*)(lds + 123392);
    const int t0 = ck * 128; const size_t rowb = (size_t)b * TA;
    const int r = tid >> 2, cq = tid & 3;
    v4u xv[4][4]; v4u yv[4];
#pragma unroll
    for (int j = 0; j < 4; ++j) { const int C = nb * 128 + cq * 32 + j * 8;
#pragma unroll
        for (int k = 0; k < 4; ++k) { int tt = t0 + r - 3 + k; tt = tt < 0 ? 0 : tt; xv[j][k] = *(const v4u*)(A.XR + (rowb + tt) * D + C); }
        if (FINAL) yv[j] = *(const v4u*)(A.YG + (rowb + t0 + r) * D + C); }
    if (tid < 160) { const int k = tid >> 5, c4 = (tid & 31) * 4; const f32x4 w = (k < 4) ? *(const f32x4*)(A.conv_w + k * D + nb * 128 + c4) : *(const f32x4*)(A.conv_b + nb * 128 + c4); *(LAS f32x4*)(CW + k * 128 + c4) = w; }
    if (FINAL) {
        const int q = tid >> 7, c = tid & 127, C = nb * 128 + c; float sa[8], sh[8];
#pragma unroll
        for (int i = 0; i < 8; ++i) { const int j = 8 * q + i; const int jc = j < ck ? j : 0; const f32x2v s = *(const f32x2v*)(A.scansum + ((size_t)(b * NCHUNK + jc) * D + C) * 2); sa[i] = j < ck ? s.x : 1.0f; sh[i] = j < ck ? s.y : 0.0f; }
        float Aq = 1.f, Hq = 0.f;
#pragma unroll
        for (int i = 0; i < 8; ++i) { Hq = sa[i] * Hq + sh[i]; Aq *= sa[i]; }
        PART[(q * 128 + c) * 2] = Aq; PART[(q * 128 + c) * 2 + 1] = Hq;
    }
    __syncthreads();
#pragma unroll
    for (int j = 0; j < 4; ++j) { const int c = cq * 32 + j * 8;
        float o[8];
        { const f32x4 cb0 = *(const LAS f32x4*)(CW + 4 * 128 + c), cb1 = *(const LAS f32x4*)(CW + 4 * 128 + c + 4); o[0] = cb0.x; o[1] = cb0.y; o[2] = cb0.z; o[3] = cb0.w; o[4] = cb1.x; o[5] = cb1.y; o[6] = cb1.z; o[7] = cb1.w; }
#pragma unroll
        for (int k = 0; k < 4; ++k) { const float ok = (t0 + r - 3 + k >= 0) ? 1.0f : 0.0f; const v4u x4 = xv[j][k];
            const f32x4 w0 = *(const LAS f32x4*)(CW + k * 128 + c) * ok, w1 = *(const LAS f32x4*)(CW + k * 128 + c + 4) * ok;
            o[0] += w0.x * bfl(x4.x); o[1] += w0.y * bfh(x4.x); o[2] += w0.z * bfl(x4.y); o[3] += w0.w * bfh(x4.y);
            o[4] += w1.x * bfl(x4.z); o[5] += w1.y * bfh(x4.z); o[6] += w1.z * bfl(x4.w); o[7] += w1.w * bfh(x4.w); }
        v4u w; w.x = pk2(o[0], o[1]); w.y = pk2(o[2], o[3]); w.z = pk2(o[4], o[5]); w.w = pk2(o[6], o[7]);
        *(LAS v4u*)(XCB + r * XP + c) = w;
        if (FINAL) *(LAS v4u*)(YGL + r * XP + c) = yv[j]; }
    __syncthreads();
    const int rb = wid >> 1, chh = wid & 1, l31 = lane & 31, hi = lane >> 5;
    f32x16 acc[2][2];
#pragma unroll
    for (int gt = 0; gt < 2; ++gt)
#pragma unroll
        for (int cb = 0; cb < 2; ++cb) acc[gt][cb] = f32x16{};
#pragma unroll
    for (int s = 0; s < 8; ++s) {
        const bf16x8 af = *(const LAS bf16x8*)(XCB + (32 * rb + l31) * XP + 16 * s + 8 * hi);
#pragma unroll
        for (int gt = 0; gt < 2; ++gt)
#pragma unroll
            for (int cb = 0; cb < 2; ++cb) { const bf16x8 bfv = *(const bf16x8*)(A.lruwt + ((size_t)((gt * 8 + nb) * 128 + 64 * chh + 32 * cb + l31)) * 128 + 16 * s + 8 * hi);
                acc[gt][cb] = __builtin_amdgcn_mfma_f32_32x32x16_bf16(af, bfv, acc[gt][cb], 0, 0, 0); }
    }
    float av[2][16], bt[2][16];
#pragma unroll
    for (int cb = 0; cb < 2; ++cb) { const int c = 64 * chh + 32 * cb + l31, C = nb * 128 + c;
        const float ba = A.b_a[C], bi = A.b_i[C], lm = A.lam[C];
        const float sp = (-lm > 20.f) ? -lm : log1pf(__expf(-lm));
        const float k8 = -8.0f * sp * 1.4426950408889634f;
#pragma unroll
        for (int rr = 0; rr < 16; ++rr) { const int row = 32 * rb + crow16(rr, hi);
            const float rg = pg8::fast_sigmoid(acc[0][cb][rr] + ba), ig = pg8::fast_sigmoid(acc[1][cb][rr] + bi);
            const float a = __builtin_amdgcn_exp2f(k8 * rg); float mult = sqrtf(fmaxf(1.0f - a * a, 0.f));
            if (t0 + row == 0) mult = 1.0f;
            const float xc = bf1(XCB[row * XP + c]);
            av[cb][rr] = a; bt[cb][rr] = mult * ig * xc; }
#pragma unroll
        for (int j = 0; j < 4; ++j) { float Ag = av[cb][4 * j], Bg = bt[cb][4 * j];
#pragma unroll
            for (int q = 1; q < 4; ++q) { Bg = av[cb][4 * j + q] * Bg + bt[cb][4 * j + q]; Ag *= av[cb][4 * j + q]; }
            const int G = 8 * rb + 2 * j + hi; COMP[(G * 128 + c) * 2] = Ag; COMP[(G * 128 + c) * 2 + 1] = Bg; }
    }
    __syncthreads();
    if (tid < 128) { const int c = tid, C = nb * 128 + c; float h = 0.f, Ap = 1.f;
        if (FINAL) {
#pragma unroll
            for (int q = 0; q < 4; ++q) h = PART[(q * 128 + c) * 2] * h + PART[(q * 128 + c) * 2 + 1]; }
#pragma unroll 8
        for (int G = 0; G < 32; ++G) { HIN[G * 128 + c] = h; const float Ag = COMP[(G * 128 + c) * 2], Bg = COMP[(G * 128 + c) * 2 + 1]; h = Ag * h + Bg; Ap *= Ag; }
        if (!FINAL) { float* sm = A.scansum + ((size_t)(b * NCHUNK + ck) * D + C) * 2; sm[0] = Ap; sm[1] = h; }
    }
    if (FINAL) {
        __syncthreads();
#pragma unroll
        for (int cb = 0; cb < 2; ++cb) { const int c = 64 * chh + 32 * cb + l31;
#pragma unroll
            for (int j = 0; j < 4; ++j) { float h = HIN[(8 * rb + 2 * j + hi) * 128 + c];
#pragma unroll
                for (int q = 0; q < 4; ++q) { const int rr = 4 * j + q; h = av[cb][rr] * h + bt[cb][rr]; const int idx = (32 * rb + crow16(rr, hi)) * XP + c;
                    YGL[idx] = (bf16)f2bf(h * bf1(YGL[idx])); } } }
        __syncthreads();
#pragma unroll
        for (int j = 0; j < 4; ++j) { const int c = cq * 32 + j * 8; *(v4u*)(A.REC + (rowb + t0 + r) * D + nb * 128 + c) = *(const LAS v4u*)(YGL + r * XP + c); }
    }
    __syncthreads();
}

__device__ __forceinline__ void route_token(const float* logits, const float* rbias, int row, unsigned* cnt, int* list, float* tokw, int lane) {
    const f32x4 lg = *((const f32x4*)(logits + (size_t)row * NE) + lane); const f32x4 rb = *((const f32x4*)rbias + lane);
    float sc[4], sel[4];
#pragma unroll
    for (int j = 0; j < 4; ++j) { sc[j] = 1.0f / (1.0f + expf(-lg[j])); sel[j] = sc[j] + rb[j]; }
    float m1 = fmaxf(sel[0], sel[1]), m2 = fminf(sel[0], sel[1]);
#pragma unroll
    for (int j = 2; j < 4; ++j) { const float v = sel[j]; m2 = fmaxf(m2, fminf(m1, v)); m1 = fmaxf(m1, v); }
#pragma unroll
    for (int o = 1; o < 8; o <<= 1) { const float o1 = __shfl_xor(m1, o), o2 = __shfl_xor(m2, o); m2 = fmaxf(fminf(m1, o1), fmaxf(m2, o2)); m1 = fmaxf(m1, o1); }
    const float gs = m1 + m2; const int g = lane >> 3; int rank = 0;
#pragma unroll
    for (int gg = 0; gg < 8; ++gg) { const float og = __shfl(gs, gg * 8); rank += (og > gs || (og == gs && gg < g)) ? 1 : 0; }
    const bool gsel = rank < 4;
#pragma unroll
    for (int j = 0; j < 4; ++j) if (!gsel) sel[j] = -INFINITY;
    float wk = 0.f; int ek = 0; float ssum = 0.f;
#pragma unroll 1
    for (int k = 0; k < TOPK; ++k) {
        float bv = sel[0]; int bi = 4 * lane;
#pragma unroll
        for (int j = 1; j < 4; ++j) if (sel[j] > bv) { bv = sel[j]; bi = 4 * lane + j; }
#pragma unroll
        for (int o = 1; o < 64; o <<= 1) { const float ov = __shfl_xor(bv, o); const int oi = __shfl_xor(bi, o); if (ov > bv || (ov == bv && oi < bi)) { bv = ov; bi = oi; } }
        const int own = bi >> 2, jj = bi & 3;
        float s = 0.f;
        if (lane == own) {
#pragma unroll
            for (int j = 0; j < 4; ++j) if (j == jj) { s = sc[j]; sel[j] = -INFINITY; } }
        s = __shfl(s, own);
        ssum += s; if (lane == k) { wk = s; ek = bi; }
    }
    if (lane < TOPK) { const float w = wk / ssum * ROUTED_SCALE; const unsigned pos = atomicAdd(cnt + ek, 1u); if (pos < (unsigned)CAP) list[(size_t)ek * CAP + pos] = (row << 4) | lane; tokw[(size_t)row * 16 + lane] = w; }
}

struct Args { const float* in[33]; float* out; unsigned char* ws; int ph_lo, ph_hi, li, pad; };
__global__ void __launch_bounds__(NWAVES * 64, 2) mega_fwd(Args args) {
    extern __shared__ __attribute__((aligned(16))) unsigned char lds[];
    LAS unsigned char* L = (LAS unsigned char*)lds;
    volatile LAS unsigned* MISC = (volatile LAS unsigned*)(L + MISC_OFF);
    const int tid = threadIdx.x, lane = tid & 63, wave = __builtin_amdgcn_readfirstlane(tid >> 6);
    const int G = gridDim.x; const int bx = blockIdx.x; const int vcu = (G % 8 == 0) ? (bx % 8) * (G / 8) + bx / 8 : bx;
    unsigned char* ws = args.ws;
    gu32* ctl = (gu32*)(ws + WS_CTL);
    for (int u = tid; u < (LDS_BYTES - LDSCTL_OFF) / 4; u += NWAVES * 64) ((LAS unsigned*)(L + LDSCTL_OFF))[u] = 0u;
    __syncthreads();
    XcdBarrier bar; bar.bar = (unsigned*)(ctl + CW_BAR); bar.x = 0; bar.st = nullptr;
    if (N_LAUNCHES == 1) bar = xcd_barrier_post((unsigned*)(ctl + CW_BAR), MISC + 8);
#define GRID_BAR() do { if (N_LAUNCHES == 1) xcd_barrier(bar); } while (0)
#if MK_DIAG
    int n_stamp = 0;
#define STAMP() do { if (blockIdx.x == 0 && tid == 0) { ((unsigned long long*)(ctl + CW_DIAG))[n_stamp] = __builtin_amdgcn_s_memrealtime(); } ++n_stamp; } while (0)
#else
#define STAMP() do {} while (0)
#endif
    STAMP();
    const int lo = args.ph_lo, hi = args.ph_hi;
#ifndef MK_REPEAT_MASK
#define MK_REPEAT_MASK 0
#endif
#ifndef MK_PHASE_MASK
#define MK_PHASE_MASK 0xffff
#endif
#define IN(k) ((((MK_PHASE_MASK) >> (k)) & 1) && lo <= (k) && (k) < hi)
#define BOTH(k) (IN(k) && IN((k) + 1))
    const int gw = vcu * NWAVES + wave, NGW = G * NWAVES;
    const float* x = args.in[0]; const float* meta = args.in[1];

    if (IN(0)) {
        LAS float* scr = (LAS float*)(L + RING_OFF + wave * 16384);
        constexpr int I_IN = 16 * (NIN / 32), I_SQ = 16 * 32, I_RT = 16 * 8, I_LRU = 2 * 8 * 2 * 4;
        constexpr int NITEMS = I_IN + 3 * I_SQ + I_RT + I_LRU;
        for (int it = gw; it < NITEMS; it += NGW) {
            int r = it;
            if (r < I_IN) { transpose_item(args.in[4], D, NIN, (bf16*)(ws + WS_WIN), 0, 0, scr, r, lane); continue; } r -= I_IN;
            if (r < I_SQ) { transpose_item(args.in[18], D, D, (bf16*)(ws + WS_WR), 0, 0, scr, r, lane); continue; } r -= I_SQ;
            if (r < I_SQ) { transpose_item(args.in[19], D, D, (bf16*)(ws + WS_WA), 0, 0, scr, r, lane); continue; } r -= I_SQ;
            if (r < I_SQ) { transpose_item(args.in[20], D, D, (bf16*)(ws + WS_WO), 0, 0, scr, r, lane); continue; } r -= I_SQ;
            if (r < I_RT) { transpose_item(args.in[23], D, NE, (bf16*)(ws + WS_WROUT), 0, 0, scr, r, lane); continue; } r -= I_RT;
            { const int m = r >> 3, it2 = r & 7, gt = m >> 3, blk = m & 7;
              transpose_item(args.in[gt ? 10 : 8] + (size_t)blk * 128 * 128, 128, 128, (bf16*)(ws + WS_LRUWT) + (size_t)(gt * 8 + blk) * 128 * 128, 0, 0, scr, it2, lane); }
        }
        for (int m = gw; m < MA; m += NGW) { const int b = m / TA, t = m - b * TA; bf16* orow = (bf16*)(ws + WS_XN) + (size_t)m * D;
            if (t < TV) { const float* xr = (t < NMETA) ? meta + (size_t)t * D : x + ((size_t)b * SEQ + (t - NMETA)) * D;
                ln_row_to_bf16(xr, args.in[2], args.in[3], orow, (float*)(ws + WS_ROWSTAT) + 2 * (size_t)m, lane); }
            else { GAS unsigned long long* o8 = (GAS unsigned long long*)orow + lane;
#pragma unroll
                for (int j = 0; j < 4; ++j) o8[64 * j] = 0ull; } }
        if (BOTH(0)) GRID_BAR();
        STAMP();
    }
    if (IN(1)) {
        pg8::Gemm g{(const bf16*)(ws + WS_XN), (const bf16*)(ws + WS_WIN), D, 0}; DenseOrder S; S.init(MA, NIN, G, bx);
        EpiIn E{(bf16*)(ws + WS_XR), args.in[5], 0.125f * 1.4426950408889634f};
        pg8::gemm_phase<EpiIn, DenseOrder, true, false>(L + RING_OFF, g, S, E);
        if (BOTH(1)) GRID_BAR();
        STAMP();
    }
    ScanArgs SA{(const bf16*)(ws + WS_XR), (const bf16*)(ws + WS_YG), (bf16*)(ws + WS_REC), args.in[6], args.in[7], (const bf16*)(ws + WS_LRUWT), args.in[9], args.in[11], args.in[12], (float*)(ws + WS_SCANSUM)};
    if (IN(2)) {
        for (int it = vcu; it < NB * 8 * NCHUNK; it += G) { const int ck = it % NCHUNK, bn = it / NCHUNK; scan_item<false>(SA, L + RING_OFF, bn >> 3, bn & 7, ck); }
        if (BOTH(2)) GRID_BAR();
        STAMP();
    }
    if (IN(3)) {
        for (int it = vcu; it < NB * 8 * NCHUNK; it += G) { const int ck = it % NCHUNK, bn = it / NCHUNK; scan_item<true>(SA, L + RING_OFF, bn >> 3, bn & 7, ck); }
        { const int bh = vcu >> 2, sub = vcu & 3, m = sub >> 1, half = sub & 1, b = bh >> 3, h = bh & 7;
          if (bh < NB * 8) {
              const attn_body::AttnTensors AT{(const attn_body::bf16*)(ws + WS_Q), (const attn_body::bf16*)(ws + WS_K), (const attn_body::bf16*)(ws + WS_V), (attn_body::bf16*)(ws + (m ? WS_O1 : WS_O0))};
              const attn_body::FixedOrder AS{b, 2 * h + m, 2 * h + half};
              attn_body::attn_phase<attn_body::FixedOrder>((char*)lds + RING_OFF, AT, AS);
          } }
        if (BOTH(3)) GRID_BAR();
        STAMP();
    }
    if (IN(4)) {
        const float lamq = wave_sum(args.in[13][lane] * args.in[14][lane]), lamq2 = wave_sum(args.in[15][lane] * args.in[16][lane]);
        const float lam = expf(lamq) - expf(lamq2) + LAMBDA_INIT;
        const bf16* O0 = (const bf16*)(ws + WS_O0); const bf16* O1 = (const bf16*)(ws + WS_O1); bf16* ATT = (bf16*)(ws + WS_ATT);
        for (int m = gw; m < MA; m += NGW) {
#pragma unroll
            for (int j = 0; j < 2; ++j) { const int c = j * 512 + lane * 8; const v4u a = *(const v4u*)(O0 + (size_t)m * D + c), bq = *(const v4u*)(O1 + (size_t)m * D + c);
                float d[8]; d[0] = bfl(a.x) - lam * bfl(bq.x); d[1] = bfh(a.x) - lam * bfh(bq.x); d[2] = bfl(a.y) - lam * bfl(bq.y); d[3] = bfh(a.y) - lam * bfh(bq.y);
                d[4] = bfl(a.z) - lam * bfl(bq.z); d[5] = bfh(a.z) - lam * bfh(bq.z); d[6] = bfl(a.w) - lam * bfl(bq.w); d[7] = bfh(a.w) - lam * bfh(bq.w);
                float ss = 0.f;
#pragma unroll
                for (int q = 0; q < 8; ++q) ss += d[q] * d[q];
                ss += __shfl_xor(ss, 1); ss += __shfl_xor(ss, 2); ss += __shfl_xor(ss, 4); ss += __shfl_xor(ss, 8);
                const float rs = (1.0f - LAMBDA_INIT) / sqrtf(ss * (1.0f / 128.f) + LN_EPS);
                const int e0 = c & 127; const f32x4 g0 = *(const f32x4*)(args.in[17] + e0), g1 = *(const f32x4*)(args.in[17] + e0 + 4);
                v4u w; w.x = pk2(d[0] * rs * g0.x, d[1] * rs * g0.y); w.y = pk2(d[2] * rs * g0.z, d[3] * rs * g0.w); w.z = pk2(d[4] * rs * g1.x, d[5] * rs * g1.y); w.w = pk2(d[6] * rs * g1.z, d[7] * rs * g1.w);
                *(v4u*)(ATT + (size_t)m * D + c) = w; } }
        if (BOTH(4)) GRID_BAR();
        STAMP();
    }
    if (IN(5)) {
        pg8::Gemm g{(const bf16*)(ws + WS_REC), (const bf16*)(ws + WS_WR), D, 0}; DenseOrder S; S.init(NVALID, D, G, bx, 1);
        EpiGate E{(const bf16*)(ws + WS_GR), nullptr, (bf16*)(ws + WS_T1)};
        pg8::gemm_phase<EpiGate, DenseOrder, true, false>(L + RING_OFF, g, S, E);
        if (BOTH(5)) GRID_BAR();
        STAMP();
    }
    if (IN(6)) {
        pg8::Gemm g{(const bf16*)(ws + WS_ATT), (const bf16*)(ws + WS_WA), D, 0}; DenseOrder S; S.init(NVALID, D, G, bx, 1);
        EpiGate E{(const bf16*)(ws + WS_GA), (const bf16*)(ws + WS_T1), (bf16*)(ws + WS_U)};
        pg8::gemm_phase<EpiGate, DenseOrder, true, false>(L + RING_OFF, g, S, E);
        if (BOTH(6)) GRID_BAR();
        STAMP();
    }
    if (IN(7)) {
        pg8::Gemm g{(const bf16*)(ws + WS_U), (const bf16*)(ws + WS_WO), D, 0}; DenseOrder S; S.init(NVALID, D, G, bx, 0);
        EpiZ E{x, args.in[2], args.in[3], (const float*)(ws + WS_ROWSTAT), (float*)(ws + WS_Z)};
        pg8::gemm_phase<EpiZ, DenseOrder, true, false>(L + RING_OFF, g, S, E);
        if (BOTH(7)) GRID_BAR();
        STAMP();
    }
    if (IN(8)) {
        for (int m = gw; m < NVALID; m += NGW) ln_row_to_bf16((const float*)(ws + WS_Z) + (size_t)m * D, args.in[21], args.in[22], (bf16*)(ws + WS_H1B) + (size_t)m * D, nullptr, lane);
        if (BOTH(8)) GRID_BAR();
        STAMP();
    }
    if (IN(9)) {
        { pg8::Gemm g{(const bf16*)(ws + WS_H1B), (const bf16*)(ws + WS_WROUT), D, 0}; DenseOrder S; S.init(NVALID, NE, G, bx, 0);
          EpiF32 E{(float*)(ws + WS_LOGITS), NE};
          pg8::gemm_phase<EpiF32, DenseOrder, false, false>(L + RING_OFF, g, S, E); }
        LAS float* scr = (LAS float*)(L + RING_OFF + wave * 16384);
        constexpr int IPE = 128;
        for (int it = gw; it < 257 * 3 * IPE; it += NGW) { const int e = it / (3 * IPE), r = it - e * 3 * IPE, which = r / IPE, i2 = r - which * IPE;
            if (which < 2) { const float* W = (e < NE) ? args.in[25 + which] + (size_t)e * D * DE : args.in[28 + which];
                transpose_item(W, D, DE, (bf16*)(ws + WS_WGU), e * 512 + which * 128, 1, scr, i2, lane); }
            else { const float* W = (e < NE) ? args.in[27] + (size_t)e * DE * D : args.in[30];
                transpose_item(W, DE, D, (bf16*)(ws + WS_WD) + (size_t)e * D * DE, 0, 0, scr, i2, lane); } }
        if (BOTH(9)) GRID_BAR();
        STAMP();
    }
    if (IN(10)) {
        for (int p = gw; p < NVALID; p += NGW) { const int row = p;
            route_token((const float*)(ws + WS_LOGITS), args.in[24], row, (unsigned*)(ctl + CW_CNT), (int*)(ws + WS_LIST), (float*)(ws + WS_TOKW), lane); }
        if (BOTH(10)) GRID_BAR();
        STAMP();
    }
    if (IN(11) || IN(12)) {
        volatile LAS unsigned* TT = (volatile LAS unsigned*)(L + TT_OFF); volatile LAS int* UB = (volatile LAS int*)(L + UB_OFF);
        const unsigned* cnt = (const unsigned*)(ctl + CW_CNT);
        volatile LAS int* CN = (volatile LAS int*)(L + CN_OFF); volatile LAS int* TB = (volatile LAS int*)(L + TB_OFF);
        if (tid <= NE) { int c = (tid == NE) ? NVALID : (int)__hip_atomic_load(cnt + tid, RLX_AGENT); if (c > CAP) c = CAP; CN[tid] = c; }
        __syncthreads();
        if (tid == 0) { int tb = 0, ub = 0;
            for (int e = 0; e <= NE; ++e) { const int c = CN[e]; int ntl = (c + 255) >> 8; if (tb + ntl > MAXTILES) ntl = MAXTILES - tb; UB[e] = ub; TB[e] = tb; ub += c; tb += ntl; }
            TB[NE + 1] = tb; MISC[16] = (unsigned)tb; }
        __syncthreads();
        if (tid <= NE) { const int t0 = TB[tid], t1 = TB[tid + 1]; for (int t = t0; t < t1; ++t) TT[t] = (unsigned)tid | ((unsigned)(t - t0) << 16); }
        __syncthreads();
        const int ntiles = (int)MISC[16];
        if (IN(11)) {
            pg8::Gemm g{(const bf16*)(ws + WS_H1B), (const bf16*)(ws + WS_WGU), D, (size_t)512 * D};
            MoeOrder<2> S{ntiles, G, vcu, TT, UB, CN, (const int*)(ws + WS_LIST), (int*)(ws + WS_TOKSLOT), 1};
            EpiAct E{(bf16*)(ws + WS_ACT)};
            pg8::gemm_phase<EpiAct, MoeOrder<2>, true, true>(L + RING_OFF, g, S, E);
            if (BOTH(11)) GRID_BAR();
            STAMP();
        STAMP();
        }
        if (IN(12)) {
            pg8::Gemm g{(const bf16*)(ws + WS_ACT), (const bf16*)(ws + WS_WD), DE, (size_t)D * DE};
            MoeOrder<4> S{ntiles, G, vcu, TT, UB, CN, (const int*)(ws + WS_LIST), (int*)(ws + WS_TOKSLOT), 0};
            EpiY E{(bf16*)(ws + WS_Y)};
            pg8::gemm_phase<EpiY, MoeOrder<4>, true, false>(L + RING_OFF, g, S, E);
            if (BOTH(12)) GRID_BAR();
            STAMP();
        STAMP();
        }
    }
    if (IN(13)) {
        const bf16* H1 = (const bf16*)(ws + WS_H1B); const bf16* Y = (const bf16*)(ws + WS_Y); const int* tokslot = (const int*)(ws + WS_TOKSLOT); const float* tokw = (const float*)(ws + WS_TOKW);
        unsigned poison = __hip_atomic_load(ctl + CW_BAR + XB_TMO, RLX_AGENT) != 0u;
        for (int p = gw; p < NVALID; p += NGW) { const int row = p;
            float z[2][8];
#pragma unroll
            for (int j = 0; j < 2; ++j) { const int c = j * 512 + lane * 8; const v4u a = *(const v4u*)(H1 + (size_t)row * D + c);
                z[j][0] = ALPHA * bfl(a.x); z[j][1] = ALPHA * bfh(a.x); z[j][2] = ALPHA * bfl(a.y); z[j][3] = ALPHA * bfh(a.y); z[j][4] = ALPHA * bfl(a.z); z[j][5] = ALPHA * bfh(a.z); z[j][6] = ALPHA * bfl(a.w); z[j][7] = ALPHA * bfh(a.w); }
#pragma unroll
            for (int k = 0; k <= TOPK; ++k) { const int yr = (k < TOPK) ? tokslot[(size_t)row * 16 + k] : YSHARED + p; const float w = (k < TOPK) ? tokw[(size_t)row * 16 + k] : 1.0f;
#pragma unroll
                for (int j = 0; j < 2; ++j) { const int c = j * 512 + lane * 8; const v4u a = *(const v4u*)(Y + (size_t)yr * D + c);
                    z[j][0] += w * bfl(a.x); z[j][1] += w * bfh(a.x); z[j][2] += w * bfl(a.y); z[j][3] += w * bfh(a.y); z[j][4] += w * bfl(a.z); z[j][5] += w * bfh(a.z); z[j][6] += w * bfl(a.w); z[j][7] += w * bfh(a.w); } }
            float s = 0.f;
#pragma unroll
            for (int j = 0; j < 2; ++j)
#pragma unroll
                for (int q = 0; q < 8; ++q) s += z[j][q];
            const float mean = wave_sum(s) * (1.f / D); float s2 = 0.f;
#pragma unroll
            for (int j = 0; j < 2; ++j)
#pragma unroll
                for (int q = 0; q < 8; ++q) { z[j][q] -= mean; s2 += z[j][q] * z[j][q]; }
            const float rstd = 1.f / sqrtf(wave_sum(s2) * (1.f / D) + LN_EPS);
            float* orow = args.out + (size_t)p * D;
#pragma unroll
            for (int j = 0; j < 2; ++j) { const int c = j * 512 + lane * 8;
#pragma unroll
                for (int q4 = 0; q4 < 2; ++q4) { const f32x4 gg = *(const f32x4*)(args.in[31] + c + 4 * q4), bb = *(const f32x4*)(args.in[32] + c + 4 * q4);
                    f32x4 o; o.x = z[j][4 * q4] * rstd * gg.x + bb.x; o.y = z[j][4 * q4 + 1] * rstd * gg.y + bb.y; o.z = z[j][4 * q4 + 2] * rstd * gg.z + bb.z; o.w = z[j][4 * q4 + 3] * rstd * gg.w + bb.w;
                    if (poison) o = (f32x4){__builtin_nanf(""), __builtin_nanf(""), __builtin_nanf(""), __builtin_nanf("")};
                    *(f32x4*)(orow + c + 4 * q4) = o; } } }
    }
#if MK_DIAG
    GRID_BAR(); STAMP();
    if (blockIdx.x == 0 && tid == 0) { const unsigned long long* ts = (const unsigned long long*)(ctl + CW_DIAG);
      const unsigned long long a0 = __hip_atomic_load(ts + MK_DIAG_S1, RLX_AGENT), a1 = __hip_atomic_load(ts + MK_DIAG_S1 + 1, RLX_AGENT);
      args.out[0] = 40.0f + (float)(a1 - a0) * 0.01f; }
#endif
#undef IN
#undef BOTH
#undef GRID_BAR
}

extern "C" void kernel_launch(void* const* d_in, const int* in_sizes, int n_in, void* d_out, int out_size, void* d_ws, size_t ws_size, hipStream_t stream) {
    static int grid = 0;
    if (grid == 0) {
        if (n_in != 33 || in_sizes[0] != NB * SEQ * D || out_size != NB * SEQ * D || ws_size < WS_END) { fprintf(stderr, "kernel_launch: unexpected shapes / workspace (n_in %d, in0 %d, out %d, ws %zu < %zu); nothing launched\n", n_in, n_in > 0 ? in_sizes[0] : -1, out_size, ws_size, (size_t)WS_END); grid = -1; return; }
        int dev = 0, cus = 0;
        if (hipGetDevice(&dev) != hipSuccess || hipDeviceGetAttribute(&cus, hipDeviceAttributeMultiprocessorCount, dev) != hipSuccess) { grid = -1; return; }
        if (hipFuncSetAttribute((const void*)mega_fwd, hipFuncAttributeMaxDynamicSharedMemorySize, LDS_BYTES) != hipSuccess) { fprintf(stderr, "kernel_launch: hipFuncSetAttribute failed\n"); grid = -1; return; }
        int per_cu = 0;
        if (hipOccupancyMaxActiveBlocksPerMultiprocessor(&per_cu, (const void*)mega_fwd, NWAVES * 64, LDS_BYTES) != hipSuccess || per_cu < 1) fprintf(stderr, "kernel_launch: occupancy query says %d\n", per_cu);
        (void)hipGetLastError();
        grid = cus;
    }
    if (grid < 0) return;
    if (hipMemsetAsync((char*)d_ws + WS_CTL, 0, CTL_ZERO_BYTES, stream) != hipSuccess) return;
    Args a{};
    for (int i = 0; i < 33; ++i) a.in[i] = (const float*)d_in[i];
    a.out = (float*)d_out; a.ws = (unsigned char*)d_ws;
    if (N_LAUNCHES == 1) { a.ph_lo = 0; a.ph_hi = NPHASE; a.li = 0; hipLaunchKernelGGL(mega_fwd, dim3(grid), dim3(NWAVES * 64), LDS_BYTES, stream, a); }
    else for (int li = 0; li < NPHASE; ++li) { a.ph_lo = li; a.ph_hi = li + 1; a.li = li; for (int rep = 0; rep < (((MK_REPEAT_MASK) >> li) & 1) + 1; ++rep) hipLaunchKernelGGL(mega_fwd, dim3(grid), dim3(NWAVES * 64), LDS_BYTES, stream, a); }
}
```

```cpp
#include <hip/hip_runtime.h>
#include <hip/hip_bf16.h>
#include <cstdio>
#include <cstdint>
#include <cmath>
namespace pg8 {
#define PG8_LAS __attribute__((address_space(3)))
typedef unsigned short bf16_t;
typedef short bf16x8 __attribute__((ext_vector_type(8)));
typedef float f32x4 __attribute__((ext_vector_type(4)));
typedef float f32x2 __attribute__((ext_vector_type(2)));
typedef unsigned u32x4 __attribute__((ext_vector_type(4)));
constexpr int BM = 256, BK = 64, HALF = 128, HTB = HALF * BK * 2  , STAGE_BYTES = 8 * HTB;

__host__ __device__ __forceinline__ int lds_byte(int r, int c) { const int st = (r >> 4) * 2 + (c >> 5), rr = r & 15, cc = c & 31, ob = rr * 64 + cc * 2; return st * 1024 + (ob ^ (((ob >> 9) & 1) << 5)); }
__host__ __device__ __forceinline__ void stage_rc(int b, int& R, int& C) { const int st = b / 1024, sb = b % 1024, swz = sb ^ (((sb >> 9) & 1) << 5); R = (st >> 1) * 16 + swz / 64; C = (st & 1) * 32 + (swz % 64) / 2; }
__host__ __device__ __forceinline__ int perm32(int rho) { const int n = rho >> 4, i = rho & 15; return 8 * (i >> 2) + 4 * n + (i & 3); }

struct Unit { int pm, pn, e, mt, nv, aux, ar; };
struct Gemm { const bf16_t* A; const bf16_t* Bt; int K; size_t b_estride; };

__device__ __forceinline__ unsigned cvt_pk_bf16(float lo, float hi) { unsigned r; asm volatile("v_cvt_pk_bf16_f32 %0, %1, %2" : "=v"(r) : "v"(lo), "v"(hi)); return r; }
__device__ __forceinline__ float bf_lo(unsigned w) { return __builtin_bit_cast(float, w << 16); }
__device__ __forceinline__ float bf_hi(unsigned w) { return __builtin_bit_cast(float, w & 0xffff0000u); }
__device__ __forceinline__ float fast_sigmoid(float x) { return __builtin_amdgcn_rcpf(1.0f + __builtin_amdgcn_exp2f(-1.4426950408889634f * x)); }
__device__ __forceinline__ float gelu_tanh(float v) { const float y = 1.5957691216057308f * (v + 0.044715f * v * v * v); return v * fast_sigmoid(y); }

template <class Epi, class Sched, bool ALIGN_EPI, bool GATHER>
__device__ __forceinline__ void gemm_phase(PG8_LAS unsigned char* lds, const Gemm g, const Sched& S, const Epi& E) {
    const int tid = threadIdx.x, wid = __builtin_amdgcn_readfirstlane(tid >> 6), lane = tid & 63, wr = wid >> 2, wc = wid & 3, fr = lane & 15, fq = lane >> 4;
    const int K = g.K, nt = K / BK;
    unsigned voffA[2], voffB[2]; int RA[2]; unsigned CA2[2];
#pragma unroll
    for (int i = 0; i < 2; ++i) { int R, C; stage_rc(tid * 16 + i * 8192, R, C); const int Rb = Epi::PERM ? ((R & ~31) + perm32(R & 31)) : R;
        voffA[i] = (unsigned)(R * K + C) * 2u; voffB[i] = (unsigned)(Rb * K + C) * 2u; RA[i] = R; CA2[i] = (unsigned)C * 2u; }
    const size_t kstep = (size_t)(BK * 2);
    const size_t hstep = (size_t)HALF * K * 2;
    const size_t tstep = 2 * hstep;
    const unsigned ldsw = (unsigned)wid * 1024u;
    const int aoff = lds_byte(wr * 64 + fr, fq * 8), boff = lds_byte(wc * 32 + fr, fq * 8);
#define PG8_SA(b, h) (((b) * 2 + (h)) * HTB)
#define PG8_SB(b, h) ((4 + (b) * 2 + (h)) * HTB)
#define PG8_STAGE2(bufoff, gbase, v0, v1) do { \
        __builtin_amdgcn_global_load_lds((const unsigned*)((const char*)(gbase) + (v0)), (PG8_LAS unsigned*)(lds + (bufoff) + ldsw), 16, 0, 0); \
        __builtin_amdgcn_global_load_lds((const unsigned*)((const char*)(gbase) + (v1)), (PG8_LAS unsigned*)(lds + (bufoff) + ldsw + 8192), 16, 0, 0); } while (0)
#define PG8_STAGEB(bufoff, gbase) PG8_STAGE2(bufoff, gbase, voffB[0], voffB[1])
#define PG8_LDA(dst, b, h) do { _Pragma("unroll") for (int m = 0; m < 4; ++m) _Pragma("unroll") for (int k = 0; k < 2; ++k) dst[m][k] = *(const PG8_LAS bf16x8*)(lds + PG8_SA(b, h) + aoff + m * 2048 + k * 1024); } while (0)
#define PG8_LDB(dst, b, h) do { _Pragma("unroll") for (int n = 0; n < 2; ++n) _Pragma("unroll") for (int k = 0; k < 2; ++k) dst[n][k] = *(const PG8_LAS bf16x8*)(lds + PG8_SB(b, h) + boff + n * 2048 + k * 1024); } while (0)
#define PG8_MMA(ai, bj, At, Bt) do { __builtin_amdgcn_s_setprio(1); _Pragma("unroll") for (int m = 0; m < 4; ++m) _Pragma("unroll") for (int n = 0; n < 2; ++n) _Pragma("unroll") for (int k = 0; k < 2; ++k) \
        acc[ai][bj][m][n] = __builtin_amdgcn_mfma_f32_16x16x32_bf16(Bt[n][k], At[m][k], acc[ai][bj][m][n], 0, 0, 0); __builtin_amdgcn_s_setprio(0); } while (0)
#define PG8_WAIT_V(n) asm volatile("s_waitcnt vmcnt(" #n ")" ::: "memory")
#define PG8_WAIT_L(n) asm volatile("s_waitcnt lgkmcnt(" #n ")" ::: "memory")
#define PG8_BAR __builtin_amdgcn_s_barrier()
#define PG8_SCHED __builtin_amdgcn_sched_barrier(0)
    Unit cur, nxt; int ui = 0;
    if (!S.next(0, cur)) return;
    f32x4 acc[2][2][4][2];
#pragma unroll
    for (int a = 0; a < 2; ++a)
#pragma unroll
        for (int b = 0; b < 2; ++b)
#pragma unroll
            for (int m = 0; m < 4; ++m)
#pragma unroll
                for (int n = 0; n < 2; ++n) acc[a][b][m][n] = (f32x4){0.f, 0.f, 0.f, 0.f};
    bf16x8 At[4][2], B0[2][2], B1[2][2];
    const char* const gA = (const char*)g.A;
    unsigned roC[2][2], roN[2][2];
    const char* cA; const char* cB = (const char*)g.Bt + ((size_t)cur.e * g.b_estride) * 2 + (size_t)cur.pn * tstep;
    if constexpr (GATHER) {
#pragma unroll
        for (int h = 0; h < 2; ++h)
#pragma unroll
            for (int i = 0; i < 2; ++i) roC[h][i] = (unsigned)S.row_of(cur, h * HALF + RA[i]) * (unsigned)(K * 2) + CA2[i];
        cA = gA;
    } else {
#pragma unroll
        for (int h = 0; h < 2; ++h)
#pragma unroll
            for (int i = 0; i < 2; ++i) roC[h][i] = voffA[i] + (unsigned)(h * hstep);
        cA = gA + (size_t)cur.ar * (size_t)(K * 2);
    }
    S.a_ready(cur);
    PG8_STAGEB(PG8_SB(0, 0), cB); PG8_STAGEB(PG8_SB(0, 1), cB + hstep); PG8_STAGE2(PG8_SA(0, 0), cA, roC[0][0], roC[0][1]); PG8_STAGE2(PG8_SA(0, 1), cA, roC[1][0], roC[1][1]);
    if (wr == 1) PG8_BAR;
    PG8_WAIT_V(2); PG8_BAR;
    PG8_STAGEB(PG8_SB(1, 0), cB + kstep); PG8_STAGE2(PG8_SA(1, 0), cA + kstep, roC[0][0], roC[0][1]); PG8_STAGEB(PG8_SB(1, 1), cB + hstep + kstep);
    PG8_WAIT_V(6); PG8_BAR;
    for (;;) {
        const bool has_next = S.next(ui + 1, nxt);
        const char* nA; const char* nB = has_next ? (const char*)g.Bt + ((size_t)nxt.e * g.b_estride) * 2 + (size_t)nxt.pn * tstep : cB;
        if constexpr (GATHER) {
            nA = gA;
            if (has_next) {
#pragma unroll
                for (int h = 0; h < 2; ++h)
#pragma unroll
                    for (int i = 0; i < 2; ++i) roN[h][i] = (unsigned)S.row_of(nxt, h * HALF + RA[i]) * (unsigned)(K * 2) + CA2[i];
            } else {
#pragma unroll
                for (int h = 0; h < 2; ++h)
#pragma unroll
                    for (int i = 0; i < 2; ++i) roN[h][i] = roC[h][i];
            }
        } else {
            nA = has_next ? gA + (size_t)nxt.ar * (size_t)(K * 2) : cA;
        }
#pragma clang loop unroll(disable)
        for (int t = 0; t < nt; t += 2) {
            const bool last = (t == nt - 2);
            const char* a1 = cA + (size_t)(t + 1) * kstep;
            const char* a2 = last ? nA : cA + (size_t)(t + 2) * kstep; const char* b2 = last ? nB : cB + (size_t)(t + 2) * kstep;
            const char* a3 = a2 + kstep; const char* b3 = b2 + kstep;
            unsigned s00, s01, s10, s11;
            if constexpr (GATHER) { s00 = last ? roN[0][0] : roC[0][0]; s01 = last ? roN[0][1] : roC[0][1]; s10 = last ? roN[1][0] : roC[1][0]; s11 = last ? roN[1][1] : roC[1][1]; }
            else { s00 = roC[0][0]; s01 = roC[0][1]; s10 = roC[1][0]; s11 = roC[1][1]; }
            if (last && has_next) S.a_ready(nxt);
            PG8_LDB(B0, 0, 0); PG8_LDB(B1, 0, 1); PG8_SCHED; PG8_LDA(At, 0, 0); PG8_STAGE2(PG8_SA(1, 1), a1, roC[1][0], roC[1][1]);
            PG8_WAIT_V(8); PG8_WAIT_L(0); PG8_BAR; PG8_MMA(0, 0, At, B0); PG8_MMA(0, 1, At, B1); PG8_BAR; PG8_SCHED;
            PG8_LDA(At, 0, 1); PG8_STAGEB(PG8_SB(0, 0), b2); PG8_STAGEB(PG8_SB(0, 1), b2 + hstep); PG8_STAGE2(PG8_SA(0, 0), a2, s00, s01);
            PG8_WAIT_V(8); PG8_WAIT_L(0); PG8_BAR; PG8_MMA(1, 0, At, B0); PG8_MMA(1, 1, At, B1); PG8_BAR; PG8_SCHED;
            PG8_LDB(B0, 1, 0); PG8_LDB(B1, 1, 1); PG8_SCHED; PG8_LDA(At, 1, 0); PG8_STAGE2(PG8_SA(0, 1), a2, s10, s11);
            PG8_WAIT_V(8); PG8_WAIT_L(0); PG8_BAR; PG8_MMA(0, 0, At, B0); PG8_MMA(0, 1, At, B1); PG8_BAR; PG8_SCHED;
            PG8_LDA(At, 1, 1); PG8_STAGEB(PG8_SB(1, 0), b3); PG8_STAGEB(PG8_SB(1, 1), b3 + hstep); PG8_STAGE2(PG8_SA(1, 0), a3, s00, s01);
            PG8_WAIT_V(8); PG8_WAIT_L(0); PG8_BAR; PG8_MMA(1, 0, At, B0); PG8_MMA(1, 1, At, B1); PG8_BAR; PG8_SCHED;
        }
        if constexpr (ALIGN_EPI) { if (wr == 0) PG8_BAR; }
        E(acc, cur, wr, wc, fr, fq); S.done(cur);
        if (!has_next) break;
#pragma unroll
        for (int a = 0; a < 2; ++a)
#pragma unroll
            for (int b = 0; b < 2; ++b)
#pragma unroll
                for (int m = 0; m < 4; ++m)
#pragma unroll
                    for (int n = 0; n < 2; ++n) acc[a][b][m][n] = (f32x4){0.f, 0.f, 0.f, 0.f};
        cur = nxt; cA = nA; cB = nB; ++ui;
        if constexpr (GATHER) {
#pragma unroll
            for (int h = 0; h < 2; ++h)
#pragma unroll
                for (int i = 0; i < 2; ++i) roC[h][i] = roN[h][i];
        }
        if constexpr (ALIGN_EPI) { if (wr == 1) PG8_BAR; }
    }
    PG8_WAIT_V(0);
    if constexpr (!ALIGN_EPI) { if (wr == 0) PG8_BAR; }
    PG8_BAR;
#undef PG8_SA
#undef PG8_SB
#undef PG8_STAGE2
#undef PG8_STAGEB
#undef PG8_LDA
#undef PG8_LDB
#undef PG8_MMA
#undef PG8_WAIT_V
#undef PG8_WAIT_L
#undef PG8_BAR
#undef PG8_SCHED
}
}
#include <hip/hip_bf16.h>
#include <cmath>
namespace attn_body {
using bf16=__hip_bfloat16;
using bf16x8=__attribute__((ext_vector_type(8)))short;
using s16x4=__attribute__((ext_vector_type(4)))short;
using f32x16=__attribute__((ext_vector_type(16)))float;
using u32x4=__attribute__((ext_vector_type(4)))unsigned;
constexpr int BATCH=8,NHEAD=16,SEQ=4352,D=64,DM=NHEAD*D;
constexpr int NW=8,QBLK=32,QB=QBLK*NW,KVBLK=64,NQB=SEQ/QB;
constexpr int ATTN_PITCH=DM, ATTN_UNIT_ROWS=QB;
__device__ __forceinline__ int crow(int r,int hi){return (r&3)+8*(r>>2)+4*hi;}
#define SBAR() __builtin_amdgcn_sched_barrier(0)
__device__ __forceinline__ void cmask(f32x16&p0,f32x16&p1,int jb,int qrel,int hi){
  const float NEG=-INFINITY; int kb=64*jb+4*hi;
  #pragma unroll
  for(int r=0;r<16;++r){int kv=kb+(r&3)+8*(r>>2); if(kv>qrel)p0[r]=NEG; if(kv+32>qrel)p1[r]=NEG;}
}

constexpr int NSLOT=3, SLOTB=8192;
constexpr int LDS_K=0, LDS_V=NSLOT*SLOTB, LDS_WS=2*NSLOT*SLOTB, LDS_OST=LDS_WS+NW*64*4, LDS_BYTES=LDS_OST+NW*4096;
constexpr float C2=0.125f*1.4426950408889634f;
__device__ __forceinline__ void glds16(const void*gsrc,unsigned lds_dst){unsigned keep;
  asm volatile("s_mov_b32 %0, m0\n\ts_mov_b32 m0, %2\n\ts_nop 0\n\tglobal_load_lds_dwordx4 %1, off\n\ts_mov_b32 m0, %0":"=&s"(keep):"v"(gsrc),"s"(lds_dst):"memory");}
__device__ __forceinline__ float max3f(float a,float b,float c){float r;asm("v_max3_f32 %0, %1, %2, %3":"=v"(r):"v"(a),"v"(b),"v"(c));return r;}
__device__ __forceinline__ float max2f(float a,float b){float r;asm("v_max_f32_e32 %0, %1, %2":"=v"(r):"v"(a),"v"(b));return r;}
__device__ __forceinline__ float fadd_s(float a,float b){float r;asm("v_add_f32_e32 %0, %1, %2":"=v"(r):"v"(a),"v"(b));return r;}
__device__ __forceinline__ float fsub_s(float a,float b){float r;asm("v_sub_f32_e32 %0, %1, %2":"=v"(r):"v"(a),"v"(b));return r;}
typedef float f32x2_t __attribute__((ext_vector_type(2))); typedef __bf16 bf16x2_t __attribute__((ext_vector_type(2)));
__device__ __forceinline__ unsigned cvtpk_s(float lo,float hi){f32x2_t v={lo,hi};bf16x2_t b=__builtin_convertvector(v,bf16x2_t);return __builtin_bit_cast(unsigned,b);}
#define WAIT_BAR(N) asm volatile("s_waitcnt vmcnt(" #N ") lgkmcnt(0)\n\ts_barrier":::"memory")

__device__ __forceinline__ void qkt(f32x16&p0,f32x16&p1,const char*Kslot,const bf16x8*qr,const f32x16&negm,int r32,int hi){
  const char*kb=Kslot+hi*1024+r32*16;
  #pragma unroll
  for(int d0=0;d0<4;++d0){
    const bf16x8 b0=*reinterpret_cast<const bf16x8*>(kb+d0*2048);
    const bf16x8 b1=*reinterpret_cast<const bf16x8*>(kb+d0*2048+512);
    if(d0==0){p0=__builtin_amdgcn_mfma_f32_32x32x16_bf16(b0,qr[0],negm,0,0,0);p1=__builtin_amdgcn_mfma_f32_32x32x16_bf16(b1,qr[0],negm,0,0,0);}
    else{p0=__builtin_amdgcn_mfma_f32_32x32x16_bf16(b0,qr[d0],p0,0,0,0);p1=__builtin_amdgcn_mfma_f32_32x32x16_bf16(b1,qr[d0],p1,0,0,0);}}
}
typedef __attribute__((address_space(3))) const char* lds_cptr;
typedef short v4i16_t __attribute__((ext_vector_type(4)));
__device__ __forceinline__ void kload8(bf16x8*kf,lds_cptr kp){
  kf[0]=*(const __attribute__((address_space(3))) bf16x8*)(kp);      kf[1]=*(const __attribute__((address_space(3))) bf16x8*)(kp+512);
  kf[2]=*(const __attribute__((address_space(3))) bf16x8*)(kp+2048); kf[3]=*(const __attribute__((address_space(3))) bf16x8*)(kp+2560);
  kf[4]=*(const __attribute__((address_space(3))) bf16x8*)(kp+4096); kf[5]=*(const __attribute__((address_space(3))) bf16x8*)(kp+4608);
  kf[6]=*(const __attribute__((address_space(3))) bf16x8*)(kp+6144); kf[7]=*(const __attribute__((address_space(3))) bf16x8*)(kp+6656);
}
__device__ __forceinline__ void kload2(bf16x8*kf,lds_cptr kp,int j){ kf[2*j]=*(const __attribute__((address_space(3))) bf16x8*)(kp+j*2048); kf[2*j+1]=*(const __attribute__((address_space(3))) bf16x8*)(kp+j*2048+512); }
__device__ __forceinline__ s16x4 vtr(lds_cptr p){ return __builtin_bit_cast(s16x4,__builtin_amdgcn_ds_read_tr16_b64_v4i16((__attribute__((address_space(3))) v4i16_t*)p)); }
__device__ __forceinline__ float rowmax(const f32x16&p0,const f32x16&p1){
  float a=max3f(p0[0],p0[1],p1[0]),b=max3f(p0[2],p0[3],p1[1]);a=max3f(a,p1[2],p1[3]);
  #pragma unroll
  for(int r=4;r<16;r+=4){a=max3f(a,p0[r],p0[r+1]);b=max3f(b,p0[r+2],p0[r+3]);a=max3f(a,p1[r],p1[r+1]);b=max3f(b,p1[r+2],p1[r+3]);}
  const float m=max2f(a,b);
  auto rr=__builtin_amdgcn_permlane32_swap(__float_as_uint(m),__float_as_uint(m),false,false);
  return max2f(__uint_as_float(rr[0]),__uint_as_float(rr[1]));
}
__device__ __forceinline__ void pv(f32x16*o,int vb,bf16x8 pa0,bf16x8 pa1,bf16x8 pa2,bf16x8 pa3){
  #pragma unroll
  for(int d0=0;d0<2;++d0){s16x4 lo[4],hi[4];
    #pragma unroll
    for(int ks=0;ks<4;++ks){
      asm volatile("ds_read_b64_tr_b16 %0,%1 offset:%c2":"=&v"(lo[ks]):"v"(vb),"i"(d0*4096+ks*1024):"memory");
      asm volatile("ds_read_b64_tr_b16 %0,%1 offset:%c2":"=&v"(hi[ks]):"v"(vb),"i"(d0*4096+ks*1024+512):"memory");}
    asm volatile("s_waitcnt lgkmcnt(0)":::"memory");SBAR();
    #define PK(k) (bf16x8){lo[k][0],lo[k][1],lo[k][2],lo[k][3],hi[k][0],hi[k][1],hi[k][2],hi[k][3]}
    o[d0]=__builtin_amdgcn_mfma_f32_32x32x16_bf16(pa0,PK(0),o[d0],0,0,0);
    o[d0]=__builtin_amdgcn_mfma_f32_32x32x16_bf16(pa1,PK(1),o[d0],0,0,0);
    o[d0]=__builtin_amdgcn_mfma_f32_32x32x16_bf16(pa2,PK(2),o[d0],0,0,0);
    o[d0]=__builtin_amdgcn_mfma_f32_32x32x16_bf16(pa3,PK(3),o[d0],0,0,0);
    #undef PK
  }
}

#ifndef ATTN_STORE16
#define ATTN_STORE16(p,v) (*(u32x4*)(p)=(v))
#endif
template<int THRL> __device__ __forceinline__ void attn_unit(int b,int h,int hv,int qb,const bf16*Q,const bf16*__restrict__ K,const bf16*__restrict__ V,bf16*O,char*shm){
  const int tid=threadIdx.x,lane=tid&63,r32=lane&31,hi=lane>>5; const int wid=__builtin_amdgcn_readfirstlane(tid>>6);
  const long rowbase=(long)b*SEQ; const int q0=qb*QB;
  const bf16*Qw=Q+(rowbase+q0+wid*QBLK)*DM+h*D;
  const bf16*Kh=K+rowbase*DM+h*D,*Vh=V+rowbase*DM+hv*D;
  const unsigned lds0=(unsigned)(uintptr_t)shm;
  float*wsf=(float*)(shm+LDS_WS)+wid*64;
  const bf16*ksrc=Kh+(long)lane*DM+wid*8;
  const bf16*vsrc=Vh+(long)(16*(wid&3)+(lane>>2))*DM+(wid>>2)*32+(lane&3)*8;
  const unsigned kdst=lds0+LDS_K+wid*1024, vdst=lds0+LDS_V+wid*1024;
  #define DMA_K(t,slot) glds16(ksrc+(long)(t)*KVBLK*DM,(unsigned)__builtin_amdgcn_readfirstlane(kdst+(slot)))
  #define DMA_V(t,slot) glds16(vsrc+(long)(t)*KVBLK*DM,(unsigned)__builtin_amdgcn_readfirstlane(vdst+(slot)))
  const int vb0=(int)(lds0+LDS_V)+((lane>>4)&1)*32+(lane&3)*8+(4*hi+((lane&15)>>2))*64;
  const char*Kbase=shm+LDS_K; bf16x8 kf[8];
  const lds_cptr shm3=(lds_cptr)shm; const lds_cptr kp0=shm3+LDS_K+hi*1024+r32*16; const lds_cptr vp0=shm3+LDS_V+((lane>>4)&1)*32+(lane&3)*8+(4*hi+((lane&15)>>2))*64;
  const int NT=(q0+QB)/KVBLK;
  DMA_K(0,0);DMA_V(0,0);DMA_K(1,SLOTB);
  bf16x8 qr[4];
  #pragma unroll
  for(int d0=0;d0<4;++d0)qr[d0]=*reinterpret_cast<const bf16x8*>(&Qw[(long)r32*DM+d0*16+hi*8]);
  float mhat=0.f,l_reg=0.f;f32x16 o[2];o[0]=f32x16{};o[1]=f32x16{};f32x16 negm=f32x16{};asm volatile("":"+v"(negm));
  const int qrel=wid*QBLK+r32;
  #define CMASK(P0,P1,t) do{int jb_=(t)-(NT-4); if(jb_>=0)cmask(P0,P1,jb_,qrel,hi);}while(0)
  bool resc=false;
  #define START(P0,P1) do{ const float rm=rowmax(P0,P1); resc=false; \
    { const float dl=rm; mhat=fadd_s(mhat,dl); \
      _Pragma("unroll") for(int r=0;r<16;++r){P0[r]=fsub_s(P0[r],dl);P1[r]=fsub_s(P1[r],dl);} \
      _Pragma("unroll") for(int r=0;r<16;++r)negm[r]=-mhat; asm volatile("":"+v"(negm)); } \
    _Pragma("unroll") for(int r=0;r<16;++r)P0[r]=__builtin_amdgcn_exp2f(P0[r]); }while(0)
  #define RESC() do{ if(resc){ asm volatile("s_waitcnt lgkmcnt(0)":::"memory"); \
      _Pragma("unroll") for(int d_=0;d_<2;++d_) _Pragma("unroll") for(int r=0;r<16;++r)o[d_][r]*=wsf[crow(r,hi)]; } }while(0)
  f32x16 pA0,pA1,pB0,pB1;
  int sl_prev=0,sl_cur=0,sl_next=SLOTB;
  #define ROT() do{sl_prev=sl_cur;sl_cur=sl_next;sl_next=(sl_next==(NSLOT-1)*SLOTB)?0:sl_next+SLOTB;}while(0)
  DMA_K(2,2*SLOTB);
  WAIT_BAR(3);
  qkt(pA0,pA1,Kbase,qr,negm,r32,hi);asm volatile("s_nop 15\n\ts_nop 7":"+v"(pA0),"+v"(pA1));CMASK(pA0,pA1,0);
  START(pA0,pA1);
  _Pragma("unroll") for(int r=0;r<16;++r)pA1[r]=__builtin_amdgcn_exp2f(pA1[r]);
  WAIT_BAR(0);
  DMA_K(3,0);DMA_V(1,SLOTB);
  ROT();
  kload8(kf,kp0+sl_cur);
  WAIT_BAR(2);
  s16x4 vlo[8],vhi[8]; u32x4 pw0,pw1,pw2,pw3;
  #define PKW(P,B) cvtpk_s(P[B],P[B+1])
  #define PAF(k) __builtin_bit_cast(bf16x8,pw##k)
  #define VFR(i) (bf16x8){vlo[i][0],vlo[i][1],vlo[i][2],vlo[i][3],vhi[i][0],vhi[i][1],vhi[i][2],vhi[i][3]}
  #define PIN(x) asm volatile("":"+v"(x))
  #define MX3(a,b,c) __builtin_fmaxf(__builtin_fmaxf((a),(b)),(c))
  #define GAPA(MF,A0,A1,A2,A3,W0,W1,PW) do{ MF; sacc+=A0; sacc+=A1; sacc+=A2; sacc+=A3; PIN(sacc); W0; W1; PIN(PW); SBAR(); }while(0)
  #define EX(v) __builtin_amdgcn_exp2f(v)
  #define GAPB(MF,X,B) do{ MF; X[B]=EX(X[B]); X[B+1]=EX(X[B+1]); X[B+2]=EX(X[B+2]); X[B+3]=EX(X[B+3]); PIN(X); SBAR(); }while(0)
  #define VRD(i) do{ vlo[i]=vtr(vp_+(((i)>>2)*4096+((i)&3)*1024)); vhi[i]=vtr(vp_+(((i)>>2)*4096+((i)&3)*1024+512)); }while(0)
  #define KRD(G,j) do{ if(G){ kload2(kf,kp0+sl_next,j); SBAR(); } }while(0)
  #define STEP(C0,C1,P0,P1,t,GK,GV,GL) do{ SBAR(); \
    const lds_cptr vp_=vp0+sl_prev; \
    VRD(0); SBAR(); float sacc=(P0[0]+P0[1]); \
    GAPA(C0=__builtin_amdgcn_mfma_f32_32x32x16_bf16(kf[0],qr[0],negm,0,0,0), P0[2],P0[3],P0[4],P0[5],     pw0[0]=PKW(P0,0), pw0[1]=PKW(P0,2), pw0); \
    VRD(4); SBAR(); GAPA(C1=__builtin_amdgcn_mfma_f32_32x32x16_bf16(kf[1],qr[0],negm,0,0,0), P0[6],P0[7],P0[8],P0[9],     pw0[2]=PKW(P0,4), pw0[3]=PKW(P0,6), pw0); \
    VRD(1); SBAR(); GAPA(C0=__builtin_amdgcn_mfma_f32_32x32x16_bf16(kf[2],qr[1],C0,0,0,0),   P0[10],P0[11],P0[12],P0[13], pw1[0]=PKW(P0,8), pw1[1]=PKW(P0,10), pw1); \
    VRD(5); SBAR(); GAPA(C1=__builtin_amdgcn_mfma_f32_32x32x16_bf16(kf[3],qr[1],C1,0,0,0),   P0[14],P0[15],P1[0],P1[1],   pw1[2]=PKW(P0,12),pw1[3]=PKW(P0,14), pw1); \
    VRD(2); SBAR(); GAPA(C0=__builtin_amdgcn_mfma_f32_32x32x16_bf16(kf[4],qr[2],C0,0,0,0),   P1[2],P1[3],P1[4],P1[5],     pw2[0]=PKW(P1,0), pw2[1]=PKW(P1,2), pw2); \
    VRD(6); SBAR(); GAPA(C1=__builtin_amdgcn_mfma_f32_32x32x16_bf16(kf[5],qr[2],C1,0,0,0),   P1[6],P1[7],P1[8],P1[9],     pw2[2]=PKW(P1,4), pw2[3]=PKW(P1,6), pw2); \
    VRD(3); SBAR(); GAPA(C0=__builtin_amdgcn_mfma_f32_32x32x16_bf16(kf[6],qr[3],C0,0,0,0),   P1[10],P1[11],P1[12],P1[13], pw3[0]=PKW(P1,8), pw3[1]=PKW(P1,10), pw3); \
    VRD(7); SBAR(); GAPA(C1=__builtin_amdgcn_mfma_f32_32x32x16_bf16(kf[7],qr[3],C1,0,0,0),   P1[14],P1[15],0.f,0.f,       pw3[2]=PKW(P1,12),pw3[3]=PKW(P1,14), pw3); \
    l_reg+=sacc; \
    if(GK){DMA_K((t)+3,sl_cur);} if(GV){DMA_V((t)+1,sl_next);} \
    CMASK(C0,C1,t); \
    { float a=MX3(C0[0],C0[1],C1[0]),b=MX3(C0[2],C0[3],C1[1]); a=MX3(a,C1[2],C1[3]); \
      _Pragma("unroll") for(int r=4;r<16;r+=4){a=MX3(a,C0[r],C0[r+1]);b=MX3(b,C0[r+2],C0[r+3]);a=MX3(a,C1[r],C1[r+1]);b=MX3(b,C1[r+2],C1[r+3]);} \
      float rm=__builtin_fmaxf(a,b); { auto rr=__builtin_amdgcn_permlane32_swap(__float_as_uint(rm),__float_as_uint(rm),false,false); rm=__builtin_fmaxf(__uint_as_float(rr[0]),__uint_as_float(rr[1])); } \
      resc=false; \
      if(__builtin_expect(__any(rm>(float)THRL),0)){ const float dl=__builtin_fmaxf(rm,0.f); mhat+=dl; \
        _Pragma("unroll") for(int r=0;r<16;++r){C0[r]-=dl;C1[r]-=dl;} \
        _Pragma("unroll") for(int r=0;r<16;++r)negm[r]=-mhat; asm volatile("":"+v"(negm)); \
        const float f=__builtin_amdgcn_exp2f(-dl); l_reg*=f; if(hi==0)wsf[r32]=f; resc=true; } } \
    SBAR(); \
    GAPB(o[0]=__builtin_amdgcn_mfma_f32_32x32x16_bf16(PAF(0),VFR(0),o[0],0,0,0), C0,0); \
    GAPB(o[1]=__builtin_amdgcn_mfma_f32_32x32x16_bf16(PAF(0),VFR(4),o[1],0,0,0), C0,4); \
    KRD(GL,0); GAPB(o[0]=__builtin_amdgcn_mfma_f32_32x32x16_bf16(PAF(1),VFR(1),o[0],0,0,0), C0,8); \
    KRD(GL,1); GAPB(o[1]=__builtin_amdgcn_mfma_f32_32x32x16_bf16(PAF(1),VFR(5),o[1],0,0,0), C0,12); \
    KRD(GL,2); GAPB(o[0]=__builtin_amdgcn_mfma_f32_32x32x16_bf16(PAF(2),VFR(2),o[0],0,0,0), C1,0); \
    KRD(GL,3); GAPB(o[1]=__builtin_amdgcn_mfma_f32_32x32x16_bf16(PAF(2),VFR(6),o[1],0,0,0), C1,4); \
    GAPB(o[0]=__builtin_amdgcn_mfma_f32_32x32x16_bf16(PAF(3),VFR(3),o[0],0,0,0), C1,8); \
    GAPB(o[1]=__builtin_amdgcn_mfma_f32_32x32x16_bf16(PAF(3),VFR(7),o[1],0,0,0), C1,12); \
    }while(0)
  int t=1;
  #undef CMASK
  #define CMASK(P0,P1,t) do{}while(0)
  for(;t+5<NT;t+=2){
    STEP(pB0,pB1,pA0,pA1,t,true,true,true);     WAIT_BAR(2); RESC(); ROT();
    STEP(pA0,pA1,pB0,pB1,t+1,true,true,true);   WAIT_BAR(2); RESC(); ROT();
  }
  #undef CMASK
  #define CMASK(P0,P1,t) do{int jb_=(t)-(NT-4); if(jb_>=0)cmask(P0,P1,jb_,qrel,hi);}while(0)
  #define ENDW(tt) do{ if((tt)+3<NT){WAIT_BAR(2);} else if((tt)+2<NT){WAIT_BAR(1);} else {WAIT_BAR(0);} }while(0)
  for(;t+1<NT;t+=2){
    STEP(pB0,pB1,pA0,pA1,t,(t+3<NT),(t+1<NT),(t+1<NT));       ENDW(t);   RESC(); ROT();
    STEP(pA0,pA1,pB0,pB1,t+1,(t+4<NT),(t+2<NT),(t+2<NT));     ENDW(t+1); RESC(); ROT();
  }
  STEP(pB0,pB1,pA0,pA1,NT-1,false,false,false); RESC();
  { float sacc=pB0[0]+pB0[1]; _Pragma("unroll") for(int r=2;r<16;++r)sacc+=pB0[r]; _Pragma("unroll") for(int r=0;r<16;++r)sacc+=pB1[r]; l_reg+=sacc;
    pw0=(u32x4){PKW(pB0,0),PKW(pB0,2),PKW(pB0,4),PKW(pB0,6)};pw1=(u32x4){PKW(pB0,8),PKW(pB0,10),PKW(pB0,12),PKW(pB0,14)};pw2=(u32x4){PKW(pB1,0),PKW(pB1,2),PKW(pB1,4),PKW(pB1,6)};pw3=(u32x4){PKW(pB1,8),PKW(pB1,10),PKW(pB1,12),PKW(pB1,14)};
    SBAR(); pv(o,vb0+sl_cur,PAF(0),PAF(1),PAF(2),PAF(3)); }
  #undef PKW
  #undef PAF
  #undef VFR
  #undef PIN
  #undef MX3
  #undef GAPA
  #undef GAPB
  #undef EX
  #undef VRD
  #undef KRD
  #undef STEP
  #undef ENDW
  {auto rr=__builtin_amdgcn_permlane32_swap(__float_as_uint(l_reg),__float_as_uint(l_reg),false,false);l_reg=__uint_as_float(rr[0])+__uint_as_float(rr[1]);}
  if(hi==0)wsf[32+r32]=l_reg;asm volatile("s_waitcnt lgkmcnt(0)":::"memory");
  float rli[16];
  #pragma unroll
  for(int r=0;r<16;++r)rli[r]=__builtin_amdgcn_rcpf(wsf[32+crow(r,hi)]);
  bf16*Ow=O+(rowbase+q0+wid*QBLK)*DM+hv*D;
  { bf16*stg=(bf16*)(shm+LDS_OST)+wid*2048;
    #pragma unroll
    for(int r=0;r<16;++r){const int orow=crow(r,hi);
      #pragma unroll
      for(int d0=0;d0<2;++d0)stg[orow*64+d0*32+r32]=__float2bfloat16(o[d0][r]*rli[r]);}
    asm volatile("s_waitcnt lgkmcnt(0)":::"memory");
    #pragma unroll
    for(int i=0;i<4;++i){const int row=i*8+(lane>>3),ch=lane&7; const u32x4 v=*(const u32x4*)(stg+row*64+ch*8); ATTN_STORE16(Ow+(long)row*DM+ch*8,v);} }
  asm volatile("s_waitcnt lgkmcnt(0)\n\ts_barrier":::"memory");
  #undef DMA_K
  #undef DMA_V
  #undef CMASK
  #undef START
  #undef RESC
  #undef ROT
}
constexpr int ATTN_LDS_BYTES=LDS_BYTES;
struct AttnTensors { const bf16* Q; const bf16* K; const bf16* V; bf16* O; };
struct AttnUnit { int b; int hq; int hv; int qb; };
struct FixedOrder {
  int b, hq, hv;
  __device__ __forceinline__ bool next(int i,AttnUnit&u)const{ if(i>=NQB)return false; u.b=b; u.hq=hq; u.hv=hv; u.qb=NQB-1-i; return true; }
};
template<class Sched,int THRL=8> __device__ __forceinline__ void attn_phase(char*lds,const AttnTensors&T,const Sched&S){
  AttnUnit u;
  for(int i=0;S.next(i,u);++i){ attn_unit<THRL>(u.b,u.hq,u.hv,u.qb,T.Q,T.K,T.V,T.O,lds); }
}
#undef SBAR
#undef WAIT_BAR
}

constexpr int NWAVES = 8;
#ifndef MK_N_LAUNCHES
#define MK_N_LAUNCHES 1
#endif
#ifndef MK_DIAG
#define MK_DIAG 0
#endif
constexpr int NPHASE = 14;
constexpr int N_LAUNCHES = MK_N_LAUNCHES;

constexpr int NB = 8, SEQ = 4096, NMETA = 16, TV = NMETA + SEQ, TA = 4352, MA = NB * TA, D = 1024;
constexpr int NIN = 7168, NE = 256, TOPK = 8, DE = 256;
constexpr int NCHUNK = 33;
constexpr float LN_EPS = 1e-5f, ALPHA = 1.189207115002721f;
constexpr float ROUTED_SCALE = 2.5f, LAMBDA_INIT = 0.2f;
constexpr int CAP = 32768;
constexpr int NVALID = NB * SEQ;
constexpr int YSHARED = NVALID * TOPK, YDUMMY = NVALID * (TOPK + 1);

constexpr size_t MiB = 1u << 20;
constexpr size_t SLOTB = 68 * MiB;
static_assert((size_t)MA * D * 2 == SLOTB, "slot size");
constexpr size_t WS_CTL = 0, CTL_ZERO_BYTES = 1 * MiB;
constexpr size_t WS_ROWSTAT = 1 * MiB;
constexpr size_t WS_SCANSUM = 1 * MiB + 320 * 1024;
constexpr size_t WS_LRUWT = 4 * MiB - 512 * 1024;
constexpr size_t WS_S0 = 26 * MiB;
#define WS_SLOT(i) (WS_S0 + (size_t)(i) * SLOTB)
constexpr size_t WS_XN = WS_SLOT(0), WS_XR = WS_SLOT(1), WS_YG = WS_SLOT(2), WS_Q = WS_SLOT(3), WS_K = WS_SLOT(4), WS_V = WS_SLOT(5), WS_GR = WS_SLOT(6), WS_GA = WS_SLOT(7),
                 WS_REC = WS_SLOT(8), WS_O0 = WS_SLOT(9), WS_O1 = WS_SLOT(10), WS_ATT = WS_SLOT(11);
constexpr size_t WS_T1 = WS_SLOT(0), WS_U = WS_SLOT(1), WS_Z = WS_SLOT(2)  , WS_LOGITS = WS_SLOT(5);
constexpr size_t WS_LIST = 262 * MiB;
constexpr size_t WS_WGU = 4 * MiB;
constexpr size_t WS_WD = 596 * MiB;
constexpr size_t WS_ACT = 725 * MiB;
constexpr size_t WS_H1B = 905 * MiB;
constexpr size_t WS_TOKSLOT = 973 * MiB;
constexpr size_t WS_TOKW = 975 * MiB + 256 * 1024;
constexpr size_t WS_WIN = 978 * MiB, WS_WR = 992 * MiB, WS_WA = 994 * MiB, WS_WO = 996 * MiB, WS_WROUT = 998 * MiB;
constexpr size_t WS_Y = 4 * MiB;
constexpr size_t WS_END = 1000 * MiB;
constexpr int MAXTILES = 1408;
static_assert(WS_Y + ((size_t)NVALID * 9 + 1) * D * 2 <= WS_WD && WS_WD + (size_t)257 * 1024 * 256 * 2 <= WS_ACT && WS_ACT + (size_t)MAXTILES * 256 * 256 * 2 <= WS_H1B, "moe map");
static_assert(WS_WGU + (size_t)257 * 512 * 1024 * 2 <= WS_LIST && WS_LIST + (size_t)NE * CAP * 4 <= WS_SLOT(4), "moe map 2");
static_assert(WS_SLOT(12) <= WS_H1B && WS_TOKW + (size_t)MA * 16 * 4 <= WS_WIN, "map 3");
constexpr int CW_TMO = 0, CW_CODE = 1;
constexpr int CW_BAR = 4096;
constexpr int CW_CNT = 16384;
constexpr int CW_DIAG = 20480;

constexpr int RING_OFF = 0, RING_BYTES = 131072;
constexpr int LDSCTL_OFF = RING_BYTES, MISC_OFF = LDSCTL_OFF + 320;
constexpr int TT_OFF = LDSCTL_OFF + 1024;
constexpr int UB_OFF = TT_OFF + MAXTILES * 4;
constexpr int LDS_BYTES = 147456;
constexpr int CN_OFF = UB_OFF + 260 * 4, TB_OFF = CN_OFF + 260 * 4;
static_assert(TB_OFF + 260 * 4 <= LDS_BYTES, "LDS map");

#define GAS __attribute__((address_space(1)))
#define LAS __attribute__((address_space(3)))
typedef unsigned short bf16;
typedef unsigned v4u __attribute__((ext_vector_type(4)));
typedef float f32x4 __attribute__((ext_vector_type(4)));
typedef short bf16x8 __attribute__((ext_vector_type(8)));
typedef GAS unsigned gu32;
typedef GAS unsigned long long gu64;
#define RLX_AGENT __ATOMIC_RELAXED, __HIP_MEMORY_SCOPE_AGENT
#define LDS_WAIT() asm volatile("s_waitcnt lgkmcnt(0)" ::: "memory")
#define VM_WAIT() asm volatile("s_waitcnt vmcnt(0)" ::: "memory")
__device__ __forceinline__ unsigned long long rt() { return __builtin_amdgcn_s_memrealtime(); }
__device__ __forceinline__ unsigned f2bf(float f) { unsigned u = __builtin_bit_cast(unsigned, f); return (u + 0x7fffu + ((u >> 16) & 1u)) >> 16; }
__device__ __forceinline__ unsigned pk2(float lo, float hi) { return f2bf(lo) | (f2bf(hi) << 16); }

#define XB_TMO      128
#define XB_XCNT(j)  (256  + 64 * (j))
#define XB_XSUB(j)  (1280 + 64 * (j))
#define XB_XGEN(j)  (2304 + 64 * (j))
#define XB_TOP      3328
#define XB_TOPGEN   3392
#define XCD_BAR_WORDS 3456
#define XB_SPIN_CAP (1u << 18)

__device__ __forceinline__ unsigned xb_ld(unsigned* p)              { return __hip_atomic_load(p, __ATOMIC_RELAXED, __HIP_MEMORY_SCOPE_AGENT); }
__device__ __forceinline__ unsigned xb_add(unsigned* p, unsigned v) { return __hip_atomic_fetch_add(p, v, __ATOMIC_RELAXED, __HIP_MEMORY_SCOPE_AGENT); }
__device__ __forceinline__ unsigned xb_xcc_id() { return (unsigned)__builtin_amdgcn_s_getreg((3 << 11) | 20) & 0xFu; }
#define XB_SPIN(cond, bar) do { unsigned _sp = 0; while (cond) { __builtin_amdgcn_s_sleep(1); \
    if ((++_sp & 255u) == 0u) { if (xb_ld(&(bar)[XB_TMO])) break; if (_sp > XB_SPIN_CAP) { atomicAdd(&(bar)[XB_TMO], 1u); break; } } } } while (0)

struct XcdBarrier {
    unsigned* bar; unsigned x;
    volatile LAS unsigned* st;
};

__device__ __forceinline__ XcdBarrier xcd_barrier_post(unsigned* bar, volatile LAS unsigned* st) {
    XcdBarrier b; b.bar = bar; b.x = xb_xcc_id(); b.st = st;
    if (threadIdx.x == 0) (void)xb_add(&bar[XB_XCNT(b.x)], 1u);
    return b;
}
__device__ __forceinline__ void xcd_barrier_complete(unsigned* bar, unsigned x, unsigned& nloc, unsigned& nx) {
    const unsigned G = gridDim.x * gridDim.y * gridDim.z;
    unsigned sum, cnt, mine, sp = 0u;
    for (;;) {
        sum = 0u; cnt = 0u; mine = 0u;
#pragma unroll
        for (unsigned j = 0; j < 16; ++j) { const unsigned c = xb_ld(&bar[XB_XCNT(j)]); sum += c; cnt += (c > 0u) ? 1u : 0u; mine = (j == x) ? c : mine; }
        if (sum == G) break;
        __builtin_amdgcn_s_sleep(1);
        if ((++sp & 255u) == 0u) { if (xb_ld(&bar[XB_TMO])) break; if (sp > XB_SPIN_CAP) { atomicAdd(&bar[XB_TMO], 1u); break; } }
    }
    nloc = mine > 0u ? mine : 1u; nx = cnt > 0u ? cnt : 1u;
}

__device__ __forceinline__ void xcd_barrier(const XcdBarrier& b) {
    asm volatile("s_waitcnt vmcnt(0)" ::: "memory");
    __syncthreads();
    if (threadIdx.x == 0) {
        unsigned* bar = b.bar;
        __builtin_amdgcn_s_waitcnt(0);
        unsigned nloc = b.st[0], nx = b.st[1];
        if (nloc == 0u) { xcd_barrier_complete(bar, b.x, nloc, nx); b.st[0] = nloc; b.st[1] = nx; }
        const unsigned old = xb_add(&bar[XB_XSUB(b.x)], 1u);
        const unsigned gen = old / nloc;
        if (old + 1u == (gen + 1u) * nloc) {
            __builtin_amdgcn_fence(__ATOMIC_RELEASE, "agent");
            asm volatile("s_waitcnt vmcnt(0)" ::: "memory");
            const unsigned og = xb_add(&bar[XB_TOP], 1u);
            const unsigned tg = og / nx;
            if (og + 1u == (tg + 1u) * nx) xb_add(&bar[XB_TOPGEN], 1u);
            else XB_SPIN(xb_ld(&bar[XB_TOPGEN]) == tg, bar);
            __builtin_amdgcn_fence(__ATOMIC_ACQUIRE, "agent");
            xb_add(&bar[XB_XGEN(b.x)], 1u);
            asm volatile("s_waitcnt vmcnt(0)" ::: "memory");
        } else {
            XB_SPIN(xb_ld(&bar[XB_XGEN(b.x)]) == gen, bar);
            __builtin_amdgcn_fence(__ATOMIC_ACQUIRE, "agent");
            asm volatile("s_waitcnt vmcnt(0)" ::: "memory");
        }
    }
    __syncthreads();
}


__device__ __forceinline__ float wave_sum(float v) {
#pragma unroll
    for (int o = 1; o < 64; o <<= 1) v += __shfl_xor(v, o);
    return v;
}
__device__ __forceinline__ float bfl(unsigned w) { return __builtin_bit_cast(float, w << 16); }
__device__ __forceinline__ float bfh(unsigned w) { return __builtin_bit_cast(float, w & 0xffff0000u); }
__device__ __forceinline__ float bf1(bf16 h) { return __builtin_bit_cast(float, (unsigned)h << 16); }

struct DenseOrder {
    int nM, nN, nwg, G, c, valid;
    __device__ void init(int M, int N, int G_, int c_, int valid_ = 0) { nM = M / 256; nN = N / 256; nwg = nM * nN; G = G_; c = c_; valid = valid_; }
    __device__ bool next(int i, pg8::Unit& u) const {
        const long L = (long)i * G + c; if (L >= nwg) return false;
        int wgid = (int)L; { const int q = nwg / 8, r = nwg % 8, xcd = wgid % 8, off = wgid / 8; wgid = (xcd < r ? xcd * (q + 1) : r * (q + 1) + (xcd - r) * q) + off; }
        const int WGM = 8; const int nig = WGM * nN, gid = wgid / nig, fm = gid * WGM, gsz = (nM - fm) < WGM ? (nM - fm) : WGM;
        u.pm = fm + ((wgid % nig) % gsz); u.pn = (wgid % nig) / gsz; u.e = 0; u.mt = 0; u.nv = 256; u.aux = 0;
        u.ar = valid ? (u.pm >> 4) * TA + NMETA + (u.pm & 15) * 256 : u.pm * 256; return true;
    }
    __device__ __forceinline__ int row_of(const pg8::Unit&, int) const { return 0; }
    __device__ __forceinline__ void a_ready(const pg8::Unit&) const {}
    __device__ __forceinline__ void done(const pg8::Unit&) const {}
};
template <int NPN> struct MoeOrder {
    int ntiles, G, vcu; volatile LAS unsigned* TT; volatile LAS int* UB; volatile LAS int* CN; const int* list; int* tokslot; int write_slots;
    __device__ bool next(int i, pg8::Unit& u) const {
        const long L = (long)i * G + vcu; if (L >= (long)ntiles * NPN) return false;
        const int tile = (int)(L / NPN); u.pn = (int)(L % NPN); u.pm = tile;
        const unsigned tt = __builtin_amdgcn_readfirstlane(TT[tile]); u.e = (int)(tt & 0xffffu); u.mt = (int)(tt >> 16);
        const int ce = __builtin_amdgcn_readfirstlane(CN[u.e]);
        const int rem = ce - u.mt * 256; u.nv = rem < 256 ? rem : 256;
        u.aux = __builtin_amdgcn_readfirstlane(UB[u.e]) + u.mt * 256; u.ar = tile * 256; return true;
    }
    __device__ __forceinline__ int row_of(const pg8::Unit& u, int r) const {
        if (u.e == NE) return u.mt * 256 + r;
        return (r < u.nv) ? (list[(size_t)u.e * CAP + u.mt * 256 + r] >> 4) : 0;
    }
    __device__ __forceinline__ void a_ready(const pg8::Unit&) const {}
    __device__ __forceinline__ void done(const pg8::Unit& u) const {
        if (write_slots && u.pn == 0 && u.e < NE) { const int r = threadIdx.x; if (r < u.nv) { const int en = list[(size_t)u.e * CAP + u.mt * 256 + r]; tokslot[(size_t)(en >> 4) * 16 + (en & 15)] = u.aux + r; } }
    }
};

using pg8::u32x4;
typedef unsigned u32x2v __attribute__((ext_vector_type(2)));
typedef float f32x2v __attribute__((ext_vector_type(2)));
struct EpiIn {
    static constexpr bool PERM = true;
    bf16* base0; const float* b_gate; float qscale;
    __device__ __forceinline__ void operator()(const f32x4 (&acc)[2][2][4][2], const pg8::Unit& u, int wr, int wc, int fr, int fq) const {
        const int colt = u.pn * 256, t = colt >> 10, colw = colt & 1023;
        bf16* base = base0 + (size_t)t * (SLOTB / 2);
        const int row0 = u.pm * 256 + wr * 64 + fr, col0 = colw + wc * 32 + 8 * fq;
        f32x4 bv[2][2];
#pragma unroll
        for (int bj = 0; bj < 2; ++bj)
#pragma unroll
            for (int n = 0; n < 2; ++n) bv[bj][n] = (t >= 5) ? *(const f32x4*)(b_gate + (t - 5) * 1024 + col0 + bj * 128 + 4 * n) : (f32x4){0.f, 0.f, 0.f, 0.f};
#pragma unroll
        for (int ai = 0; ai < 2; ++ai)
#pragma unroll
            for (int m = 0; m < 4; ++m) { bf16* rowp = base + (size_t)(row0 + ai * 128 + m * 16) * D + col0;
#pragma unroll
                for (int bj = 0; bj < 2; ++bj) { f32x4 v0 = acc[ai][bj][m][0], v1 = acc[ai][bj][m][1];
                    if (t == 1) {
#pragma unroll
                        for (int j = 0; j < 4; ++j) { v0[j] = pg8::gelu_tanh(v0[j]); v1[j] = pg8::gelu_tanh(v1[j]); }
                    } else if (t == 2) { v0 = v0 * qscale; v1 = v1 * qscale; }
                    else if (t >= 5) { v0 = v0 + bv[bj][0]; v1 = v1 + bv[bj][1];
#pragma unroll
                        for (int j = 0; j < 4; ++j) { v0[j] = pg8::fast_sigmoid(v0[j]); v1[j] = pg8::fast_sigmoid(v1[j]); } }
                    u32x4 w; w.x = pg8::cvt_pk_bf16(v0[0], v0[1]); w.y = pg8::cvt_pk_bf16(v0[2], v0[3]); w.z = pg8::cvt_pk_bf16(v1[0], v1[1]); w.w = pg8::cvt_pk_bf16(v1[2], v1[3]);
                    *(u32x4*)(rowp + bj * 128) = w; } }
    }
};
struct EpiGate {
    static constexpr bool PERM = true;
    const bf16* gate; const bf16* add; bf16* out;
    __device__ __forceinline__ void operator()(const f32x4 (&acc)[2][2][4][2], const pg8::Unit& u, int wr, int wc, int fr, int fq) const {
        const int rl = wr * 64 + fr, col0 = u.pn * 256 + wc * 32 + 8 * fq;
#pragma unroll
        for (int ai = 0; ai < 2; ++ai)
#pragma unroll
            for (int m = 0; m < 4; ++m) { const int r = rl + ai * 128 + m * 16; const size_t off = (size_t)(u.pm * 256 + r) * D + col0, goff = (size_t)(u.ar + r) * D + col0;
#pragma unroll
                for (int bj = 0; bj < 2; ++bj) { const f32x4 a0 = acc[ai][bj][m][0], a1 = acc[ai][bj][m][1];
                    const u32x4 gw = *(const u32x4*)(gate + goff + bj * 128);
                    u32x4 aw = (u32x4){0u, 0u, 0u, 0u}; if (add) aw = *(const u32x4*)(add + off + bj * 128);
                    const float r0 = bfl(aw.x) + bfl(gw.x) * a0[0], r1 = bfh(aw.x) + bfh(gw.x) * a0[1], r2 = bfl(aw.y) + bfl(gw.y) * a0[2], r3 = bfh(aw.y) + bfh(gw.y) * a0[3];
                    const float r4 = bfl(aw.z) + bfl(gw.z) * a1[0], r5 = bfh(aw.z) + bfh(gw.z) * a1[1], r6 = bfl(aw.w) + bfl(gw.w) * a1[2], r7 = bfh(aw.w) + bfh(gw.w) * a1[3];
                    u32x4 w; w.x = pg8::cvt_pk_bf16(r0, r1); w.y = pg8::cvt_pk_bf16(r2, r3); w.z = pg8::cvt_pk_bf16(r4, r5); w.w = pg8::cvt_pk_bf16(r6, r7);
                    *(u32x4*)(out + off + bj * 128) = w; } }
    }
};
struct EpiZ {
    static constexpr bool PERM = false;
    const float* x; const float* g0; const float* b0; const float* rowstat; float* Z;
    __device__ __forceinline__ void operator()(const f32x4 (&acc)[2][2][4][2], const pg8::Unit& u, int wr, int wc, int fr, int fq) const {
        const int col0 = u.pn * 256 + wc * 32 + 4 * fq;
        f32x4 gv[2][2], bv[2][2];
#pragma unroll
        for (int bj = 0; bj < 2; ++bj)
#pragma unroll
            for (int n = 0; n < 2; ++n) { gv[bj][n] = *(const f32x4*)(g0 + col0 + bj * 128 + n * 16); bv[bj][n] = *(const f32x4*)(b0 + col0 + bj * 128 + n * 16); }
#pragma unroll
        for (int ai = 0; ai < 2; ++ai)
#pragma unroll
            for (int m = 0; m < 4; ++m) { const int r = ai * 128 + wr * 64 + m * 16 + fr; const int p = u.pm * 256 + r, rt = (p >> 12) * TA + NMETA + (p & 4095);
                const float* xr = x + (size_t)p * D; const float mean = rowstat[2 * rt], rstd = rowstat[2 * rt + 1];
#pragma unroll
                for (int bj = 0; bj < 2; ++bj)
#pragma unroll
                    for (int n = 0; n < 2; ++n) { const int c = col0 + bj * 128 + n * 16; const f32x4 xv = *(const f32x4*)(xr + c);
                        const f32x4 h0 = (xv - mean) * rstd * gv[bj][n] + bv[bj][n];
                        *(f32x4*)(Z + (size_t)p * D + c) = h0 * ALPHA + acc[ai][bj][m][n]; } }
    }
};
struct EpiF32 {
    static constexpr bool PERM = false;
    float* out; int ldc;
    __device__ __forceinline__ void operator()(const f32x4 (&acc)[2][2][4][2], const pg8::Unit& u, int wr, int wc, int fr, int fq) const {
        const int col0 = u.pn * 256 + wc * 32 + 4 * fq;
#pragma unroll
        for (int ai = 0; ai < 2; ++ai)
#pragma unroll
            for (int m = 0; m < 4; ++m) { const int row = u.pm * 256 + ai * 128 + wr * 64 + m * 16 + fr;
#pragma unroll
                for (int bj = 0; bj < 2; ++bj)
#pragma unroll
                    for (int n = 0; n < 2; ++n) *(f32x4*)(out + (size_t)row * ldc + col0 + bj * 128 + n * 16) = acc[ai][bj][m][n]; }
    }
};
struct EpiAct {
    static constexpr bool PERM = true;
    bf16* act;
    __device__ __forceinline__ void operator()(const f32x4 (&acc)[2][2][4][2], const pg8::Unit& u, int wr, int wc, int fr, int fq) const {
        const int row0 = u.pm * 256 + wr * 64 + fr, col0 = u.pn * 128 + wc * 32 + 8 * fq;
#pragma unroll
        for (int ai = 0; ai < 2; ++ai)
#pragma unroll
            for (int m = 0; m < 4; ++m) { float r[8];
#pragma unroll
                for (int n = 0; n < 2; ++n)
#pragma unroll
                    for (int j = 0; j < 4; ++j) { const float gte = acc[ai][0][m][n][j], up = acc[ai][1][m][n][j]; r[n * 4 + j] = gte * pg8::fast_sigmoid(gte) * up; }
                u32x4 w; w.x = pg8::cvt_pk_bf16(r[0], r[1]); w.y = pg8::cvt_pk_bf16(r[2], r[3]); w.z = pg8::cvt_pk_bf16(r[4], r[5]); w.w = pg8::cvt_pk_bf16(r[6], r[7]);
                *(u32x4*)(act + (size_t)(row0 + ai * 128 + m * 16) * DE + col0) = w; }
    }
};
struct EpiY {
    static constexpr bool PERM = true;
    bf16* Y;
    __device__ __forceinline__ void operator()(const f32x4 (&acc)[2][2][4][2], const pg8::Unit& u, int wr, int wc, int fr, int fq) const {
        const int r0 = wr * 64 + fr, col0 = u.pn * 256 + wc * 32 + 8 * fq;
#pragma unroll
        for (int ai = 0; ai < 2; ++ai)
#pragma unroll
            for (int m = 0; m < 4; ++m) { const int r = r0 + ai * 128 + m * 16; const int yr = (r < u.nv) ? (u.aux + r) : YDUMMY;
                bf16* rowp = Y + (size_t)yr * D + col0;
#pragma unroll
                for (int bj = 0; bj < 2; ++bj) { const f32x4 v0 = acc[ai][bj][m][0], v1 = acc[ai][bj][m][1];
                    u32x4 w; w.x = pg8::cvt_pk_bf16(v0[0], v0[1]); w.y = pg8::cvt_pk_bf16(v0[2], v0[3]); w.z = pg8::cvt_pk_bf16(v1[0], v1[1]); w.w = pg8::cvt_pk_bf16(v1[2], v1[3]);
                    *(u32x4*)(rowp + bj * 128) = w; } }
    }
};

__device__ __forceinline__ void transpose_item(const float* W, int K, int N, bf16* WT, int row_base, int gu, LAS float* scr, int item, int lane) {
    const int nblk = N / 32, kb = item / nblk, nb = item % nblk, k0 = 64 * kb, n0 = 32 * nb;
    const int r0 = row_base + (gu ? ((n0 >> 7) * 256 + (n0 & 127)) : n0);
#pragma unroll 8
    for (int i = 0; i < 32; ++i) { const int kk = 2 * i + (lane >> 5); scr[kk * 33 + (lane & 31)] = W[(size_t)(k0 + kk) * N + n0 + (lane & 31)]; }
    LDS_WAIT(); asm volatile("" ::: "memory");
    const int c = lane & 7;
#pragma unroll
    for (int j = 0; j < 4; ++j) { const int n = (lane >> 3) + 8 * j; const LAS float* s = scr + (8 * c) * 33 + n;
        v4u o; o.x = pk2(s[0 * 33], s[1 * 33]); o.y = pk2(s[2 * 33], s[3 * 33]); o.z = pk2(s[4 * 33], s[5 * 33]); o.w = pk2(s[6 * 33], s[7 * 33]);
        *(GAS v4u*)(WT + (size_t)(r0 + n) * K + k0 + 8 * c) = o; }
    LDS_WAIT(); asm volatile("" ::: "memory");
}
__device__ __forceinline__ void ln_row_to_bf16(const float* xrow, const float* g, const float* b, bf16* orow, float* stat, int lane) {
    const GAS f32x4* xr = (const GAS f32x4*)xrow + lane;
    f32x4 v[4]; float s = 0.f;
#pragma unroll
    for (int j = 0; j < 4; ++j) { v[j] = xr[64 * j]; s += (v[j].x + v[j].y) + (v[j].z + v[j].w); }
    const float mean = wave_sum(s) * (1.f / D); float s2 = 0.f;
#pragma unroll
    for (int j = 0; j < 4; ++j) { v[j] = v[j] - mean; s2 += (v[j].x * v[j].x + v[j].y * v[j].y) + (v[j].z * v[j].z + v[j].w * v[j].w); }
    const float rstd = 1.f / sqrtf(wave_sum(s2) * (1.f / D) + LN_EPS);
    if (stat && lane == 0) { stat[0] = mean; stat[1] = rstd; }
    GAS unsigned long long* o8 = (GAS unsigned long long*)orow + lane;
#pragma unroll
    for (int j = 0; j < 4; ++j) { const f32x4 gg = *((const f32x4*)g + lane + 64 * j), bb = *((const f32x4*)b + lane + 64 * j); const f32x4 y = v[j] * rstd * gg + bb;
        o8[64 * j] = (unsigned long long)pk2(y.x, y.y) | ((unsigned long long)pk2(y.z, y.w) << 32); }
}

__device__ __forceinline__ int crow16(int r, int hi) { return (r & 3) + 8 * (r >> 2) + 4 * hi; }
typedef float f32x16 __attribute__((ext_vector_type(16)));
struct ScanArgs { const bf16* XR; const bf16* YG; bf16* REC; const float* conv_w; const float* conv_b; const bf16* lruwt; const float* b_a; const float* b_i; const float* lam; float* scansum; };
__device__ __forceinline__ float xlane32(float v) { return __shfl_xor(v, 32); }
template <bool FINAL>
__device__ __forceinline__ void scan_phase(const ScanArgs& A, LAS unsigned char* lds, int vcu, int G) {
    const int tid = threadIdx.x, lane = tid & 63, wave = __builtin_amdgcn_readfirstlane(tid >> 6);
    const int nb = vcu & 7, cun = vcu >> 3, nslots = (G >> 3) * 8;
    const int cc = lane & 15, rg = lane >> 4;
    const int l31 = lane & 31, hi = lane >> 5;
#pragma unroll
    for (int i = 0; i < 8; ++i) { const int idx = tid + 512 * i, n = idx >> 4, ch = idx & 15; const int gt = n >> 7, col = n & 127;
        const v4u w = *(const v4u*)(A.lruwt + ((size_t)((gt * 8 + nb) * 128 + col)) * 128 + ch * 8);
        *(LAS v4u*)(lds + n * 272 + ch * 16) = w; }
    __syncthreads();
    constexpr int SPW = 272;
    LAS unsigned char* TL = lds + (wave < 7 ? 256 * SPW + wave * 32 * SPW : LDSCTL_OFF + 1024);
    LAS unsigned char* const WLb = lds + l31 * SPW + hi * 16;
    LAS unsigned char* const TLa = TL + l31 * SPW + hi * 16;
    LAS unsigned char* const TLx = TL + hi * (4 * SPW) + l31 * 2;
    LAS unsigned char* const TLs = TL + rg * (8 * SPW) + cc * 16;
    LAS float* CWL = (LAS float*)(lds + LDSCTL_OFF + 1024 + 32 * SPW);
    if (tid < 160) { const int k = tid >> 5, c4 = (tid & 31) * 4; const f32x4 w = (k < 4) ? *(const f32x4*)(A.conv_w + k * D + nb * 128 + c4) : *(const f32x4*)(A.conv_b + nb * 128 + c4); *(LAS f32x4*)(CWL + k * 128 + c4) = w; }
    __syncthreads();
    float gba[4], gbi[4], gk8[4];
#pragma unroll
    for (int q = 0; q < 4; ++q) { const int C = nb * 128 + 32 * q + l31; gba[q] = A.b_a[C]; gbi[q] = A.b_i[C]; const float lm = A.lam[C];
        const float sp = (-lm > 20.f) ? -lm : log1pf(__expf(-lm)); gk8[q] = -8.0f * sp * 1.4426950408889634f; }
    for (int wv = cun * 8 + wave; wv < 256; wv += nslots) {
        const int b = wv >> 5, ri = wv & 31; const int sb0 = ri == 0 ? 0 : 4 * ri + 1, nsb = ri == 0 ? 5 : 4;
        const size_t rowb = (size_t)b * TA;
        float hc[4], Ac[4];
#pragma unroll
        for (int q = 0; q < 4; ++q) { hc[q] = 0.f; Ac[q] = 1.f; }
        if (FINAL) {
            float h0 = 0.f, h1 = 0.f;
#pragma unroll 1
            for (int j0 = 0; j0 < ri; j0 += 8) { f32x4 s[8];
#pragma unroll
                for (int i = 0; i < 8; ++i) { const int j = j0 + i; const int jc = j < ri ? j : 0; s[i] = *(const f32x4*)(A.scansum + ((size_t)(b * 32 + jc) * D + nb * 128 + 2 * lane) * 2); if (j >= ri) s[i] = (f32x4){1.f, 0.f, 1.f, 0.f}; }
#pragma unroll
                for (int i = 0; i < 8; ++i) { h0 = s[i].x * h0 + s[i].y; h1 = s[i].z * h1 + s[i].w; } }
            ((LAS float*)TL)[2 * lane] = h0; ((LAS float*)TL)[2 * lane + 1] = h1;
            asm volatile("s_waitcnt lgkmcnt(0)" ::: "memory");
#pragma unroll
            for (int q = 0; q < 4; ++q) hc[q] = ((LAS float*)TL)[32 * q + l31];
            asm volatile("s_waitcnt lgkmcnt(0)" ::: "memory");
        }
#pragma unroll 1
        for (int s = 0; s < nsb; ++s) {
            const int t0 = 32 * (sb0 + s);
            v4u xv[11];
#pragma unroll
            for (int i = 0; i < 11; ++i) { int tt = t0 + 8 * rg - 3 + i; tt = tt < 0 ? 0 : tt; xv[i] = *(const v4u*)(A.XR + (rowb + tt) * D + nb * 128 + cc * 8); }
            { f32x4 w0[4], w1[4];
#pragma unroll
              for (int k = 0; k < 4; ++k) { w0[k] = *(const LAS f32x4*)(CWL + k * 128 + cc * 8); w1[k] = *(const LAS f32x4*)(CWL + k * 128 + cc * 8 + 4); }
              const f32x4 cb0 = *(const LAS f32x4*)(CWL + 4 * 128 + cc * 8), cb1 = *(const LAS f32x4*)(CWL + 4 * 128 + cc * 8 + 4);
#pragma unroll
              for (int i = 0; i < 8; ++i) { float o[8]; o[0] = cb0.x; o[1] = cb0.y; o[2] = cb0.z; o[3] = cb0.w; o[4] = cb1.x; o[5] = cb1.y; o[6] = cb1.z; o[7] = cb1.w;
#pragma unroll
                for (int k = 0; k < 4; ++k) { const float ok = (t0 + 8 * rg + i - 3 + k >= 0) ? 1.0f : 0.0f; const v4u x4 = xv[i + k]; const f32x4 a0 = w0[k] * ok, a1 = w1[k] * ok;
                    o[0] += a0.x * bfl(x4.x); o[1] += a0.y * bfh(x4.x); o[2] += a0.z * bfl(x4.y); o[3] += a0.w * bfh(x4.y);
                    o[4] += a1.x * bfl(x4.z); o[5] += a1.y * bfh(x4.z); o[6] += a1.z * bfl(x4.w); o[7] += a1.w * bfh(x4.w); }
                v4u w; w.x = pk2(o[0], o[1]); w.y = pk2(o[2], o[3]); w.z = pk2(o[4], o[5]); w.w = pk2(o[6], o[7]);
                *(LAS v4u*)(TLs + i * SPW) = w; } }
            asm volatile("s_waitcnt lgkmcnt(0)" ::: "memory");
            bf16x8 af[8];
#pragma unroll
            for (int k8 = 0; k8 < 8; ++k8) af[k8] = *(const LAS bf16x8*)(TLa + k8 * 32);
#pragma unroll
            for (int hh = 0; hh < 2; ++hh) {
                f32x16 acc[2][2];
#pragma unroll
                for (int gt = 0; gt < 2; ++gt)
#pragma unroll
                    for (int cb = 0; cb < 2; ++cb) acc[gt][cb] = f32x16{};
#pragma unroll
                for (int k8 = 0; k8 < 8; ++k8) {
#pragma unroll
                    for (int gt = 0; gt < 2; ++gt)
#pragma unroll
                        for (int cb = 0; cb < 2; ++cb) {
                            const bf16x8 bfv = *(const LAS bf16x8*)(WLb + (gt * 128 + 64 * hh + 32 * cb) * SPW + k8 * 32);
                            acc[gt][cb] = __builtin_amdgcn_mfma_f32_32x32x16_bf16(af[k8], bfv, acc[gt][cb], 0, 0, 0); }
                }
#pragma unroll
                for (int cb = 0; cb < 2; ++cb) { const int q = 2 * hh + cb, c = 32 * q + l31;
                    float av[16], bt[16];
#pragma unroll
                    for (int rr = 0; rr < 16; ++rr) { const int row = crow16(rr, hi);
                        const float rgt = pg8::fast_sigmoid(acc[0][cb][rr] + gba[q]), igt = pg8::fast_sigmoid(acc[1][cb][rr] + gbi[q]);
                        const float a = __builtin_amdgcn_exp2f(gk8[q] * rgt); float mult = sqrtf(fmaxf(1.0f - a * a, 0.f));
                        if (t0 + row == 0) mult = 1.0f;
                        const float xc = bf1(*(const LAS bf16*)(TLx + crow16(rr, 0) * SPW + q * 64));
                        av[rr] = a; bt[rr] = mult * igt * xc; }
                    float Ao[4], Bo[4], Ap[4], Bp[4];
#pragma unroll
                    for (int j = 0; j < 4; ++j) { float Ag = av[4 * j], Bg = bt[4 * j];
#pragma unroll
                        for (int k = 1; k < 4; ++k) { Bg = av[4 * j + k] * Bg + bt[4 * j + k]; Ag *= av[4 * j + k]; }
                        Ao[j] = Ag; Bo[j] = Bg; Ap[j] = xlane32(Ag); Bp[j] = xlane32(Bg); }
                    float h = hc[q]; float hin[4];
#pragma unroll
                    for (int j = 0; j < 4; ++j) {
                        const float Ae = hi ? Ap[j] : Ao[j], Be = hi ? Bp[j] : Bo[j], Aod = hi ? Ao[j] : Ap[j], Bod = hi ? Bo[j] : Bp[j];
                        const float h_even_in = h; const float h_odd_in = Ae * h + Be; h = Aod * h_odd_in + Bod;
                        hin[j] = hi ? h_odd_in : h_even_in; Ac[q] *= Ae * Aod; }
                    hc[q] = h;
                    if (FINAL) {
#pragma unroll
                        for (int j = 0; j < 4; ++j) { float hh2 = hin[j];
#pragma unroll
                            for (int k = 0; k < 4; ++k) { const int rr = 4 * j + k, row = crow16(rr, hi); hh2 = av[rr] * hh2 + bt[rr];
                                *(LAS bf16*)(TLx + crow16(rr, 0) * SPW + q * 64) = (bf16)f2bf(hh2); } } }
                }
            }
            if (FINAL) {
                v4u yv[8];
#pragma unroll
                for (int i = 0; i < 8; ++i) yv[i] = *(const v4u*)(A.YG + (rowb + t0 + 8 * rg + i) * D + nb * 128 + cc * 8);
                asm volatile("s_waitcnt lgkmcnt(0)" ::: "memory");
#pragma unroll
                for (int i = 0; i < 8; ++i) { const int row = 8 * rg + i; const v4u hv = *(const LAS v4u*)(TLs + i * SPW); const v4u y = yv[i];
                    v4u o; o.x = pk2(bfl(hv.x) * bfl(y.x), bfh(hv.x) * bfh(y.x)); o.y = pk2(bfl(hv.y) * bfl(y.y), bfh(hv.y) * bfh(y.y)); o.z = pk2(bfl(hv.z) * bfl(y.z), bfh(hv.z) * bfh(y.z)); o.w = pk2(bfl(hv.w) * bfl(y.w), bfh(hv.w) * bfh(y.w));
                    *(v4u*)(A.REC + (rowb + t0 + row) * D + nb * 128 + cc * 8) = o; }
                asm volatile("s_waitcnt lgkmcnt(0)" ::: "memory");
            }
        }
        if (!FINAL && hi == 0) {
#pragma unroll
            for (int q = 0; q < 4; ++q) { float* sm = A.scansum + ((size_t)(b * 32 + ri) * D + nb * 128 + 32 * q + l31) * 2; sm[0] = Ac[q]; sm[1] = hc[q]; } }
    }
    __syncthreads();
}

__device__ __forceinline__ void route_token(const float* logits, const float* rbias, int row, unsigned* cnt, int* list, float* tokw, int lane) {
    const f32x4 lg = *((const f32x4*)(logits + (size_t)row * NE) + lane); const f32x4 rb = *((const f32x4*)rbias + lane);
    float sc[4], sel[4];
#pragma unroll
    for (int j = 0; j < 4; ++j) { sc[j] = 1.0f / (1.0f + expf(-lg[j])); sel[j] = sc[j] + rb[j]; }
    float m1 = fmaxf(sel[0], sel[1]), m2 = fminf(sel[0], sel[1]);
#pragma unroll
    for (int j = 2; j < 4; ++j) { const float v = sel[j]; m2 = fmaxf(m2, fminf(m1, v)); m1 = fmaxf(m1, v); }
#pragma unroll
    for (int o = 1; o < 8; o <<= 1) { const float o1 = __shfl_xor(m1, o), o2 = __shfl_xor(m2, o); m2 = fmaxf(fminf(m1, o1), fmaxf(m2, o2)); m1 = fmaxf(m1, o1); }
    const float gs = m1 + m2; const int g = lane >> 3; int rank = 0;
#pragma unroll
    for (int gg = 0; gg < 8; ++gg) { const float og = __shfl(gs, gg * 8); rank += (og > gs || (og == gs && gg < g)) ? 1 : 0; }
    const bool gsel = rank < 4;
#pragma unroll
    for (int j = 0; j < 4; ++j) if (!gsel) sel[j] = -INFINITY;
    float wk = 0.f; int ek = 0; float ssum = 0.f;
#pragma unroll 1
    for (int k = 0; k < TOPK; ++k) {
        float bv = sel[0]; int bi = 4 * lane;
#pragma unroll
        for (int j = 1; j < 4; ++j) if (sel[j] > bv) { bv = sel[j]; bi = 4 * lane + j; }
#pragma unroll
        for (int o = 1; o < 64; o <<= 1) { const float ov = __shfl_xor(bv, o); const int oi = __shfl_xor(bi, o); if (ov > bv || (ov == bv && oi < bi)) { bv = ov; bi = oi; } }
        const int own = bi >> 2, jj = bi & 3;
        float s = 0.f;
        if (lane == own) {
#pragma unroll
            for (int j = 0; j < 4; ++j) if (j == jj) { s = sc[j]; sel[j] = -INFINITY; } }
        s = __shfl(s, own);
        ssum += s; if (lane == k) { wk = s; ek = bi; }
    }
    if (lane < TOPK) { const float w = wk / ssum * ROUTED_SCALE; const unsigned pos = atomicAdd(cnt + ek, 1u); if (pos < (unsigned)CAP) list[(size_t)ek * CAP + pos] = (row << 4) | lane; tokw[(size_t)row * 16 + lane] = w; }
}

struct Args { const float* in[33]; float* out; unsigned char* ws; int ph_lo, ph_hi, li, pad; };
__global__ void __launch_bounds__(NWAVES * 64, 2) mega_fwd(Args args) {
    extern __shared__ __attribute__((aligned(16))) unsigned char lds[];
    LAS unsigned char* L = (LAS unsigned char*)lds;
    volatile LAS unsigned* MISC = (volatile LAS unsigned*)(L + MISC_OFF);
    const int tid = threadIdx.x, lane = tid & 63, wave = __builtin_amdgcn_readfirstlane(tid >> 6);
    const int G = gridDim.x; const int bx = blockIdx.x; const int vcu = (G % 8 == 0) ? (bx % 8) * (G / 8) + bx / 8 : bx;
    unsigned char* ws = args.ws;
    gu32* ctl = (gu32*)(ws + WS_CTL);
    for (int u = tid; u < (LDS_BYTES - LDSCTL_OFF) / 4; u += NWAVES * 64) ((LAS unsigned*)(L + LDSCTL_OFF))[u] = 0u;
    __syncthreads();
    XcdBarrier bar; bar.bar = (unsigned*)(ctl + CW_BAR); bar.x = 0; bar.st = nullptr;
    if (N_LAUNCHES == 1) bar = xcd_barrier_post((unsigned*)(ctl + CW_BAR), MISC + 8);
#define GRID_BAR() do { if (N_LAUNCHES == 1) xcd_barrier(bar); } while (0)
#if MK_DIAG
    int n_stamp = 0;
#define STAMP() do { if (blockIdx.x == 0 && tid == 0) { ((unsigned long long*)(ctl + CW_DIAG))[n_stamp] = __builtin_amdgcn_s_memrealtime(); } ++n_stamp; } while (0)
#else
#define STAMP() do {} while (0)
#endif
    STAMP();
    const int lo = args.ph_lo, hi = args.ph_hi;
#ifndef MK_REPEAT_MASK
#define MK_REPEAT_MASK 0
#endif
#ifndef MK_PHASE_MASK
#define MK_PHASE_MASK 0xffff
#endif
#define IN(k) ((((MK_PHASE_MASK) >> (k)) & 1) && lo <= (k) && (k) < hi)
#define BOTH(k) (IN(k) && IN((k) + 1))
    const int gw = vcu * NWAVES + wave, NGW = G * NWAVES;
    const float* x = args.in[0]; const float* meta = args.in[1];

    if (IN(0)) {
        LAS float* scr = (LAS float*)(L + RING_OFF + wave * 16384);
        constexpr int I_IN = 16 * (NIN / 32), I_SQ = 16 * 32, I_RT = 16 * 8, I_LRU = 2 * 8 * 2 * 4;
        constexpr int NITEMS = I_IN + 3 * I_SQ + I_RT + I_LRU;
        for (int it = gw; it < NITEMS; it += NGW) {
            int r = it;
            if (r < I_IN) { transpose_item(args.in[4], D, NIN, (bf16*)(ws + WS_WIN), 0, 0, scr, r, lane); continue; } r -= I_IN;
            if (r < I_SQ) { transpose_item(args.in[18], D, D, (bf16*)(ws + WS_WR), 0, 0, scr, r, lane); continue; } r -= I_SQ;
            if (r < I_SQ) { transpose_item(args.in[19], D, D, (bf16*)(ws + WS_WA), 0, 0, scr, r, lane); continue; } r -= I_SQ;
            if (r < I_SQ) { transpose_item(args.in[20], D, D, (bf16*)(ws + WS_WO), 0, 0, scr, r, lane); continue; } r -= I_SQ;
            if (r < I_RT) { transpose_item(args.in[23], D, NE, (bf16*)(ws + WS_WROUT), 0, 0, scr, r, lane); continue; } r -= I_RT;
            { const int m = r >> 3, it2 = r & 7, gt = m >> 3, blk = m & 7;
              transpose_item(args.in[gt ? 10 : 8] + (size_t)blk * 128 * 128, 128, 128, (bf16*)(ws + WS_LRUWT) + (size_t)(gt * 8 + blk) * 128 * 128, 0, 0, scr, it2, lane); }
        }
        for (int m = gw; m < MA; m += NGW) { const int b = m / TA, t = m - b * TA; bf16* orow = (bf16*)(ws + WS_XN) + (size_t)m * D;
            if (t < TV) { const float* xr = (t < NMETA) ? meta + (size_t)t * D : x + ((size_t)b * SEQ + (t - NMETA)) * D;
                ln_row_to_bf16(xr, args.in[2], args.in[3], orow, (float*)(ws + WS_ROWSTAT) + 2 * (size_t)m, lane); }
            else { GAS unsigned long long* o8 = (GAS unsigned long long*)orow + lane;
#pragma unroll
                for (int j = 0; j < 4; ++j) o8[64 * j] = 0ull; } }
        if (BOTH(0)) GRID_BAR();
        STAMP();
    }
    if (IN(1)) {
        pg8::Gemm g{(const bf16*)(ws + WS_XN), (const bf16*)(ws + WS_WIN), D, 0}; DenseOrder S; S.init(MA, NIN, G, bx);
        EpiIn E{(bf16*)(ws + WS_XR), args.in[5], 0.125f * 1.4426950408889634f};
        pg8::gemm_phase<EpiIn, DenseOrder, true, false>(L + RING_OFF, g, S, E);
        if (BOTH(1)) GRID_BAR();
        STAMP();
    }
    ScanArgs SA{(const bf16*)(ws + WS_XR), (const bf16*)(ws + WS_YG), (bf16*)(ws + WS_REC), args.in[6], args.in[7], (const bf16*)(ws + WS_LRUWT), args.in[9], args.in[11], args.in[12], (float*)(ws + WS_SCANSUM)};
    if (IN(2)) {
        scan_phase<false>(SA, L + RING_OFF, vcu, G);
        if (BOTH(2)) GRID_BAR();
        STAMP();
    }
    if (IN(3)) {
        scan_phase<true>(SA, L + RING_OFF, vcu, G);
        { const int bh = vcu >> 2, sub = vcu & 3, m = sub >> 1, half = sub & 1, b = bh >> 3, h = bh & 7;
          if (bh < NB * 8) {
              const attn_body::AttnTensors AT{(const attn_body::bf16*)(ws + WS_Q), (const attn_body::bf16*)(ws + WS_K), (const attn_body::bf16*)(ws + WS_V), (attn_body::bf16*)(ws + (m ? WS_O1 : WS_O0))};
              const attn_body::FixedOrder AS{b, 2 * h + m, 2 * h + half};
              attn_body::attn_phase<attn_body::FixedOrder>((char*)lds + RING_OFF, AT, AS);
          } }
        if (BOTH(3)) GRID_BAR();
        STAMP();
    }
    if (IN(4)) {
        const float lamq = wave_sum(args.in[13][lane] * args.in[14][lane]), lamq2 = wave_sum(args.in[15][lane] * args.in[16][lane]);
        const float lam = expf(lamq) - expf(lamq2) + LAMBDA_INIT;
        const bf16* O0 = (const bf16*)(ws + WS_O0); const bf16* O1 = (const bf16*)(ws + WS_O1); bf16* ATT = (bf16*)(ws + WS_ATT);
        for (int m = gw; m < MA; m += NGW) {
#pragma unroll
            for (int j = 0; j < 2; ++j) { const int c = j * 512 + lane * 8; const v4u a = *(const v4u*)(O0 + (size_t)m * D + c), bq = *(const v4u*)(O1 + (size_t)m * D + c);
                float d[8]; d[0] = bfl(a.x) - lam * bfl(bq.x); d[1] = bfh(a.x) - lam * bfh(bq.x); d[2] = bfl(a.y) - lam * bfl(bq.y); d[3] = bfh(a.y) - lam * bfh(bq.y);
                d[4] = bfl(a.z) - lam * bfl(bq.z); d[5] = bfh(a.z) - lam * bfh(bq.z); d[6] = bfl(a.w) - lam * bfl(bq.w); d[7] = bfh(a.w) - lam * bfh(bq.w);
                float ss = 0.f;
#pragma unroll
                for (int q = 0; q < 8; ++q) ss += d[q] * d[q];
                ss += __shfl_xor(ss, 1); ss += __shfl_xor(ss, 2); ss += __shfl_xor(ss, 4); ss += __shfl_xor(ss, 8);
                const float rs = (1.0f - LAMBDA_INIT) / sqrtf(ss * (1.0f / 128.f) + LN_EPS);
                const int e0 = c & 127; const f32x4 g0 = *(const f32x4*)(args.in[17] + e0), g1 = *(const f32x4*)(args.in[17] + e0 + 4);
                v4u w; w.x = pk2(d[0] * rs * g0.x, d[1] * rs * g0.y); w.y = pk2(d[2] * rs * g0.z, d[3] * rs * g0.w); w.z = pk2(d[4] * rs * g1.x, d[5] * rs * g1.y); w.w = pk2(d[6] * rs * g1.z, d[7] * rs * g1.w);
                *(v4u*)(ATT + (size_t)m * D + c) = w; } }
        if (BOTH(4)) GRID_BAR();
        STAMP();
    }
    if (IN(5)) {
        pg8::Gemm g{(const bf16*)(ws + WS_REC), (const bf16*)(ws + WS_WR), D, 0}; DenseOrder S; S.init(NVALID, D, G, bx, 1);
        EpiGate E{(const bf16*)(ws + WS_GR), nullptr, (bf16*)(ws + WS_T1)};
        pg8::gemm_phase<EpiGate, DenseOrder, true, false>(L + RING_OFF, g, S, E);
        if (BOTH(5)) GRID_BAR();
        STAMP();
    }
    if (IN(6)) {
        pg8::Gemm g{(const bf16*)(ws + WS_ATT), (const bf16*)(ws + WS_WA), D, 0}; DenseOrder S; S.init(NVALID, D, G, bx, 1);
        EpiGate E{(const bf16*)(ws + WS_GA), (const bf16*)(ws + WS_T1), (bf16*)(ws + WS_U)};
        pg8::gemm_phase<EpiGate, DenseOrder, true, false>(L + RING_OFF, g, S, E);
        if (BOTH(6)) GRID_BAR();
        STAMP();
    }
    if (IN(7)) {
        pg8::Gemm g{(const bf16*)(ws + WS_U), (const bf16*)(ws + WS_WO), D, 0}; DenseOrder S; S.init(NVALID, D, G, bx, 0);
        EpiZ E{x, args.in[2], args.in[3], (const float*)(ws + WS_ROWSTAT), (float*)(ws + WS_Z)};
        pg8::gemm_phase<EpiZ, DenseOrder, true, false>(L + RING_OFF, g, S, E);
        if (BOTH(7)) GRID_BAR();
        STAMP();
    }
    if (IN(8)) {
        for (int m = gw; m < NVALID; m += NGW) ln_row_to_bf16((const float*)(ws + WS_Z) + (size_t)m * D, args.in[21], args.in[22], (bf16*)(ws + WS_H1B) + (size_t)m * D, nullptr, lane);
        if (BOTH(8)) GRID_BAR();
        STAMP();
    }
    if (IN(9)) {
        { pg8::Gemm g{(const bf16*)(ws + WS_H1B), (const bf16*)(ws + WS_WROUT), D, 0}; DenseOrder S; S.init(NVALID, NE, G, bx, 0);
          EpiF32 E{(float*)(ws + WS_LOGITS), NE};
          pg8::gemm_phase<EpiF32, DenseOrder, false, false>(L + RING_OFF, g, S, E); }
        LAS float* scr = (LAS float*)(L + RING_OFF + wave * 16384);
        constexpr int IPE = 128;
        for (int it = gw; it < 257 * 3 * IPE; it += NGW) { const int e = it / (3 * IPE), r = it - e * 3 * IPE, which = r / IPE, i2 = r - which * IPE;
            if (which < 2) { const float* W = (e < NE) ? args.in[25 + which] + (size_t)e * D * DE : args.in[28 + which];
                transpose_item(W, D, DE, (bf16*)(ws + WS_WGU), e * 512 + which * 128, 1, scr, i2, lane); }
            else { const float* W = (e < NE) ? args.in[27] + (size_t)e * DE * D : args.in[30];
                transpose_item(W, DE, D, (bf16*)(ws + WS_WD) + (size_t)e * D * DE, 0, 0, scr, i2, lane); } }
        if (BOTH(9)) GRID_BAR();
        STAMP();
    }
    if (IN(10)) {
        for (int p = gw; p < NVALID; p += NGW) { const int row = p;
            route_token((const float*)(ws + WS_LOGITS), args.in[24], row, (unsigned*)(ctl + CW_CNT), (int*)(ws + WS_LIST), (float*)(ws + WS_TOKW), lane); }
        if (BOTH(10)) GRID_BAR();
        STAMP();
    }
    if (IN(11) || IN(12)) {
        volatile LAS unsigned* TT = (volatile LAS unsigned*)(L + TT_OFF); volatile LAS int* UB = (volatile LAS int*)(L + UB_OFF);
        const unsigned* cnt = (const unsigned*)(ctl + CW_CNT);
        volatile LAS int* CN = (volatile LAS int*)(L + CN_OFF); volatile LAS int* TB = (volatile LAS int*)(L + TB_OFF);
        if (tid <= NE) { int c = (tid == NE) ? NVALID : (int)__hip_atomic_load(cnt + tid, RLX_AGENT); if (c > CAP) c = CAP; CN[tid] = c; }
        __syncthreads();
        if (tid == 0) { int tb = 0, ub = 0;
            for (int e = 0; e <= NE; ++e) { const int c = CN[e]; int ntl = (c + 255) >> 8; if (tb + ntl > MAXTILES) ntl = MAXTILES - tb; UB[e] = ub; TB[e] = tb; ub += c; tb += ntl; }
            TB[NE + 1] = tb; MISC[16] = (unsigned)tb; }
        __syncthreads();
        if (tid <= NE) { const int t0 = TB[tid], t1 = TB[tid + 1]; for (int t = t0; t < t1; ++t) TT[t] = (unsigned)tid | ((unsigned)(t - t0) << 16); }
        __syncthreads();
        const int ntiles = (int)MISC[16];
        if (IN(11)) {
            pg8::Gemm g{(const bf16*)(ws + WS_H1B), (const bf16*)(ws + WS_WGU), D, (size_t)512 * D};
            MoeOrder<2> S{ntiles, G, vcu, TT, UB, CN, (const int*)(ws + WS_LIST), (int*)(ws + WS_TOKSLOT), 1};
            EpiAct E{(bf16*)(ws + WS_ACT)};
            pg8::gemm_phase<EpiAct, MoeOrder<2>, true, true>(L + RING_OFF, g, S, E);
            if (BOTH(11)) GRID_BAR();
            STAMP();
        STAMP();
        }
        if (IN(12)) {
            pg8::Gemm g{(const bf16*)(ws + WS_ACT), (const bf16*)(ws + WS_WD), DE, (size_t)D * DE};
            MoeOrder<4> S{ntiles, G, vcu, TT, UB, CN, (const int*)(ws + WS_LIST), (int*)(ws + WS_TOKSLOT), 0};
            EpiY E{(bf16*)(ws + WS_Y)};
            pg8::gemm_phase<EpiY, MoeOrder<4>, true, false>(L + RING_OFF, g, S, E);
            if (BOTH(12)) GRID_BAR();
            STAMP();
        STAMP();
        }
    }
    if (IN(13)) {
        const bf16* H1 = (const bf16*)(ws + WS_H1B); const bf16* Y = (const bf16*)(ws + WS_Y); const int* tokslot = (const int*)(ws + WS_TOKSLOT); const float* tokw = (const float*)(ws + WS_TOKW);
        unsigned poison = __hip_atomic_load(ctl + CW_BAR + XB_TMO, RLX_AGENT) != 0u;
        for (int p = gw; p < NVALID; p += NGW) { const int row = p;
            float z[2][8];
#pragma unroll
            for (int j = 0; j < 2; ++j) { const int c = j * 512 + lane * 8; const v4u a = *(const v4u*)(H1 + (size_t)row * D + c);
                z[j][0] = ALPHA * bfl(a.x); z[j][1] = ALPHA * bfh(a.x); z[j][2] = ALPHA * bfl(a.y); z[j][3] = ALPHA * bfh(a.y); z[j][4] = ALPHA * bfl(a.z); z[j][5] = ALPHA * bfh(a.z); z[j][6] = ALPHA * bfl(a.w); z[j][7] = ALPHA * bfh(a.w); }
#pragma unroll
            for (int k = 0; k <= TOPK; ++k) { const int yr = (k < TOPK) ? tokslot[(size_t)row * 16 + k] : YSHARED + p; const float w = (k < TOPK) ? tokw[(size_t)row * 16 + k] : 1.0f;
#pragma unroll
                for (int j = 0; j < 2; ++j) { const int c = j * 512 + lane * 8; const v4u a = *(const v4u*)(Y + (size_t)yr * D + c);
                    z[j][0] += w * bfl(a.x); z[j][1] += w * bfh(a.x); z[j][2] += w * bfl(a.y); z[j][3] += w * bfh(a.y); z[j][4] += w * bfl(a.z); z[j][5] += w * bfh(a.z); z[j][6] += w * bfl(a.w); z[j][7] += w * bfh(a.w); } }
            float s = 0.f;
#pragma unroll
            for (int j = 0; j < 2; ++j)
#pragma unroll
                for (int q = 0; q < 8; ++q) s += z[j][q];
            const float mean = wave_sum(s) * (1.f / D); float s2 = 0.f;
#pragma unroll
            for (int j = 0; j < 2; ++j)
#pragma unroll
                for (int q = 0; q < 8; ++q) { z[j][q] -= mean; s2 += z[j][q] * z[j][q]; }
            const float rstd = 1.f / sqrtf(wave_sum(s2) * (1.f / D) + LN_EPS);
            float* orow = args.out + (size_t)p * D;
#pragma unroll
            for (int j = 0; j < 2; ++j) { const int c = j * 512 + lane * 8;
#pragma unroll
                for (int q4 = 0; q4 < 2; ++q4) { const f32x4 gg = *(const f32x4*)(args.in[31] + c + 4 * q4), bb = *(const f32x4*)(args.in[32] + c + 4 * q4);
                    f32x4 o; o.x = z[j][4 * q4] * rstd * gg.x + bb.x; o.y = z[j][4 * q4 + 1] * rstd * gg.y + bb.y; o.z = z[j][4 * q4 + 2] * rstd * gg.z + bb.z; o.w = z[j][4 * q4 + 3] * rstd * gg.w + bb.w;
                    if (poison) o = (f32x4){__builtin_nanf(""), __builtin_nanf(""), __builtin_nanf(""), __builtin_nanf("")};
                    *(f32x4*)(orow + c + 4 * q4) = o; } } }
    }
#if MK_DIAG
    GRID_BAR(); STAMP();
    if (blockIdx.x == 0 && tid == 0) { const unsigned long long* ts = (const unsigned long long*)(ctl + CW_DIAG);
      const unsigned long long a0 = __hip_atomic_load(ts + MK_DIAG_S1, RLX_AGENT), a1 = __hip_atomic_load(ts + MK_DIAG_S1 + 1, RLX_AGENT);
      args.out[0] = 40.0f + (float)(a1 - a0) * 0.01f; }
#endif
#undef IN
#undef BOTH
#undef GRID_BAR
}

extern "C" void kernel_launch(void* const* d_in, const int* in_sizes, int n_in, void* d_out, int out_size, void* d_ws, size_t ws_size, hipStream_t stream) {
    static int grid = 0;
    if (grid == 0) {
        if (n_in != 33 || in_sizes[0] != NB * SEQ * D || out_size != NB * SEQ * D || ws_size < WS_END) { fprintf(stderr, "kernel_launch: unexpected shapes / workspace (n_in %d, in0 %d, out %d, ws %zu < %zu); nothing launched\n", n_in, n_in > 0 ? in_sizes[0] : -1, out_size, ws_size, (size_t)WS_END); grid = -1; return; }
        int dev = 0, cus = 0;
        if (hipGetDevice(&dev) != hipSuccess || hipDeviceGetAttribute(&cus, hipDeviceAttributeMultiprocessorCount, dev) != hipSuccess) { grid = -1; return; }
        if (hipFuncSetAttribute((const void*)mega_fwd, hipFuncAttributeMaxDynamicSharedMemorySize, LDS_BYTES) != hipSuccess) { fprintf(stderr, "kernel_launch: hipFuncSetAttribute failed\n"); grid = -1; return; }
        int per_cu = 0;
        if (hipOccupancyMaxActiveBlocksPerMultiprocessor(&per_cu, (const void*)mega_fwd, NWAVES * 64, LDS_BYTES) != hipSuccess || per_cu < 1) fprintf(stderr, "kernel_launch: occupancy query says %d\n", per_cu);
        (void)hipGetLastError();
        grid = cus;
    }
    if (grid < 0) return;
    if (hipMemsetAsync((char*)d_ws + WS_CTL, 0, CTL_ZERO_BYTES, stream) != hipSuccess) return;
    Args a{};
    for (int i = 0; i < 33; ++i) a.in[i] = (const float*)d_in[i];
    a.out = (float*)d_out; a.ws = (unsigned char*)d_ws;
    if (N_LAUNCHES == 1) { a.ph_lo = 0; a.ph_hi = NPHASE; a.li = 0; hipLaunchKernelGGL(mega_fwd, dim3(grid), dim3(NWAVES * 64), LDS_BYTES, stream, a); }
    else for (int li = 0; li < NPHASE; ++li) { a.ph_lo = li; a.ph_hi = li + 1; a.li = li; for (int rep = 0; rep < (((MK_REPEAT_MASK) >> li) & 1) + 1; ++rep) hipLaunchKernelGGL(mega_fwd, dim3(grid), dim3(NWAVES * 64), LDS_BYTES, stream, a); }
}
```

```cpp
#include <hip/hip_runtime.h>
#include <hip/hip_bf16.h>
#include <cstdio>
#include <cstdint>
#include <cmath>
namespace pg8 {
#define PG8_LAS __attribute__((address_space(3)))
typedef unsigned short bf16_t;
typedef short bf16x8 __attribute__((ext_vector_type(8)));
typedef float f32x4 __attribute__((ext_vector_type(4)));
typedef float f32x2 __attribute__((ext_vector_type(2)));
typedef unsigned u32x4 __attribute__((ext_vector_type(4)));
constexpr int BM = 256, BK = 64, HALF = 128, HTB = HALF * BK * 2  , STAGE_BYTES = 8 * HTB;

__host__ __device__ __forceinline__ int lds_byte(int r, int c) { const int st = (r >> 4) * 2 + (c >> 5), rr = r & 15, cc = c & 31, ob = rr * 64 + cc * 2; return st * 1024 + (ob ^ (((ob >> 9) & 1) << 5)); }
__host__ __device__ __forceinline__ void stage_rc(int b, int& R, int& C) { const int st = b / 1024, sb = b % 1024, swz = sb ^ (((sb >> 9) & 1) << 5); R = (st >> 1) * 16 + swz / 64; C = (st & 1) * 32 + (swz % 64) / 2; }
__host__ __device__ __forceinline__ int perm32(int rho) { const int n = rho >> 4, i = rho & 15; return 8 * (i >> 2) + 4 * n + (i & 3); }

struct Unit { int pm, pn, e, mt, nv, aux, ar; };
struct Gemm { const bf16_t* A; const bf16_t* Bt; int K; size_t b_estride; };

__device__ __forceinline__ unsigned cvt_pk_bf16(float lo, float hi) { unsigned r; asm volatile("v_cvt_pk_bf16_f32 %0, %1, %2" : "=v"(r) : "v"(lo), "v"(hi)); return r; }
__device__ __forceinline__ float bf_lo(unsigned w) { return __builtin_bit_cast(float, w << 16); }
__device__ __forceinline__ float bf_hi(unsigned w) { return __builtin_bit_cast(float, w & 0xffff0000u); }
__device__ __forceinline__ float fast_sigmoid(float x) { return __builtin_amdgcn_rcpf(1.0f + __builtin_amdgcn_exp2f(-1.4426950408889634f * x)); }
__device__ __forceinline__ float gelu_tanh(float v) { const float y = 1.5957691216057308f * (v + 0.044715f * v * v * v); return v * fast_sigmoid(y); }

template <class Epi, class Sched, bool ALIGN_EPI, bool GATHER>
__device__ __forceinline__ void gemm_phase(PG8_LAS unsigned char* lds, const Gemm g, const Sched& S, const Epi& E) {
    const int tid = threadIdx.x, wid = __builtin_amdgcn_readfirstlane(tid >> 6), lane = tid & 63, wr = wid >> 2, wc = wid & 3, fr = lane & 15, fq = lane >> 4;
    const int K = g.K, nt = K / BK;
    unsigned voffA[2], voffB[2]; int RA[2]; unsigned CA2[2];
#pragma unroll
    for (int i = 0; i < 2; ++i) { int R, C; stage_rc(tid * 16 + i * 8192, R, C); const int Rb = Epi::PERM ? ((R & ~31) + perm32(R & 31)) : R;
        voffA[i] = (unsigned)(R * K + C) * 2u; voffB[i] = (unsigned)(Rb * K + C) * 2u; RA[i] = R; CA2[i] = (unsigned)C * 2u; }
    const size_t kstep = (size_t)(BK * 2);
    const size_t hstep = (size_t)HALF * K * 2;
    const size_t tstep = 2 * hstep;
    const unsigned ldsw = (unsigned)wid * 1024u;
    const int aoff = lds_byte(wr * 64 + fr, fq * 8), boff = lds_byte(wc * 32 + fr, fq * 8);
#define PG8_SA(b, h) (((b) * 2 + (h)) * HTB)
#define PG8_SB(b, h) ((4 + (b) * 2 + (h)) * HTB)
#define PG8_STAGE2(bufoff, gbase, v0, v1) do { \
        __builtin_amdgcn_global_load_lds((const unsigned*)((const char*)(gbase) + (v0)), (PG8_LAS unsigned*)(lds + (bufoff) + ldsw), 16, 0, 0); \
        __builtin_amdgcn_global_load_lds((const unsigned*)((const char*)(gbase) + (v1)), (PG8_LAS unsigned*)(lds + (bufoff) + ldsw + 8192), 16, 0, 0); } while (0)
#define PG8_STAGEB(bufoff, gbase) PG8_STAGE2(bufoff, gbase, voffB[0], voffB[1])
#define PG8_LDA(dst, b, h) do { _Pragma("unroll") for (int m = 0; m < 4; ++m) _Pragma("unroll") for (int k = 0; k < 2; ++k) dst[m][k] = *(const PG8_LAS bf16x8*)(lds + PG8_SA(b, h) + aoff + m * 2048 + k * 1024); } while (0)
#define PG8_LDB(dst, b, h) do { _Pragma("unroll") for (int n = 0; n < 2; ++n) _Pragma("unroll") for (int k = 0; k < 2; ++k) dst[n][k] = *(const PG8_LAS bf16x8*)(lds + PG8_SB(b, h) + boff + n * 2048 + k * 1024); } while (0)
#define PG8_MMA(ai, bj, At, Bt) do { __builtin_amdgcn_s_setprio(1); _Pragma("unroll") for (int m = 0; m < 4; ++m) _Pragma("unroll") for (int n = 0; n < 2; ++n) _Pragma("unroll") for (int k = 0; k < 2; ++k) \
        acc[ai][bj][m][n] = __builtin_amdgcn_mfma_f32_16x16x32_bf16(Bt[n][k], At[m][k], acc[ai][bj][m][n], 0, 0, 0); __builtin_amdgcn_s_setprio(0); } while (0)
#define PG8_WAIT_V(n) asm volatile("s_waitcnt vmcnt(" #n ")" ::: "memory")
#define PG8_WAIT_L(n) asm volatile("s_waitcnt lgkmcnt(" #n ")" ::: "memory")
#define PG8_BAR __builtin_amdgcn_s_barrier()
#define PG8_SCHED __builtin_amdgcn_sched_barrier(0)
    Unit cur, nxt; int ui = 0;
    if (!S.next(0, cur)) return;
    f32x4 acc[2][2][4][2];
#pragma unroll
    for (int a = 0; a < 2; ++a)
#pragma unroll
        for (int b = 0; b < 2; ++b)
#pragma unroll
            for (int m = 0; m < 4; ++m)
#pragma unroll
                for (int n = 0; n < 2; ++n) acc[a][b][m][n] = (f32x4){0.f, 0.f, 0.f, 0.f};
    bf16x8 At[4][2], B0[2][2], B1[2][2];
    const char* const gA = (const char*)g.A;
    unsigned roC[2][2], roN[2][2];
    const char* cA; const char* cB = (const char*)g.Bt + ((size_t)cur.e * g.b_estride) * 2 + (size_t)cur.pn * tstep;
    if constexpr (GATHER) {
#pragma unroll
        for (int h = 0; h < 2; ++h)
#pragma unroll
            for (int i = 0; i < 2; ++i) roC[h][i] = (unsigned)S.row_of(cur, h * HALF + RA[i]) * (unsigned)(K * 2) + CA2[i];
        cA = gA;
    } else {
#pragma unroll
        for (int h = 0; h < 2; ++h)
#pragma unroll
            for (int i = 0; i < 2; ++i) roC[h][i] = voffA[i] + (unsigned)(h * hstep);
        cA = gA + (size_t)cur.ar * (size_t)(K * 2);
    }
    S.a_ready(cur);
    PG8_STAGEB(PG8_SB(0, 0), cB); PG8_STAGEB(PG8_SB(0, 1), cB + hstep); PG8_STAGE2(PG8_SA(0, 0), cA, roC[0][0], roC[0][1]); PG8_STAGE2(PG8_SA(0, 1), cA, roC[1][0], roC[1][1]);
    if (wr == 1) PG8_BAR;
    PG8_WAIT_V(2); PG8_BAR;
    PG8_STAGEB(PG8_SB(1, 0), cB + kstep); PG8_STAGE2(PG8_SA(1, 0), cA + kstep, roC[0][0], roC[0][1]); PG8_STAGEB(PG8_SB(1, 1), cB + hstep + kstep);
    PG8_WAIT_V(6); PG8_BAR;
    for (;;) {
        const bool has_next = S.next(ui + 1, nxt);
        const char* nA; const char* nB = has_next ? (const char*)g.Bt + ((size_t)nxt.e * g.b_estride) * 2 + (size_t)nxt.pn * tstep : cB;
        if constexpr (GATHER) {
            nA = gA;
            if (has_next) {
#pragma unroll
                for (int h = 0; h < 2; ++h)
#pragma unroll
                    for (int i = 0; i < 2; ++i) roN[h][i] = (unsigned)S.row_of(nxt, h * HALF + RA[i]) * (unsigned)(K * 2) + CA2[i];
            } else {
#pragma unroll
                for (int h = 0; h < 2; ++h)
#pragma unroll
                    for (int i = 0; i < 2; ++i) roN[h][i] = roC[h][i];
            }
        } else {
            nA = has_next ? gA + (size_t)nxt.ar * (size_t)(K * 2) : cA;
        }
#pragma clang loop unroll(disable)
        for (int t = 0; t < nt; t += 2) {
            const bool last = (t == nt - 2);
            const char* a1 = cA + (size_t)(t + 1) * kstep;
            const char* a2 = last ? nA : cA + (size_t)(t + 2) * kstep; const char* b2 = last ? nB : cB + (size_t)(t + 2) * kstep;
            const char* a3 = a2 + kstep; const char* b3 = b2 + kstep;
            unsigned s00, s01, s10, s11;
            if constexpr (GATHER) { s00 = last ? roN[0][0] : roC[0][0]; s01 = last ? roN[0][1] : roC[0][1]; s10 = last ? roN[1][0] : roC[1][0]; s11 = last ? roN[1][1] : roC[1][1]; }
            else { s00 = roC[0][0]; s01 = roC[0][1]; s10 = roC[1][0]; s11 = roC[1][1]; }
            if (last && has_next) S.a_ready(nxt);
            PG8_LDB(B0, 0, 0); PG8_LDB(B1, 0, 1); PG8_SCHED; PG8_LDA(At, 0, 0); PG8_STAGE2(PG8_SA(1, 1), a1, roC[1][0], roC[1][1]);
            PG8_WAIT_V(8); PG8_WAIT_L(0); PG8_BAR; PG8_MMA(0, 0, At, B0); PG8_MMA(0, 1, At, B1); PG8_BAR; PG8_SCHED;
            PG8_LDA(At, 0, 1); PG8_STAGEB(PG8_SB(0, 0), b2); PG8_STAGEB(PG8_SB(0, 1), b2 + hstep); PG8_STAGE2(PG8_SA(0, 0), a2, s00, s01);
            PG8_WAIT_V(8); PG8_WAIT_L(0); PG8_BAR; PG8_MMA(1, 0, At, B0); PG8_MMA(1, 1, At, B1); PG8_BAR; PG8_SCHED;
            PG8_LDB(B0, 1, 0); PG8_LDB(B1, 1, 1); PG8_SCHED; PG8_LDA(At, 1, 0); PG8_STAGE2(PG8_SA(0, 1), a2, s10, s11);
            PG8_WAIT_V(8); PG8_WAIT_L(0); PG8_BAR; PG8_MMA(0, 0, At, B0); PG8_MMA(0, 1, At, B1); PG8_BAR; PG8_SCHED;
            PG8_LDA(At, 1, 1); PG8_STAGEB(PG8_SB(1, 0), b3); PG8_STAGEB(PG8_SB(1, 1), b3 + hstep); PG8_STAGE2(PG8_SA(1, 0), a3, s00, s01);
            PG8_WAIT_V(8); PG8_WAIT_L(0); PG8_BAR; PG8_MMA(1, 0, At, B0); PG8_MMA(1, 1, At, B1); PG8_BAR; PG8_SCHED;
        }
        if constexpr (ALIGN_EPI) { if (wr == 0) PG8_BAR; }
        E(acc, cur, wr, wc, fr, fq); S.done(cur);
        if (!has_next) break;
#pragma unroll
        for (int a = 0; a < 2; ++a)
#pragma unroll
            for (int b = 0; b < 2; ++b)
#pragma unroll
                for (int m = 0; m < 4; ++m)
#pragma unroll
                    for (int n = 0; n < 2; ++n) acc[a][b][m][n] = (f32x4){0.f, 0.f, 0.f, 0.f};
        cur = nxt; cA = nA; cB = nB; ++ui;
        if constexpr (GATHER) {
#pragma unroll
            for (int h = 0; h < 2; ++h)
#pragma unroll
                for (int i = 0; i < 2; ++i) roC[h][i] = roN[h][i];
        }
        if constexpr (ALIGN_EPI) { if (wr == 1) PG8_BAR; }
    }
    PG8_WAIT_V(0);
    if constexpr (!ALIGN_EPI) { if (wr == 0) PG8_BAR; }
    PG8_BAR;
#undef PG8_SA
#undef PG8_SB
#undef PG8_STAGE2
#undef PG8_STAGEB
#undef PG8_LDA
#undef PG8_LDB
#undef PG8_MMA
#undef PG8_WAIT_V
#undef PG8_WAIT_L
#undef PG8_BAR
#undef PG8_SCHED
}
}
namespace attn2 {
using bf16=__hip_bfloat16;
using bf16x8=__attribute__((ext_vector_type(8)))short;
using s16x4=__attribute__((ext_vector_type(4)))short;
using f32x16=__attribute__((ext_vector_type(16)))float;
using u32x4=__attribute__((ext_vector_type(4)))unsigned;
constexpr int BATCH=8,NHEAD=16,SEQ=4352,D=64,DM=NHEAD*D;
constexpr int NW=8,QBLK=32,QB=QBLK*NW,KVBLK=64,NQB=SEQ/QB;
constexpr int ATTN_PITCH=DM, ATTN_UNIT_ROWS=QB;
__device__ __forceinline__ int crow(int r,int hi){return (r&3)+8*(r>>2)+4*hi;}
#define SBAR() __builtin_amdgcn_sched_barrier(0)
__device__ __forceinline__ void cmask(f32x16&p0,f32x16&p1,int jb,int qrel,int hi){
  const float NEG=-INFINITY; int kb=64*jb+4*hi;
  #pragma unroll
  for(int r=0;r<16;++r){int kv=kb+(r&3)+8*(r>>2); if(kv>qrel)p0[r]=NEG; if(kv+32>qrel)p1[r]=NEG;}
}

constexpr int NSLOT=3, SLOTB=8192, QPW=4608;
constexpr int LDS_K=0, LDS_V=NSLOT*SLOTB, LDS_WS=3*NSLOT*SLOTB, LDS_QP=LDS_WS+NW*64*4, LDS_BYTES=LDS_QP+NW*QPW;
constexpr float C2=0.125f*1.4426950408889634f;
__device__ __forceinline__ void glds16(const void*gsrc,unsigned lds_dst){unsigned keep;
  asm volatile("s_mov_b32 %0, m0\n\ts_mov_b32 m0, %2\n\ts_nop 0\n\tglobal_load_lds_dwordx4 %1, off\n\ts_mov_b32 m0, %0":"=&s"(keep):"v"(gsrc),"s"(lds_dst):"memory");}
__device__ __forceinline__ float max3f(float a,float b,float c){float r;asm("v_max3_f32 %0, %1, %2, %3":"=v"(r):"v"(a),"v"(b),"v"(c));return r;}
__device__ __forceinline__ float max2f(float a,float b){float r;asm("v_max_f32_e32 %0, %1, %2":"=v"(r):"v"(a),"v"(b));return r;}
__device__ __forceinline__ float fadd_s(float a,float b){float r;asm("v_add_f32_e32 %0, %1, %2":"=v"(r):"v"(a),"v"(b));return r;}
__device__ __forceinline__ float fsub_s(float a,float b){float r;asm("v_sub_f32_e32 %0, %1, %2":"=v"(r):"v"(a),"v"(b));return r;}
typedef float f32x2_t __attribute__((ext_vector_type(2))); typedef __bf16 bf16x2_t __attribute__((ext_vector_type(2)));
__device__ __forceinline__ unsigned cvtpk_s(float lo,float hi){f32x2_t v={lo,hi};bf16x2_t b=__builtin_convertvector(v,bf16x2_t);return __builtin_bit_cast(unsigned,b);}
#define WAIT_BAR(N) asm volatile("s_waitcnt vmcnt(" #N ") lgkmcnt(0)\n\ts_barrier":::"memory")

__device__ __forceinline__ void qkt(f32x16&p0,f32x16&p1,const char*Kslot,const bf16x8*qr,int r32,int hi){ const f32x16 negm=f32x16{};
  const char*kb=Kslot+hi*1024+r32*16;
  #pragma unroll
  for(int d0=0;d0<4;++d0){
    const bf16x8 b0=*reinterpret_cast<const bf16x8*>(kb+d0*2048);
    const bf16x8 b1=*reinterpret_cast<const bf16x8*>(kb+d0*2048+512);
    if(d0==0){p0=__builtin_amdgcn_mfma_f32_32x32x16_bf16(b0,qr[0],negm,0,0,0);p1=__builtin_amdgcn_mfma_f32_32x32x16_bf16(b1,qr[0],negm,0,0,0);}
    else{p0=__builtin_amdgcn_mfma_f32_32x32x16_bf16(b0,qr[d0],p0,0,0,0);p1=__builtin_amdgcn_mfma_f32_32x32x16_bf16(b1,qr[d0],p1,0,0,0);}}
}
typedef __attribute__((address_space(3))) const char* lds_cptr;
typedef short v4i16_t __attribute__((ext_vector_type(4)));
__device__ __forceinline__ void kload8(bf16x8*kf,lds_cptr kp){
  kf[0]=*(const __attribute__((address_space(3))) bf16x8*)(kp);      kf[1]=*(const __attribute__((address_space(3))) bf16x8*)(kp+512);
  kf[2]=*(const __attribute__((address_space(3))) bf16x8*)(kp+2048); kf[3]=*(const __attribute__((address_space(3))) bf16x8*)(kp+2560);
  kf[4]=*(const __attribute__((address_space(3))) bf16x8*)(kp+4096); kf[5]=*(const __attribute__((address_space(3))) bf16x8*)(kp+4608);
  kf[6]=*(const __attribute__((address_space(3))) bf16x8*)(kp+6144); kf[7]=*(const __attribute__((address_space(3))) bf16x8*)(kp+6656);
}
__device__ __forceinline__ void kload2(bf16x8*kf,lds_cptr kp,int j){ kf[2*j]=*(const __attribute__((address_space(3))) bf16x8*)(kp+j*2048); kf[2*j+1]=*(const __attribute__((address_space(3))) bf16x8*)(kp+j*2048+512); }
__device__ __forceinline__ s16x4 vtr(lds_cptr p){ return __builtin_bit_cast(s16x4,__builtin_amdgcn_ds_read_tr16_b64_v4i16((__attribute__((address_space(3))) v4i16_t*)p)); }
__device__ __forceinline__ float rowmax(const f32x16&p0,const f32x16&p1){
  float a=max3f(p0[0],p0[1],p1[0]),b=max3f(p0[2],p0[3],p1[1]);a=max3f(a,p1[2],p1[3]);
  #pragma unroll
  for(int r=4;r<16;r+=4){a=max3f(a,p0[r],p0[r+1]);b=max3f(b,p0[r+2],p0[r+3]);a=max3f(a,p1[r],p1[r+1]);b=max3f(b,p1[r+2],p1[r+3]);}
  const float m=max2f(a,b);
  auto rr=__builtin_amdgcn_permlane32_swap(__float_as_uint(m),__float_as_uint(m),false,false);
  return max2f(__uint_as_float(rr[0]),__uint_as_float(rr[1]));
}
__device__ __forceinline__ void pv(f32x16*o,int vb,bf16x8 pa0,bf16x8 pa1,bf16x8 pa2,bf16x8 pa3){
  #pragma unroll
  for(int d0=0;d0<4;++d0){s16x4 lo[4],hi[4];
    #pragma unroll
    for(int ks=0;ks<4;++ks){
      asm volatile("ds_read_b64_tr_b16 %0,%1 offset:%c2":"=&v"(lo[ks]):"v"(vb),"i"(d0*4096+ks*1024):"memory");
      asm volatile("ds_read_b64_tr_b16 %0,%1 offset:%c2":"=&v"(hi[ks]):"v"(vb),"i"(d0*4096+ks*1024+512):"memory");}
    asm volatile("s_waitcnt lgkmcnt(0)":::"memory");SBAR();
    #define PK(k) (bf16x8){lo[k][0],lo[k][1],lo[k][2],lo[k][3],hi[k][0],hi[k][1],hi[k][2],hi[k][3]}
    o[d0]=__builtin_amdgcn_mfma_f32_32x32x16_bf16(pa0,PK(0),o[d0],0,0,0);
    o[d0]=__builtin_amdgcn_mfma_f32_32x32x16_bf16(pa1,PK(1),o[d0],0,0,0);
    o[d0]=__builtin_amdgcn_mfma_f32_32x32x16_bf16(pa2,PK(2),o[d0],0,0,0);
    o[d0]=__builtin_amdgcn_mfma_f32_32x32x16_bf16(pa3,PK(3),o[d0],0,0,0);
    #undef PK
  }
}

#ifndef ATTN_STORE16
#define ATTN_STORE16(p,v) (*(u32x4*)(p)=(v))
#endif
template<int THRL> __device__ __forceinline__ void attn_unit(int b,int h,int hv,int qb,const bf16*Q,const bf16*__restrict__ K,const bf16*__restrict__ V,bf16*O,char*shm){
  const int tid=threadIdx.x,lane=tid&63,r32=lane&31,hi=lane>>5; const int wid=__builtin_amdgcn_readfirstlane(tid>>6);
  const long rowbase=(long)b*SEQ; const int q0=qb*QB;
  const bf16*Qw=Q+(rowbase+q0+wid*QBLK)*DM+h*D;
  const bf16*Kh=K+rowbase*DM+h*D,*Vh=V+rowbase*DM+hv*128;
  const unsigned lds0=(unsigned)(uintptr_t)shm;
  float*wsf=(float*)(shm+LDS_WS)+wid*64;
  const bf16*ksrc=Kh+(long)lane*DM+wid*8;
  const bf16*vsrc=Vh+(long)(16*(wid&3)+(lane>>2))*DM+(wid>>2)*32+(lane&3)*8;
  const unsigned kdst=lds0+LDS_K+wid*1024, vdst=lds0+LDS_V+wid*1024;
  #define DMA_K(t,slot) glds16(ksrc+(long)(t)*KVBLK*DM,(unsigned)__builtin_amdgcn_readfirstlane(kdst+(slot)))
  #define DMA_V(t,slot) do{ glds16(vsrc+(long)(t)*KVBLK*DM,(unsigned)__builtin_amdgcn_readfirstlane(vdst+2*(slot))); glds16(vsrc+64+(long)(t)*KVBLK*DM,(unsigned)__builtin_amdgcn_readfirstlane(vdst+2*(slot)+8192)); }while(0)
  const int vb0=(int)(lds0+LDS_V)+((lane>>4)&1)*32+(lane&3)*8+(4*hi+((lane&15)>>2))*64;
  const char*Kbase=shm+LDS_K; bf16x8 kf[8];
  const lds_cptr shm3=(lds_cptr)shm; const lds_cptr kp0=shm3+LDS_K+hi*1024+r32*16; const lds_cptr vp0=shm3+LDS_V+((lane>>4)&1)*32+(lane&3)*8+(4*hi+((lane&15)>>2))*64;
  const int NT=(q0+QB)/KVBLK;
  DMA_K(0,0);DMA_V(0,0);DMA_K(1,SLOTB);
  typedef __attribute__((address_space(3))) bf16x8* lds_q8; const lds_q8 qpl=(lds_q8)((__attribute__((address_space(3))) char*)shm3+LDS_QP+wid*QPW+r32*144+hi*16);
  { bf16x8 qr[4];
  #pragma unroll
  for(int d0=0;d0<4;++d0)qr[d0]=*reinterpret_cast<const bf16x8*>(&Qw[(long)r32*DM+d0*16+hi*8]);
  #pragma unroll
  for(int d0=0;d0<4;++d0)qpl[2*d0]=qr[d0]; }
  float mhat=0.f,l_reg=0.f;f32x16 o[4];o[0]=f32x16{};o[1]=f32x16{};o[2]=f32x16{};o[3]=f32x16{};
  const int qrel=wid*QBLK+r32;
  #define CMASK(P0,P1,t) do{int jb_=(t)-(NT-4); if(jb_>=0)cmask(P0,P1,jb_,qrel,hi);}while(0)
  bool resc=false;
  #define START(P0,P1) do{ const float rm=rowmax(P0,P1); resc=false; mhat=rm; \
    _Pragma("unroll") for(int r=0;r<16;++r)P0[r]=__builtin_amdgcn_exp2f(P0[r]-mhat); }while(0)
  #define RESC() do{ if(resc){ asm volatile("s_waitcnt lgkmcnt(0)":::"memory"); \
      _Pragma("unroll") for(int d_=0;d_<4;++d_) _Pragma("unroll") for(int r=0;r<16;++r)o[d_][r]*=wsf[crow(r,hi)]; } }while(0)
  f32x16 pA0,pA1,pB0,pB1;
  int sl_prev=0,sl_cur=0,sl_next=SLOTB;
  #define ROT() do{sl_prev=sl_cur;sl_cur=sl_next;sl_next=(sl_next==(NSLOT-1)*SLOTB)?0:sl_next+SLOTB;}while(0)
  DMA_K(2,2*SLOTB);
  WAIT_BAR(4);
  { bf16x8 qf[4]; _Pragma("unroll") for(int d0=0;d0<4;++d0)qf[d0]=qpl[2*d0]; qkt(pA0,pA1,Kbase,qf,r32,hi); } asm volatile("s_nop 15\n\ts_nop 7":"+v"(pA0),"+v"(pA1));CMASK(pA0,pA1,0);
  START(pA0,pA1);
  _Pragma("unroll") for(int r=0;r<16;++r)pA1[r]=__builtin_amdgcn_exp2f(pA1[r]-mhat);
  WAIT_BAR(0);
  DMA_K(3,0);DMA_V(1,SLOTB);
  ROT();
  kload8(kf,kp0+sl_cur);
  WAIT_BAR(3);
  s16x4 vlo[8],vhi[8],wlo[8],whi[8]; u32x4 pw0,pw1,pw2,pw3; const f32x16 zero16=f32x16{};
  #define PKW(P,B) cvtpk_s(P[B],P[B+1])
  #define PAF(k) __builtin_bit_cast(bf16x8,pw##k)
  #define VFR(i) (bf16x8){vlo[i][0],vlo[i][1],vlo[i][2],vlo[i][3],vhi[i][0],vhi[i][1],vhi[i][2],vhi[i][3]}
  #define PIN(x) asm volatile("":"+v"(x))
  #define MX3(a,b,c) __builtin_fmaxf(__builtin_fmaxf((a),(b)),(c))
  #define GAPA(MF,A0,A1,A2,A3,W0,W1,PW) do{ MF; sacc+=A0; sacc+=A1; sacc+=A2; sacc+=A3; PIN(sacc); W0; W1; PIN(PW); SBAR(); }while(0)
  #define EX(v) __builtin_amdgcn_exp2f(v)
  #define EXM(v) __builtin_amdgcn_exp2f((v)-mhat)
  #define GAPB2(MF,X,B) do{ MF; X[B]=EXM(X[B]); X[B+1]=EXM(X[B+1]); PIN(X); SBAR(); }while(0)
  #define VRD2(i) do{ wlo[i]=vtr(vp_+((((i)>>2)+2)*4096+((i)&3)*1024)); whi[i]=vtr(vp_+((((i)>>2)+2)*4096+((i)&3)*1024+512)); }while(0)
  #define WFR(i) (bf16x8){wlo[i][0],wlo[i][1],wlo[i][2],wlo[i][3],whi[i][0],whi[i][1],whi[i][2],whi[i][3]}
  #define VRD(i) do{ vlo[i]=vtr(vp_+(((i)>>2)*4096+((i)&3)*1024)); vhi[i]=vtr(vp_+(((i)>>2)*4096+((i)&3)*1024+512)); }while(0)
  #define KRD(G,j) do{ if(G){ kload2(kf,kp0+sl_next,j); SBAR(); } }while(0)
  #define STEP(C0,C1,P0,P1,t,GK,GV,GL) do{ SBAR(); \
    const lds_cptr vp_=vp0+2*sl_prev; const bf16x8 qf0=qpl[0],qf1=qpl[2],qf2=qpl[4],qf3=qpl[6]; \
    VRD(0); SBAR(); float sacc=(P0[0]+P0[1]); \
    GAPA(C0=__builtin_amdgcn_mfma_f32_32x32x16_bf16(kf[0],qf0,zero16,0,0,0), P0[2],P0[3],P0[4],P0[5],     pw0[0]=PKW(P0,0), pw0[1]=PKW(P0,2), pw0); \
    VRD(4); SBAR(); GAPA(C1=__builtin_amdgcn_mfma_f32_32x32x16_bf16(kf[1],qf0,zero16,0,0,0), P0[6],P0[7],P0[8],P0[9],     pw0[2]=PKW(P0,4), pw0[3]=PKW(P0,6), pw0); \
    VRD(1); SBAR(); GAPA(C0=__builtin_amdgcn_mfma_f32_32x32x16_bf16(kf[2],qf1,C0,0,0,0),   P0[10],P0[11],P0[12],P0[13], pw1[0]=PKW(P0,8), pw1[1]=PKW(P0,10), pw1); \
    VRD(5); SBAR(); GAPA(C1=__builtin_amdgcn_mfma_f32_32x32x16_bf16(kf[3],qf1,C1,0,0,0),   P0[14],P0[15],P1[0],P1[1],   pw1[2]=PKW(P0,12),pw1[3]=PKW(P0,14), pw1); \
    VRD(2); SBAR(); GAPA(C0=__builtin_amdgcn_mfma_f32_32x32x16_bf16(kf[4],qf2,C0,0,0,0),   P1[2],P1[3],P1[4],P1[5],     pw2[0]=PKW(P1,0), pw2[1]=PKW(P1,2), pw2); \
    VRD(6); SBAR(); GAPA(C1=__builtin_amdgcn_mfma_f32_32x32x16_bf16(kf[5],qf2,C1,0,0,0),   P1[6],P1[7],P1[8],P1[9],     pw2[2]=PKW(P1,4), pw2[3]=PKW(P1,6), pw2); \
    VRD(3); SBAR(); GAPA(C0=__builtin_amdgcn_mfma_f32_32x32x16_bf16(kf[6],qf3,C0,0,0,0),   P1[10],P1[11],P1[12],P1[13], pw3[0]=PKW(P1,8), pw3[1]=PKW(P1,10), pw3); \
    VRD(7); SBAR(); GAPA(C1=__builtin_amdgcn_mfma_f32_32x32x16_bf16(kf[7],qf3,C1,0,0,0),   P1[14],P1[15],0.f,0.f,       pw3[2]=PKW(P1,12),pw3[3]=PKW(P1,14), pw3); \
    l_reg+=sacc; \
    if(GK){DMA_K((t)+3,sl_cur);} if(GV){DMA_V((t)+1,sl_next);} \
    CMASK(C0,C1,t); \
    { float a=MX3(C0[0],C0[1],C1[0]),b=MX3(C0[2],C0[3],C1[1]); a=MX3(a,C1[2],C1[3]); \
      _Pragma("unroll") for(int r=4;r<16;r+=4){a=MX3(a,C0[r],C0[r+1]);b=MX3(b,C0[r+2],C0[r+3]);a=MX3(a,C1[r],C1[r+1]);b=MX3(b,C1[r+2],C1[r+3]);} \
      float rm=__builtin_fmaxf(a,b); { auto rr=__builtin_amdgcn_permlane32_swap(__float_as_uint(rm),__float_as_uint(rm),false,false); rm=__builtin_fmaxf(__uint_as_float(rr[0]),__uint_as_float(rr[1])); } \
      rm-=mhat; resc=false; \
      if(__builtin_expect(__any(rm>(float)THRL),0)){ const float dl=__builtin_fmaxf(rm,0.f); mhat+=dl; \
        const float f=__builtin_amdgcn_exp2f(-dl); l_reg*=f; if(hi==0)wsf[r32]=f; resc=true; } } \
    SBAR(); \
    VRD2(0); SBAR(); GAPB2(o[0]=__builtin_amdgcn_mfma_f32_32x32x16_bf16(PAF(0),VFR(0),o[0],0,0,0), C0,0); \
    VRD2(4); SBAR(); GAPB2(o[1]=__builtin_amdgcn_mfma_f32_32x32x16_bf16(PAF(0),VFR(4),o[1],0,0,0), C0,2); \
    KRD(GL,0); VRD2(1); SBAR(); GAPB2(o[0]=__builtin_amdgcn_mfma_f32_32x32x16_bf16(PAF(1),VFR(1),o[0],0,0,0), C0,4); \
    KRD(GL,1); VRD2(5); SBAR(); GAPB2(o[1]=__builtin_amdgcn_mfma_f32_32x32x16_bf16(PAF(1),VFR(5),o[1],0,0,0), C0,6); \
    KRD(GL,2); VRD2(2); SBAR(); GAPB2(o[0]=__builtin_amdgcn_mfma_f32_32x32x16_bf16(PAF(2),VFR(2),o[0],0,0,0), C0,8); \
    KRD(GL,3); VRD2(6); SBAR(); GAPB2(o[1]=__builtin_amdgcn_mfma_f32_32x32x16_bf16(PAF(2),VFR(6),o[1],0,0,0), C0,10); \
    VRD2(3); SBAR(); GAPB2(o[0]=__builtin_amdgcn_mfma_f32_32x32x16_bf16(PAF(3),VFR(3),o[0],0,0,0), C0,12); \
    VRD2(7); SBAR(); GAPB2(o[1]=__builtin_amdgcn_mfma_f32_32x32x16_bf16(PAF(3),VFR(7),o[1],0,0,0), C0,14); \
    GAPB2(o[2]=__builtin_amdgcn_mfma_f32_32x32x16_bf16(PAF(0),WFR(0),o[2],0,0,0), C1,0); \
    GAPB2(o[3]=__builtin_amdgcn_mfma_f32_32x32x16_bf16(PAF(0),WFR(4),o[3],0,0,0), C1,2); \
    GAPB2(o[2]=__builtin_amdgcn_mfma_f32_32x32x16_bf16(PAF(1),WFR(1),o[2],0,0,0), C1,4); \
    GAPB2(o[3]=__builtin_amdgcn_mfma_f32_32x32x16_bf16(PAF(1),WFR(5),o[3],0,0,0), C1,6); \
    GAPB2(o[2]=__builtin_amdgcn_mfma_f32_32x32x16_bf16(PAF(2),WFR(2),o[2],0,0,0), C1,8); \
    GAPB2(o[3]=__builtin_amdgcn_mfma_f32_32x32x16_bf16(PAF(2),WFR(6),o[3],0,0,0), C1,10); \
    GAPB2(o[2]=__builtin_amdgcn_mfma_f32_32x32x16_bf16(PAF(3),WFR(3),o[2],0,0,0), C1,12); \
    GAPB2(o[3]=__builtin_amdgcn_mfma_f32_32x32x16_bf16(PAF(3),WFR(7),o[3],0,0,0), C1,14); \
    }while(0)
  int t=1;
  #undef CMASK
  #define CMASK(P0,P1,t) do{}while(0)
  for(;t+5<NT;t+=2){
    STEP(pB0,pB1,pA0,pA1,t,true,true,true);     WAIT_BAR(3); RESC(); ROT();
    STEP(pA0,pA1,pB0,pB1,t+1,true,true,true);   WAIT_BAR(3); RESC(); ROT();
  }
  #undef CMASK
  #define CMASK(P0,P1,t) do{int jb_=(t)-(NT-4); if(jb_>=0)cmask(P0,P1,jb_,qrel,hi);}while(0)
  #define ENDW(tt) do{ if((tt)+3<NT){WAIT_BAR(3);} else if((tt)+2<NT){WAIT_BAR(2);} else {WAIT_BAR(0);} }while(0)
  for(;t+1<NT;t+=2){
    STEP(pB0,pB1,pA0,pA1,t,(t+3<NT),(t+1<NT),(t+1<NT));       ENDW(t);   RESC(); ROT();
    STEP(pA0,pA1,pB0,pB1,t+1,(t+4<NT),(t+2<NT),(t+2<NT));     ENDW(t+1); RESC(); ROT();
  }
  STEP(pB0,pB1,pA0,pA1,NT-1,false,false,false); RESC();
  { float sacc=pB0[0]+pB0[1]; _Pragma("unroll") for(int r=2;r<16;++r)sacc+=pB0[r]; _Pragma("unroll") for(int r=0;r<16;++r)sacc+=pB1[r]; l_reg+=sacc;
    pw0=(u32x4){PKW(pB0,0),PKW(pB0,2),PKW(pB0,4),PKW(pB0,6)};pw1=(u32x4){PKW(pB0,8),PKW(pB0,10),PKW(pB0,12),PKW(pB0,14)};pw2=(u32x4){PKW(pB1,0),PKW(pB1,2),PKW(pB1,4),PKW(pB1,6)};pw3=(u32x4){PKW(pB1,8),PKW(pB1,10),PKW(pB1,12),PKW(pB1,14)};
    SBAR(); pv(o,vb0+2*sl_cur,PAF(0),PAF(1),PAF(2),PAF(3)); }
  #undef PKW
  #undef PAF
  #undef VFR
  #undef PIN
  #undef MX3
  #undef GAPA
  #undef GAPB2
  #undef EXM
  #undef VRD2
  #undef WFR
  #undef EX
  #undef VRD
  #undef KRD
  #undef STEP
  #undef ENDW
  {auto rr=__builtin_amdgcn_permlane32_swap(__float_as_uint(l_reg),__float_as_uint(l_reg),false,false);l_reg=__uint_as_float(rr[0])+__uint_as_float(rr[1]);}
  if(hi==0)wsf[32+r32]=l_reg;asm volatile("s_waitcnt lgkmcnt(0)":::"memory");
  float rli[16];
  #pragma unroll
  for(int r=0;r<16;++r)rli[r]=__builtin_amdgcn_rcpf(wsf[32+crow(r,hi)]);
  bf16*Ow=O+(rowbase+q0+wid*QBLK)*DM+hv*128;
  asm volatile("s_waitcnt lgkmcnt(0)\n\ts_barrier":::"memory");
  { bf16*stg=(bf16*)(shm)+wid*4096;
    int r32e=(int)(threadIdx.x&31u); asm volatile("":"+v"(r32e));
    #pragma unroll
    for(int r=0;r<16;++r){const int orow=crow(r,hi);
      #pragma unroll
      for(int d0=0;d0<4;++d0)stg[orow*128+d0*32+r32e]=__float2bfloat16(o[d0][r]*rli[r]);}
    asm volatile("s_waitcnt lgkmcnt(0)":::"memory");
    #pragma unroll
    for(int i=0;i<8;++i){const int row=i*4+(lane>>4),ch=lane&15; const u32x4 v=*(const u32x4*)(stg+row*128+ch*8); ATTN_STORE16(Ow+(long)row*DM+ch*8,v);} }
  asm volatile("s_waitcnt lgkmcnt(0)\n\ts_barrier":::"memory");
  #undef DMA_K
  #undef DMA_V
  #undef CMASK
  #undef START
  #undef RESC
  #undef ROT
}
constexpr int ATTN_LDS_BYTES=LDS_BYTES;
struct AttnTensors { const bf16* Q; const bf16* K; const bf16* V; bf16* O; };
struct AttnUnit { int b; int hq; int hv; int qb; };
struct SplitOrder {
  int b, hq, hv, part;
  __device__ __forceinline__ bool next(int i,AttnUnit&u)const{ if(i>=9-part)return false; u.b=b; u.hq=hq; u.hv=hv; u.qb=16-2*i-((i&1)^part); return true; }
};
template<class Sched,int THRL=8> __device__ __forceinline__ void attn_phase(char*lds,const AttnTensors&T,const Sched&S){
  AttnUnit u;
  for(int i=0;S.next(i,u);++i){ attn_unit<THRL>(u.b,u.hq,u.hv,u.qb,T.Q,T.K,T.V,T.O,lds); }
}
#undef SBAR
#undef WAIT_BAR
}

constexpr int NWAVES = 8;
#ifndef MK_N_LAUNCHES
#define MK_N_LAUNCHES 1
#endif
#ifndef MK_DIAG
#define MK_DIAG 0
#endif
constexpr int NPHASE = 14;
constexpr int N_LAUNCHES = MK_N_LAUNCHES;

constexpr int NB = 8, SEQ = 4096, NMETA = 16, TV = NMETA + SEQ, TA = 4352, MA = NB * TA, D = 1024;
constexpr int NIN = 7168, NE = 256, TOPK = 8, DE = 256;
constexpr int NCHUNK = 33;
constexpr float LN_EPS = 1e-5f, ALPHA = 1.189207115002721f;
constexpr float ROUTED_SCALE = 2.5f, LAMBDA_INIT = 0.2f;
constexpr int CAP = 32768;
constexpr int NVALID = NB * SEQ;
constexpr int YSHARED = NVALID * TOPK, YDUMMY = NVALID * (TOPK + 1);

constexpr size_t MiB = 1u << 20;
constexpr size_t SLOTB = 68 * MiB;
static_assert((size_t)MA * D * 2 == SLOTB, "slot size");
constexpr size_t WS_CTL = 0, CTL_ZERO_BYTES = 1 * MiB;
constexpr size_t WS_ROWSTAT = 1 * MiB;
constexpr size_t WS_SCANSUM = 1 * MiB + 320 * 1024;
constexpr size_t WS_LRUWT = 4 * MiB - 512 * 1024;
constexpr size_t WS_S0 = 26 * MiB;
#define WS_SLOT(i) (WS_S0 + (size_t)(i) * SLOTB)
constexpr size_t WS_XN = WS_SLOT(0), WS_XR = WS_SLOT(1), WS_YG = WS_SLOT(2), WS_Q = WS_SLOT(3), WS_K = WS_SLOT(4), WS_V = WS_SLOT(5), WS_GR = WS_SLOT(6), WS_GA = WS_SLOT(7),
                 WS_REC = WS_SLOT(8), WS_O0 = WS_SLOT(9), WS_O1 = WS_SLOT(10), WS_ATT = WS_SLOT(11);
constexpr size_t WS_T1 = WS_SLOT(0), WS_U = WS_SLOT(1), WS_Z = WS_SLOT(2)  , WS_LOGITS = WS_SLOT(5);
constexpr size_t WS_LIST = 262 * MiB;
constexpr size_t WS_WGU = 4 * MiB;
constexpr size_t WS_WD = 596 * MiB;
constexpr size_t WS_ACT = 725 * MiB;
constexpr size_t WS_H1B = 905 * MiB;
constexpr size_t WS_TOKSLOT = 973 * MiB;
constexpr size_t WS_TOKW = 975 * MiB + 256 * 1024;
constexpr size_t WS_WIN = 978 * MiB, WS_WR = 992 * MiB, WS_WA = 994 * MiB, WS_WO = 996 * MiB, WS_WROUT = 998 * MiB;
constexpr size_t WS_Y = 4 * MiB;
constexpr size_t WS_END = 1000 * MiB;
constexpr int MAXTILES = 1408;
static_assert(WS_Y + ((size_t)NVALID * 9 + 1) * D * 2 <= WS_WD && WS_WD + (size_t)257 * 1024 * 256 * 2 <= WS_ACT && WS_ACT + (size_t)MAXTILES * 256 * 256 * 2 <= WS_H1B, "moe map");
static_assert(WS_WGU + (size_t)257 * 512 * 1024 * 2 <= WS_LIST && WS_LIST + (size_t)NE * CAP * 4 <= WS_SLOT(4), "moe map 2");
static_assert(WS_SLOT(12) <= WS_H1B && WS_TOKW + (size_t)MA * 16 * 4 <= WS_WIN, "map 3");
constexpr int CW_TMO = 0, CW_CODE = 1;
constexpr int CW_BAR = 4096;
constexpr int CW_CNT = 16384;
constexpr int CW_DIAG = 20480;

constexpr int RING_OFF = 0, RING_BYTES = 131072;
constexpr int LDSCTL_OFF = RING_BYTES, MISC_OFF = LDSCTL_OFF + 320;
constexpr int TT_OFF = LDSCTL_OFF + 1024;
constexpr int UB_OFF = TT_OFF + MAXTILES * 4;
constexpr int LDS_BYTES = 147456;
constexpr int CN_OFF = UB_OFF + 260 * 4, TB_OFF = CN_OFF + 260 * 4;
static_assert(TB_OFF + 260 * 4 <= LDS_BYTES, "LDS map");

#define GAS __attribute__((address_space(1)))
#define LAS __attribute__((address_space(3)))
typedef unsigned short bf16;
typedef unsigned v4u __attribute__((ext_vector_type(4)));
typedef float f32x4 __attribute__((ext_vector_type(4)));
typedef short bf16x8 __attribute__((ext_vector_type(8)));
typedef GAS unsigned gu32;
typedef GAS unsigned long long gu64;
#define RLX_AGENT __ATOMIC_RELAXED, __HIP_MEMORY_SCOPE_AGENT
#define LDS_WAIT() asm volatile("s_waitcnt lgkmcnt(0)" ::: "memory")
#define VM_WAIT() asm volatile("s_waitcnt vmcnt(0)" ::: "memory")
__device__ __forceinline__ unsigned long long rt() { return __builtin_amdgcn_s_memrealtime(); }
__device__ __forceinline__ unsigned f2bf(float f) { unsigned u = __builtin_bit_cast(unsigned, f); return (u + 0x7fffu + ((u >> 16) & 1u)) >> 16; }
__device__ __forceinline__ unsigned pk2(float lo, float hi) { return f2bf(lo) | (f2bf(hi) << 16); }

#define XB_TMO      128
#define XB_XCNT(j)  (256  + 64 * (j))
#define XB_XSUB(j)  (1280 + 64 * (j))
#define XB_XGEN(j)  (2304 + 64 * (j))
#define XB_TOP      3328
#define XB_TOPGEN   3392
#define XCD_BAR_WORDS 3456
#define XB_SPIN_CAP (1u << 18)

__device__ __forceinline__ unsigned xb_ld(unsigned* p)              { return __hip_atomic_load(p, __ATOMIC_RELAXED, __HIP_MEMORY_SCOPE_AGENT); }
__device__ __forceinline__ unsigned xb_add(unsigned* p, unsigned v) { return __hip_atomic_fetch_add(p, v, __ATOMIC_RELAXED, __HIP_MEMORY_SCOPE_AGENT); }
__device__ __forceinline__ unsigned xb_xcc_id() { return (unsigned)__builtin_amdgcn_s_getreg((3 << 11) | 20) & 0xFu; }
#define XB_SPIN(cond, bar) do { unsigned _sp = 0; while (cond) { __builtin_amdgcn_s_sleep(1); \
    if ((++_sp & 255u) == 0u) { if (xb_ld(&(bar)[XB_TMO])) break; if (_sp > XB_SPIN_CAP) { atomicAdd(&(bar)[XB_TMO], 1u); break; } } } } while (0)

struct XcdBarrier {
    unsigned* bar; unsigned x;
    volatile LAS unsigned* st;
};

__device__ __forceinline__ XcdBarrier xcd_barrier_post(unsigned* bar, volatile LAS unsigned* st) {
    XcdBarrier b; b.bar = bar; b.x = xb_xcc_id(); b.st = st;
    if (threadIdx.x == 0) (void)xb_add(&bar[XB_XCNT(b.x)], 1u);
    return b;
}
__device__ __forceinline__ void xcd_barrier_complete(unsigned* bar, unsigned x, unsigned& nloc, unsigned& nx) {
    const unsigned G = gridDim.x * gridDim.y * gridDim.z;
    unsigned sum, cnt, mine, sp = 0u;
    for (;;) {
        sum = 0u; cnt = 0u; mine = 0u;
#pragma unroll
        for (unsigned j = 0; j < 16; ++j) { const unsigned c = xb_ld(&bar[XB_XCNT(j)]); sum += c; cnt += (c > 0u) ? 1u : 0u; mine = (j == x) ? c : mine; }
        if (sum == G) break;
        __builtin_amdgcn_s_sleep(1);
        if ((++sp & 255u) == 0u) { if (xb_ld(&bar[XB_TMO])) break; if (sp > XB_SPIN_CAP) { atomicAdd(&bar[XB_TMO], 1u); break; } }
    }
    nloc = mine > 0u ? mine : 1u; nx = cnt > 0u ? cnt : 1u;
}

__device__ __forceinline__ void xcd_barrier(const XcdBarrier& b) {
    asm volatile("s_waitcnt vmcnt(0)" ::: "memory");
    __syncthreads();
    if (threadIdx.x == 0) {
        unsigned* bar = b.bar;
        __builtin_amdgcn_s_waitcnt(0);
        unsigned nloc = b.st[0], nx = b.st[1];
        if (nloc == 0u) { xcd_barrier_complete(bar, b.x, nloc, nx); b.st[0] = nloc; b.st[1] = nx; }
        const unsigned old = xb_add(&bar[XB_XSUB(b.x)], 1u);
        const unsigned gen = old / nloc;
        if (old + 1u == (gen + 1u) * nloc) {
            __builtin_amdgcn_fence(__ATOMIC_RELEASE, "agent");
            asm volatile("s_waitcnt vmcnt(0)" ::: "memory");
            const unsigned og = xb_add(&bar[XB_TOP], 1u);
            const unsigned tg = og / nx;
            if (og + 1u == (tg + 1u) * nx) xb_add(&bar[XB_TOPGEN], 1u);
            else XB_SPIN(xb_ld(&bar[XB_TOPGEN]) == tg, bar);
            __builtin_amdgcn_fence(__ATOMIC_ACQUIRE, "agent");
            xb_add(&bar[XB_XGEN(b.x)], 1u);
            asm volatile("s_waitcnt vmcnt(0)" ::: "memory");
        } else {
            XB_SPIN(xb_ld(&bar[XB_XGEN(b.x)]) == gen, bar);
            __builtin_amdgcn_fence(__ATOMIC_ACQUIRE, "agent");
            asm volatile("s_waitcnt vmcnt(0)" ::: "memory");
        }
    }
    __syncthreads();
}


__device__ __forceinline__ float wave_sum(float v) {
#pragma unroll
    for (int o = 1; o < 64; o <<= 1) v += __shfl_xor(v, o);
    return v;
}
__device__ __forceinline__ float bfl(unsigned w) { return __builtin_bit_cast(float, w << 16); }
__device__ __forceinline__ float bfh(unsigned w) { return __builtin_bit_cast(float, w & 0xffff0000u); }
__device__ __forceinline__ float bf1(bf16 h) { return __builtin_bit_cast(float, (unsigned)h << 16); }

struct DenseOrder {
    int nM, nN, nwg, G, c, valid;
    __device__ void init(int M, int N, int G_, int c_, int valid_ = 0) { nM = M / 256; nN = N / 256; nwg = nM * nN; G = G_; c = c_; valid = valid_; }
    __device__ bool next(int i, pg8::Unit& u) const {
        const long L = (long)i * G + c; if (L >= nwg) return false;
        int wgid = (int)L; { const int q = nwg / 8, r = nwg % 8, xcd = wgid % 8, off = wgid / 8; wgid = (xcd < r ? xcd * (q + 1) : r * (q + 1) + (xcd - r) * q) + off; }
        const int WGM = 8; const int nig = WGM * nN, gid = wgid / nig, fm = gid * WGM, gsz = (nM - fm) < WGM ? (nM - fm) : WGM;
        u.pm = fm + ((wgid % nig) % gsz); u.pn = (wgid % nig) / gsz; u.e = 0; u.mt = 0; u.nv = 256; u.aux = 0;
        u.ar = valid ? (u.pm >> 4) * TA + NMETA + (u.pm & 15) * 256 : u.pm * 256; return true;
    }
    __device__ __forceinline__ int row_of(const pg8::Unit&, int) const { return 0; }
    __device__ __forceinline__ void a_ready(const pg8::Unit&) const {}
    __device__ __forceinline__ void done(const pg8::Unit&) const {}
};
template <int NPN> struct MoeOrder {
    int ntiles, G, vcu; volatile LAS unsigned* TT; volatile LAS int* UB; volatile LAS int* CN; const int* list; int* tokslot; int write_slots;
    __device__ bool next(int i, pg8::Unit& u) const {
        const long L = (long)i * G + vcu; if (L >= (long)ntiles * NPN) return false;
        const int tile = (int)(L / NPN); u.pn = (int)(L % NPN); u.pm = tile;
        const unsigned tt = __builtin_amdgcn_readfirstlane(TT[tile]); u.e = (int)(tt & 0xffffu); u.mt = (int)(tt >> 16);
        const int ce = __builtin_amdgcn_readfirstlane(CN[u.e]);
        const int rem = ce - u.mt * 256; u.nv = rem < 256 ? rem : 256;
        u.aux = __builtin_amdgcn_readfirstlane(UB[u.e]) + u.mt * 256; u.ar = tile * 256; return true;
    }
    __device__ __forceinline__ int row_of(const pg8::Unit& u, int r) const {
        if (u.e == NE) return u.mt * 256 + r;
        return (r < u.nv) ? (list[(size_t)u.e * CAP + u.mt * 256 + r] >> 4) : 0;
    }
    __device__ __forceinline__ void a_ready(const pg8::Unit&) const {}
    __device__ __forceinline__ void done(const pg8::Unit& u) const {
        if (write_slots && u.pn == 0 && u.e < NE) { const int r = threadIdx.x; if (r < u.nv) { const int en = list[(size_t)u.e * CAP + u.mt * 256 + r]; tokslot[(size_t)(en >> 4) * 16 + (en & 15)] = u.aux + r; } }
    }
};

using pg8::u32x4;
typedef unsigned u32x2v __attribute__((ext_vector_type(2)));
typedef float f32x2v __attribute__((ext_vector_type(2)));
struct EpiIn {
    static constexpr bool PERM = true;
    bf16* base0; const float* b_gate; float qscale;
    __device__ __forceinline__ void operator()(const f32x4 (&acc)[2][2][4][2], const pg8::Unit& u, int wr, int wc, int fr, int fq) const {
        const int colt = u.pn * 256, t = colt >> 10, colw = colt & 1023;
        bf16* base = base0 + (size_t)t * (SLOTB / 2);
        const int row0 = u.pm * 256 + wr * 64 + fr, col0 = colw + wc * 32 + 8 * fq;
        f32x4 bv[2][2];
#pragma unroll
        for (int bj = 0; bj < 2; ++bj)
#pragma unroll
            for (int n = 0; n < 2; ++n) bv[bj][n] = (t >= 5) ? *(const f32x4*)(b_gate + (t - 5) * 1024 + col0 + bj * 128 + 4 * n) : (f32x4){0.f, 0.f, 0.f, 0.f};
#pragma unroll
        for (int ai = 0; ai < 2; ++ai)
#pragma unroll
            for (int m = 0; m < 4; ++m) { bf16* rowp = base + (size_t)(row0 + ai * 128 + m * 16) * D + col0;
#pragma unroll
                for (int bj = 0; bj < 2; ++bj) { f32x4 v0 = acc[ai][bj][m][0], v1 = acc[ai][bj][m][1];
                    if (t == 1) {
#pragma unroll
                        for (int j = 0; j < 4; ++j) { v0[j] = pg8::gelu_tanh(v0[j]); v1[j] = pg8::gelu_tanh(v1[j]); }
                    } else if (t == 2) { v0 = v0 * qscale; v1 = v1 * qscale; }
                    else if (t >= 5) { v0 = v0 + bv[bj][0]; v1 = v1 + bv[bj][1];
#pragma unroll
                        for (int j = 0; j < 4; ++j) { v0[j] = pg8::fast_sigmoid(v0[j]); v1[j] = pg8::fast_sigmoid(v1[j]); } }
                    u32x4 w; w.x = pg8::cvt_pk_bf16(v0[0], v0[1]); w.y = pg8::cvt_pk_bf16(v0[2], v0[3]); w.z = pg8::cvt_pk_bf16(v1[0], v1[1]); w.w = pg8::cvt_pk_bf16(v1[2], v1[3]);
                    *(u32x4*)(rowp + bj * 128) = w; } }
    }
};
struct EpiGate {
    static constexpr bool PERM = true;
    const bf16* gate; const bf16* add; bf16* out;
    __device__ __forceinline__ void operator()(const f32x4 (&acc)[2][2][4][2], const pg8::Unit& u, int wr, int wc, int fr, int fq) const {
        const int rl = wr * 64 + fr, col0 = u.pn * 256 + wc * 32 + 8 * fq;
#pragma unroll
        for (int ai = 0; ai < 2; ++ai)
#pragma unroll
            for (int m = 0; m < 4; ++m) { const int r = rl + ai * 128 + m * 16; const size_t off = (size_t)(u.pm * 256 + r) * D + col0, goff = (size_t)(u.ar + r) * D + col0;
#pragma unroll
                for (int bj = 0; bj < 2; ++bj) { const f32x4 a0 = acc[ai][bj][m][0], a1 = acc[ai][bj][m][1];
                    const u32x4 gw = *(const u32x4*)(gate + goff + bj * 128);
                    u32x4 aw = (u32x4){0u, 0u, 0u, 0u}; if (add) aw = *(const u32x4*)(add + off + bj * 128);
                    const float r0 = bfl(aw.x) + bfl(gw.x) * a0[0], r1 = bfh(aw.x) + bfh(gw.x) * a0[1], r2 = bfl(aw.y) + bfl(gw.y) * a0[2], r3 = bfh(aw.y) + bfh(gw.y) * a0[3];
                    const float r4 = bfl(aw.z) + bfl(gw.z) * a1[0], r5 = bfh(aw.z) + bfh(gw.z) * a1[1], r6 = bfl(aw.w) + bfl(gw.w) * a1[2], r7 = bfh(aw.w) + bfh(gw.w) * a1[3];
                    u32x4 w; w.x = pg8::cvt_pk_bf16(r0, r1); w.y = pg8::cvt_pk_bf16(r2, r3); w.z = pg8::cvt_pk_bf16(r4, r5); w.w = pg8::cvt_pk_bf16(r6, r7);
                    *(u32x4*)(out + off + bj * 128) = w; } }
    }
};
struct EpiZ {
    static constexpr bool PERM = false;
    const float* x; const float* g0; const float* b0; const float* rowstat; float* Z;
    __device__ __forceinline__ void operator()(const f32x4 (&acc)[2][2][4][2], const pg8::Unit& u, int wr, int wc, int fr, int fq) const {
        const int col0 = u.pn * 256 + wc * 32 + 4 * fq;
        f32x4 gv[2][2], bv[2][2];
#pragma unroll
        for (int bj = 0; bj < 2; ++bj)
#pragma unroll
            for (int n = 0; n < 2; ++n) { gv[bj][n] = *(const f32x4*)(g0 + col0 + bj * 128 + n * 16); bv[bj][n] = *(const f32x4*)(b0 + col0 + bj * 128 + n * 16); }
#pragma unroll
        for (int ai = 0; ai < 2; ++ai)
#pragma unroll
            for (int m = 0; m < 4; ++m) { const int r = ai * 128 + wr * 64 + m * 16 + fr; const int p = u.pm * 256 + r, rt = (p >> 12) * TA + NMETA + (p & 4095);
                const float* xr = x + (size_t)p * D; const float mean = rowstat[2 * rt], rstd = rowstat[2 * rt + 1];
#pragma unroll
                for (int bj = 0; bj < 2; ++bj)
#pragma unroll
                    for (int n = 0; n < 2; ++n) { const int c = col0 + bj * 128 + n * 16; const f32x4 xv = *(const f32x4*)(xr + c);
                        const f32x4 h0 = (xv - mean) * rstd * gv[bj][n] + bv[bj][n];
                        *(f32x4*)(Z + (size_t)p * D + c) = h0 * ALPHA + acc[ai][bj][m][n]; } }
    }
};
struct EpiF32 {
    static constexpr bool PERM = false;
    float* out; int ldc;
    __device__ __forceinline__ void operator()(const f32x4 (&acc)[2][2][4][2], const pg8::Unit& u, int wr, int wc, int fr, int fq) const {
        const int col0 = u.pn * 256 + wc * 32 + 4 * fq;
#pragma unroll
        for (int ai = 0; ai < 2; ++ai)
#pragma unroll
            for (int m = 0; m < 4; ++m) { const int row = u.pm * 256 + ai * 128 + wr * 64 + m * 16 + fr;
#pragma unroll
                for (int bj = 0; bj < 2; ++bj)
#pragma unroll
                    for (int n = 0; n < 2; ++n) *(f32x4*)(out + (size_t)row * ldc + col0 + bj * 128 + n * 16) = acc[ai][bj][m][n]; }
    }
};
struct EpiAct {
    static constexpr bool PERM = true;
    bf16* act;
    __device__ __forceinline__ void operator()(const f32x4 (&acc)[2][2][4][2], const pg8::Unit& u, int wr, int wc, int fr, int fq) const {
        const int row0 = u.pm * 256 + wr * 64 + fr, col0 = u.pn * 128 + wc * 32 + 8 * fq;
#pragma unroll
        for (int ai = 0; ai < 2; ++ai)
#pragma unroll
            for (int m = 0; m < 4; ++m) { float r[8];
#pragma unroll
                for (int n = 0; n < 2; ++n)
#pragma unroll
                    for (int j = 0; j < 4; ++j) { const float gte = acc[ai][0][m][n][j], up = acc[ai][1][m][n][j]; r[n * 4 + j] = gte * pg8::fast_sigmoid(gte) * up; }
                u32x4 w; w.x = pg8::cvt_pk_bf16(r[0], r[1]); w.y = pg8::cvt_pk_bf16(r[2], r[3]); w.z = pg8::cvt_pk_bf16(r[4], r[5]); w.w = pg8::cvt_pk_bf16(r[6], r[7]);
                *(u32x4*)(act + (size_t)(row0 + ai * 128 + m * 16) * DE + col0) = w; }
    }
};
struct EpiY {
    static constexpr bool PERM = true;
    bf16* Y;
    __device__ __forceinline__ void operator()(const f32x4 (&acc)[2][2][4][2], const pg8::Unit& u, int wr, int wc, int fr, int fq) const {
        const int r0 = wr * 64 + fr, col0 = u.pn * 256 + wc * 32 + 8 * fq;
#pragma unroll
        for (int ai = 0; ai < 2; ++ai)
#pragma unroll
            for (int m = 0; m < 4; ++m) { const int r = r0 + ai * 128 + m * 16; const int yr = (r < u.nv) ? (u.aux + r) : YDUMMY;
                bf16* rowp = Y + (size_t)yr * D + col0;
#pragma unroll
                for (int bj = 0; bj < 2; ++bj) { const f32x4 v0 = acc[ai][bj][m][0], v1 = acc[ai][bj][m][1];
                    u32x4 w; w.x = pg8::cvt_pk_bf16(v0[0], v0[1]); w.y = pg8::cvt_pk_bf16(v0[2], v0[3]); w.z = pg8::cvt_pk_bf16(v1[0], v1[1]); w.w = pg8::cvt_pk_bf16(v1[2], v1[3]);
                    *(u32x4*)(rowp + bj * 128) = w; } }
    }
};

__device__ __forceinline__ void transpose_item(const float* W, int K, int N, bf16* WT, int row_base, int gu, LAS float* scr, int item, int lane) {
    const int nblk = N / 32, kb = item / nblk, nb = item % nblk, k0 = 64 * kb, n0 = 32 * nb;
    const int r0 = row_base + (gu ? ((n0 >> 7) * 256 + (n0 & 127)) : n0);
#pragma unroll 8
    for (int i = 0; i < 32; ++i) { const int kk = 2 * i + (lane >> 5); scr[kk * 33 + (lane & 31)] = W[(size_t)(k0 + kk) * N + n0 + (lane & 31)]; }
    LDS_WAIT(); asm volatile("" ::: "memory");
    const int c = lane & 7;
#pragma unroll
    for (int j = 0; j < 4; ++j) { const int n = (lane >> 3) + 8 * j; const LAS float* s = scr + (8 * c) * 33 + n;
        v4u o; o.x = pk2(s[0 * 33], s[1 * 33]); o.y = pk2(s[2 * 33], s[3 * 33]); o.z = pk2(s[4 * 33], s[5 * 33]); o.w = pk2(s[6 * 33], s[7 * 33]);
        *(GAS v4u*)(WT + (size_t)(r0 + n) * K + k0 + 8 * c) = o; }
    LDS_WAIT(); asm volatile("" ::: "memory");
}
__device__ __forceinline__ void ln_row_to_bf16(const float* xrow, const float* g, const float* b, bf16* orow, float* stat, int lane) {
    const GAS f32x4* xr = (const GAS f32x4*)xrow + lane;
    f32x4 v[4]; float s = 0.f;
#pragma unroll
    for (int j = 0; j < 4; ++j) { v[j] = xr[64 * j]; s += (v[j].x + v[j].y) + (v[j].z + v[j].w); }
    const float mean = wave_sum(s) * (1.f / D); float s2 = 0.f;
#pragma unroll
    for (int j = 0; j < 4; ++j) { v[j] = v[j] - mean; s2 += (v[j].x * v[j].x + v[j].y * v[j].y) + (v[j].z * v[j].z + v[j].w * v[j].w); }
    const float rstd = 1.f / sqrtf(wave_sum(s2) * (1.f / D) + LN_EPS);
    if (stat && lane == 0) { stat[0] = mean; stat[1] = rstd; }
    GAS unsigned long long* o8 = (GAS unsigned long long*)orow + lane;
#pragma unroll
    for (int j = 0; j < 4; ++j) { const f32x4 gg = *((const f32x4*)g + lane + 64 * j), bb = *((const f32x4*)b + lane + 64 * j); const f32x4 y = v[j] * rstd * gg + bb;
        o8[64 * j] = (unsigned long long)pk2(y.x, y.y) | ((unsigned long long)pk2(y.z, y.w) << 32); }
}

__device__ __forceinline__ int crow16(int r, int hi) { return (r & 3) + 8 * (r >> 2) + 4 * hi; }
typedef float f32x16 __attribute__((ext_vector_type(16)));
struct ScanArgs { const bf16* XR; const bf16* YG; bf16* REC; const float* conv_w; const float* conv_b; const bf16* lruwt; const float* b_a; const float* b_i; const float* lam; float* scansum; };
__device__ __forceinline__ float xlane32(float v) { return __shfl_xor(v, 32); }
template <bool FINAL>
__device__ __forceinline__ void scan_phase(const ScanArgs& A, LAS unsigned char* lds, int vcu, int G) {
    const int tid = threadIdx.x, lane = tid & 63, wave = __builtin_amdgcn_readfirstlane(tid >> 6);
    const int nb = vcu & 7, cun = vcu >> 3, nslots = (G >> 3) * 8;
    const int cc = lane & 15, rg = lane >> 4;
    const int l31 = lane & 31, hi = lane >> 5;
#pragma unroll
    for (int i = 0; i < 8; ++i) { const int idx = tid + 512 * i, n = idx >> 4, ch = idx & 15; const int gt = n >> 7, col = n & 127;
        const v4u w = *(const v4u*)(A.lruwt + ((size_t)((gt * 8 + nb) * 128 + col)) * 128 + ch * 8);
        *(LAS v4u*)(lds + n * 272 + ch * 16) = w; }
    __syncthreads();
    constexpr int SPW = 272;
    LAS unsigned char* TL = lds + (wave < 7 ? 256 * SPW + wave * 32 * SPW : LDSCTL_OFF + 1024);
    LAS unsigned char* const WLb = lds + l31 * SPW + hi * 16;
    LAS unsigned char* const TLa = TL + l31 * SPW + hi * 16;
    LAS unsigned char* const TLx = TL + hi * (4 * SPW) + l31 * 2;
    LAS unsigned char* const TLs = TL + rg * (8 * SPW) + cc * 16;
    LAS float* CWL = (LAS float*)(lds + LDSCTL_OFF + 1024 + 32 * SPW);
    if (tid < 160) { const int k = tid >> 5, c4 = (tid & 31) * 4; const f32x4 w = (k < 4) ? *(const f32x4*)(A.conv_w + k * D + nb * 128 + c4) : *(const f32x4*)(A.conv_b + nb * 128 + c4); *(LAS f32x4*)(CWL + k * 128 + c4) = w; }
    __syncthreads();
    float gba[4], gbi[4], gk8[4];
#pragma unroll
    for (int q = 0; q < 4; ++q) { const int C = nb * 128 + 32 * q + l31; gba[q] = A.b_a[C]; gbi[q] = A.b_i[C]; const float lm = A.lam[C];
        const float sp = (-lm > 20.f) ? -lm : log1pf(__expf(-lm)); gk8[q] = -8.0f * sp * 1.4426950408889634f; }
    for (int wv = cun * 8 + wave; wv < 256; wv += nslots) {
        const int b = wv >> 5, ri = wv & 31; const int sb0 = ri == 0 ? 0 : 4 * ri + 1, nsb = ri == 0 ? 5 : 4;
        const size_t rowb = (size_t)b * TA;
        float hc[4], Ac[4];
#pragma unroll
        for (int q = 0; q < 4; ++q) { hc[q] = 0.f; Ac[q] = 1.f; }
        if (FINAL) {
            float h0 = 0.f, h1 = 0.f;
#pragma unroll 1
            for (int j0 = 0; j0 < ri; j0 += 8) { f32x4 s[8];
#pragma unroll
                for (int i = 0; i < 8; ++i) { const int j = j0 + i; const int jc = j < ri ? j : 0; s[i] = *(const f32x4*)(A.scansum + ((size_t)(b * 32 + jc) * D + nb * 128 + 2 * lane) * 2); if (j >= ri) s[i] = (f32x4){1.f, 0.f, 1.f, 0.f}; }
#pragma unroll
                for (int i = 0; i < 8; ++i) { h0 = s[i].x * h0 + s[i].y; h1 = s[i].z * h1 + s[i].w; } }
            ((LAS float*)TL)[2 * lane] = h0; ((LAS float*)TL)[2 * lane + 1] = h1;
            asm volatile("s_waitcnt lgkmcnt(0)" ::: "memory");
#pragma unroll
            for (int q = 0; q < 4; ++q) hc[q] = ((LAS float*)TL)[32 * q + l31];
            asm volatile("s_waitcnt lgkmcnt(0)" ::: "memory");
        }
#pragma unroll 1
        for (int s = 0; s < nsb; ++s) {
            const int t0 = 32 * (sb0 + s);
            v4u xv[11];
#pragma unroll
            for (int i = 0; i < 11; ++i) { int tt = t0 + 8 * rg - 3 + i; const bool neg = tt < 0; tt = neg ? 0 : tt; xv[i] = *(const v4u*)(A.XR + (rowb + tt) * D + nb * 128 + cc * 8); if (i < 3 && neg) xv[i] = (v4u){0u, 0u, 0u, 0u}; }
            { f32x4 w0[4], w1[4];
#pragma unroll
              for (int k = 0; k < 4; ++k) { w0[k] = *(const LAS f32x4*)(CWL + k * 128 + cc * 8); w1[k] = *(const LAS f32x4*)(CWL + k * 128 + cc * 8 + 4); }
              const f32x4 cb0 = *(const LAS f32x4*)(CWL + 4 * 128 + cc * 8), cb1 = *(const LAS f32x4*)(CWL + 4 * 128 + cc * 8 + 4);
#pragma unroll
              for (int i = 0; i < 8; ++i) { float o[8]; o[0] = cb0.x; o[1] = cb0.y; o[2] = cb0.z; o[3] = cb0.w; o[4] = cb1.x; o[5] = cb1.y; o[6] = cb1.z; o[7] = cb1.w;
#pragma unroll
                for (int k = 0; k < 4; ++k) { const v4u x4 = xv[i + k]; const f32x4 a0 = w0[k], a1 = w1[k];
                    o[0] += a0.x * bfl(x4.x); o[1] += a0.y * bfh(x4.x); o[2] += a0.z * bfl(x4.y); o[3] += a0.w * bfh(x4.y);
                    o[4] += a1.x * bfl(x4.z); o[5] += a1.y * bfh(x4.z); o[6] += a1.z * bfl(x4.w); o[7] += a1.w * bfh(x4.w); }
                v4u w; w.x = pk2(o[0], o[1]); w.y = pk2(o[2], o[3]); w.z = pk2(o[4], o[5]); w.w = pk2(o[6], o[7]);
                *(LAS v4u*)(TLs + i * SPW) = w; } }
            asm volatile("s_waitcnt lgkmcnt(0)" ::: "memory");
            bf16x8 af[8];
#pragma unroll
            for (int k8 = 0; k8 < 8; ++k8) af[k8] = *(const LAS bf16x8*)(TLa + k8 * 32);
#pragma unroll
            for (int hh = 0; hh < 2; ++hh) {
                f32x16 acc[2][2];
#pragma unroll
                for (int gt = 0; gt < 2; ++gt)
#pragma unroll
                    for (int cb = 0; cb < 2; ++cb) acc[gt][cb] = f32x16{};
#pragma unroll
                for (int k8 = 0; k8 < 8; ++k8) {
#pragma unroll
                    for (int gt = 0; gt < 2; ++gt)
#pragma unroll
                        for (int cb = 0; cb < 2; ++cb) {
                            const bf16x8 bfv = *(const LAS bf16x8*)(WLb + (gt * 128 + 64 * hh + 32 * cb) * SPW + k8 * 32);
                            acc[gt][cb] = __builtin_amdgcn_mfma_f32_32x32x16_bf16(af[k8], bfv, acc[gt][cb], 0, 0, 0); }
                }
#pragma unroll
                for (int cb = 0; cb < 2; ++cb) { const int q = 2 * hh + cb, c = 32 * q + l31;
                    float av[16], bt[16];
#pragma unroll
                    for (int rr = 0; rr < 16; ++rr) { const int row = crow16(rr, hi);
                        const float rgt = pg8::fast_sigmoid(acc[0][cb][rr] + gba[q]), igt = pg8::fast_sigmoid(acc[1][cb][rr] + gbi[q]);
                        const float a = __builtin_amdgcn_exp2f(gk8[q] * rgt); float mult = __builtin_amdgcn_sqrtf(fmaxf(1.0f - a * a, 0.f));
                        if (rr == 0 && t0 == 0 && hi == 0) mult = 1.0f;
                        const float xc = bf1(*(const LAS bf16*)(TLx + crow16(rr, 0) * SPW + q * 64));
                        av[rr] = a; bt[rr] = mult * igt * xc; }
                    float Ao[4], Bo[4], Ap[4], Bp[4];
#pragma unroll
                    for (int j = 0; j < 4; ++j) { float Ag = av[4 * j], Bg = bt[4 * j];
#pragma unroll
                        for (int k = 1; k < 4; ++k) { Bg = av[4 * j + k] * Bg + bt[4 * j + k]; Ag *= av[4 * j + k]; }
                        Ao[j] = Ag; Bo[j] = Bg; Ap[j] = xlane32(Ag); Bp[j] = xlane32(Bg); }
                    float h = hc[q]; float hin[4];
#pragma unroll
                    for (int j = 0; j < 4; ++j) {
                        const float Ae = hi ? Ap[j] : Ao[j], Be = hi ? Bp[j] : Bo[j], Aod = hi ? Ao[j] : Ap[j], Bod = hi ? Bo[j] : Bp[j];
                        const float h_even_in = h; const float h_odd_in = Ae * h + Be; h = Aod * h_odd_in + Bod;
                        hin[j] = hi ? h_odd_in : h_even_in; Ac[q] *= Ae * Aod; }
                    hc[q] = h;
                    if (FINAL) {
#pragma unroll
                        for (int j = 0; j < 4; ++j) { float hh2 = hin[j];
#pragma unroll
                            for (int k = 0; k < 4; ++k) { const int rr = 4 * j + k, row = crow16(rr, hi); hh2 = av[rr] * hh2 + bt[rr];
                                *(LAS bf16*)(TLx + crow16(rr, 0) * SPW + q * 64) = (bf16)f2bf(hh2); } } }
                }
            }
            if (FINAL) {
                v4u yv[8];
#pragma unroll
                for (int i = 0; i < 8; ++i) yv[i] = *(const v4u*)(A.YG + (rowb + t0 + 8 * rg + i) * D + nb * 128 + cc * 8);
                asm volatile("s_waitcnt lgkmcnt(0)" ::: "memory");
#pragma unroll
                for (int i = 0; i < 8; ++i) { const int row = 8 * rg + i; const v4u hv = *(const LAS v4u*)(TLs + i * SPW); const v4u y = yv[i];
                    v4u o; o.x = pk2(bfl(hv.x) * bfl(y.x), bfh(hv.x) * bfh(y.x)); o.y = pk2(bfl(hv.y) * bfl(y.y), bfh(hv.y) * bfh(y.y)); o.z = pk2(bfl(hv.z) * bfl(y.z), bfh(hv.z) * bfh(y.z)); o.w = pk2(bfl(hv.w) * bfl(y.w), bfh(hv.w) * bfh(y.w));
                    *(v4u*)(A.REC + (rowb + t0 + row) * D + nb * 128 + cc * 8) = o; }
                asm volatile("s_waitcnt lgkmcnt(0)" ::: "memory");
            }
        }
        if (!FINAL && hi == 0) {
#pragma unroll
            for (int q = 0; q < 4; ++q) { float* sm = A.scansum + ((size_t)(b * 32 + ri) * D + nb * 128 + 32 * q + l31) * 2; sm[0] = Ac[q]; sm[1] = hc[q]; } }
    }
    __syncthreads();
}

__device__ __forceinline__ void route_token(const float* logits, const float* rbias, int row, unsigned* cnt, int* list, float* tokw, int lane) {
    const f32x4 lg = *((const f32x4*)(logits + (size_t)row * NE) + lane); const f32x4 rb = *((const f32x4*)rbias + lane);
    float sc[4], sel[4];
#pragma unroll
    for (int j = 0; j < 4; ++j) { sc[j] = 1.0f / (1.0f + expf(-lg[j])); sel[j] = sc[j] + rb[j]; }
    float m1 = fmaxf(sel[0], sel[1]), m2 = fminf(sel[0], sel[1]);
#pragma unroll
    for (int j = 2; j < 4; ++j) { const float v = sel[j]; m2 = fmaxf(m2, fminf(m1, v)); m1 = fmaxf(m1, v); }
#pragma unroll
    for (int o = 1; o < 8; o <<= 1) { const float o1 = __shfl_xor(m1, o), o2 = __shfl_xor(m2, o); m2 = fmaxf(fminf(m1, o1), fmaxf(m2, o2)); m1 = fmaxf(m1, o1); }
    const float gs = m1 + m2; const int g = lane >> 3; int rank = 0;
#pragma unroll
    for (int gg = 0; gg < 8; ++gg) { const float og = __shfl(gs, gg * 8); rank += (og > gs || (og == gs && gg < g)) ? 1 : 0; }
    const bool gsel = rank < 4;
#pragma unroll
    for (int j = 0; j < 4; ++j) if (!gsel) sel[j] = -INFINITY;
    float wk = 0.f; int ek = 0; float ssum = 0.f;
#pragma unroll 1
    for (int k = 0; k < TOPK; ++k) {
        float bv = sel[0]; int bi = 4 * lane;
#pragma unroll
        for (int j = 1; j < 4; ++j) if (sel[j] > bv) { bv = sel[j]; bi = 4 * lane + j; }
#pragma unroll
        for (int o = 1; o < 64; o <<= 1) { const float ov = __shfl_xor(bv, o); const int oi = __shfl_xor(bi, o); if (ov > bv || (ov == bv && oi < bi)) { bv = ov; bi = oi; } }
        const int own = bi >> 2, jj = bi & 3;
        float s = 0.f;
        if (lane == own) {
#pragma unroll
            for (int j = 0; j < 4; ++j) if (j == jj) { s = sc[j]; sel[j] = -INFINITY; } }
        s = __shfl(s, own);
        ssum += s; if (lane == k) { wk = s; ek = bi; }
    }
    if (lane < TOPK) { const float w = wk / ssum * ROUTED_SCALE; const unsigned pos = atomicAdd(cnt + ek, 1u); if (pos < (unsigned)CAP) list[(size_t)ek * CAP + pos] = (row << 4) | lane; tokw[(size_t)row * 16 + lane] = w; }
}

struct Args { const float* in[33]; float* out; unsigned char* ws; int ph_lo, ph_hi, li, pad; };
__global__ void __launch_bounds__(NWAVES * 64, 2) mega_fwd(Args args) {
    extern __shared__ __attribute__((aligned(16))) unsigned char lds[];
    LAS unsigned char* L = (LAS unsigned char*)lds;
    volatile LAS unsigned* MISC = (volatile LAS unsigned*)(L + MISC_OFF);
    const int tid = threadIdx.x, lane = tid & 63, wave = __builtin_amdgcn_readfirstlane(tid >> 6);
    const int G = gridDim.x; const int bx = blockIdx.x; const int vcu = (G % 8 == 0) ? (bx % 8) * (G / 8) + bx / 8 : bx;
    unsigned char* ws = args.ws;
    gu32* ctl = (gu32*)(ws + WS_CTL);
    for (int u = tid; u < (LDS_BYTES - LDSCTL_OFF) / 4; u += NWAVES * 64) ((LAS unsigned*)(L + LDSCTL_OFF))[u] = 0u;
    __syncthreads();
    XcdBarrier bar; bar.bar = (unsigned*)(ctl + CW_BAR); bar.x = 0; bar.st = nullptr;
    if (N_LAUNCHES == 1) bar = xcd_barrier_post((unsigned*)(ctl + CW_BAR), MISC + 8);
#define GRID_BAR() do { if (N_LAUNCHES == 1) xcd_barrier(bar); } while (0)
#if MK_DIAG
    int n_stamp = 0;
#define STAMP() do { if (blockIdx.x == 0 && tid == 0) { ((unsigned long long*)(ctl + CW_DIAG))[n_stamp] = __builtin_amdgcn_s_memrealtime(); } ++n_stamp; } while (0)
#else
#define STAMP() do {} while (0)
#endif
    STAMP();
    const int lo = args.ph_lo, hi = args.ph_hi;
#ifndef MK_REPEAT_MASK
#define MK_REPEAT_MASK 0
#endif
#ifndef MK_PHASE_MASK
#define MK_PHASE_MASK 0xffff
#endif
#define IN(k) ((((MK_PHASE_MASK) >> (k)) & 1) && lo <= (k) && (k) < hi)
#define BOTH(k) (IN(k) && IN((k) + 1))
    const int gw = vcu * NWAVES + wave, NGW = G * NWAVES;
    const float* x = args.in[0]; const float* meta = args.in[1];

    if (IN(0)) {
        LAS float* scr = (LAS float*)(L + RING_OFF + wave * 16384);
        constexpr int I_IN = 16 * (NIN / 32), I_SQ = 16 * 32, I_RT = 16 * 8, I_LRU = 2 * 8 * 2 * 4;
        constexpr int NITEMS = I_IN + 3 * I_SQ + I_RT + I_LRU;
        for (int it = gw; it < NITEMS; it += NGW) {
            int r = it;
            if (r < I_IN) { transpose_item(args.in[4], D, NIN, (bf16*)(ws + WS_WIN), 0, 0, scr, r, lane); continue; } r -= I_IN;
            if (r < I_SQ) { transpose_item(args.in[18], D, D, (bf16*)(ws + WS_WR), 0, 0, scr, r, lane); continue; } r -= I_SQ;
            if (r < I_SQ) { transpose_item(args.in[19], D, D, (bf16*)(ws + WS_WA), 0, 0, scr, r, lane); continue; } r -= I_SQ;
            if (r < I_SQ) { transpose_item(args.in[20], D, D, (bf16*)(ws + WS_WO), 0, 0, scr, r, lane); continue; } r -= I_SQ;
            if (r < I_RT) { transpose_item(args.in[23], D, NE, (bf16*)(ws + WS_WROUT), 0, 0, scr, r, lane); continue; } r -= I_RT;
            { const int m = r >> 3, it2 = r & 7, gt = m >> 3, blk = m & 7;
              transpose_item(args.in[gt ? 10 : 8] + (size_t)blk * 128 * 128, 128, 128, (bf16*)(ws + WS_LRUWT) + (size_t)(gt * 8 + blk) * 128 * 128, 0, 0, scr, it2, lane); }
        }
        for (int m = gw; m < MA; m += NGW) { const int b = m / TA, t = m - b * TA; bf16* orow = (bf16*)(ws + WS_XN) + (size_t)m * D;
            if (t < TV) { const float* xr = (t < NMETA) ? meta + (size_t)t * D : x + ((size_t)b * SEQ + (t - NMETA)) * D;
                ln_row_to_bf16(xr, args.in[2], args.in[3], orow, (float*)(ws + WS_ROWSTAT) + 2 * (size_t)m, lane); }
            else { GAS unsigned long long* o8 = (GAS unsigned long long*)orow + lane;
#pragma unroll
                for (int j = 0; j < 4; ++j) o8[64 * j] = 0ull; } }
        if (BOTH(0)) GRID_BAR();
        STAMP();
    }
    if (IN(1)) {
        pg8::Gemm g{(const bf16*)(ws + WS_XN), (const bf16*)(ws + WS_WIN), D, 0}; DenseOrder S; S.init(MA, NIN, G, bx);
        EpiIn E{(bf16*)(ws + WS_XR), args.in[5], 0.125f * 1.4426950408889634f};
        pg8::gemm_phase<EpiIn, DenseOrder, true, false>(L + RING_OFF, g, S, E);
        if (BOTH(1)) GRID_BAR();
        STAMP();
    }
    ScanArgs SA{(const bf16*)(ws + WS_XR), (const bf16*)(ws + WS_YG), (bf16*)(ws + WS_REC), args.in[6], args.in[7], (const bf16*)(ws + WS_LRUWT), args.in[9], args.in[11], args.in[12], (float*)(ws + WS_SCANSUM)};
    if (IN(2)) {
        scan_phase<false>(SA, L + RING_OFF, vcu, G);
        if (BOTH(2)) GRID_BAR();
        STAMP();
    }
    if (IN(3)) {
        scan_phase<true>(SA, L + RING_OFF, vcu, G);
        { const int bh = vcu >> 2, sub = vcu & 3, m = sub >> 1, part = sub & 1, b = bh >> 3, h = bh & 7;
          if (bh < NB * 8) {
              const attn2::AttnTensors AT{(const attn2::bf16*)(ws + WS_Q), (const attn2::bf16*)(ws + WS_K), (const attn2::bf16*)(ws + WS_V), (attn2::bf16*)(ws + (m ? WS_O1 : WS_O0))};
              const attn2::SplitOrder AS{b, 2 * h + m, h, part};
              attn2::attn_phase<attn2::SplitOrder>((char*)lds + RING_OFF, AT, AS);
          } }
        if (BOTH(3)) GRID_BAR();
        STAMP();
    }
    if (IN(4)) {
        const float lamq = wave_sum(args.in[13][lane] * args.in[14][lane]), lamq2 = wave_sum(args.in[15][lane] * args.in[16][lane]);
        const float lam = expf(lamq) - expf(lamq2) + LAMBDA_INIT;
        const bf16* O0 = (const bf16*)(ws + WS_O0); const bf16* O1 = (const bf16*)(ws + WS_O1); bf16* ATT = (bf16*)(ws + WS_ATT);
        for (int m = gw; m < MA; m += NGW) {
#pragma unroll
            for (int j = 0; j < 2; ++j) { const int c = j * 512 + lane * 8; const v4u a = *(const v4u*)(O0 + (size_t)m * D + c), bq = *(const v4u*)(O1 + (size_t)m * D + c);
                float d[8]; d[0] = bfl(a.x) - lam * bfl(bq.x); d[1] = bfh(a.x) - lam * bfh(bq.x); d[2] = bfl(a.y) - lam * bfl(bq.y); d[3] = bfh(a.y) - lam * bfh(bq.y);
                d[4] = bfl(a.z) - lam * bfl(bq.z); d[5] = bfh(a.z) - lam * bfh(bq.z); d[6] = bfl(a.w) - lam * bfl(bq.w); d[7] = bfh(a.w) - lam * bfh(bq.w);
                float ss = 0.f;
#pragma unroll
                for (int q = 0; q < 8; ++q) ss += d[q] * d[q];
                ss += __shfl_xor(ss, 1); ss += __shfl_xor(ss, 2); ss += __shfl_xor(ss, 4); ss += __shfl_xor(ss, 8);
                const float rs = (1.0f - LAMBDA_INIT) / sqrtf(ss * (1.0f / 128.f) + LN_EPS);
                const int e0 = c & 127; const f32x4 g0 = *(const f32x4*)(args.in[17] + e0), g1 = *(const f32x4*)(args.in[17] + e0 + 4);
                v4u w; w.x = pk2(d[0] * rs * g0.x, d[1] * rs * g0.y); w.y = pk2(d[2] * rs * g0.z, d[3] * rs * g0.w); w.z = pk2(d[4] * rs * g1.x, d[5] * rs * g1.y); w.w = pk2(d[6] * rs * g1.z, d[7] * rs * g1.w);
                *(v4u*)(ATT + (size_t)m * D + c) = w; } }
        if (BOTH(4)) GRID_BAR();
        STAMP();
    }
    if (IN(5)) {
        pg8::Gemm g{(const bf16*)(ws + WS_REC), (const bf16*)(ws + WS_WR), D, 0}; DenseOrder S; S.init(NVALID, D, G, bx, 1);
        EpiGate E{(const bf16*)(ws + WS_GR), nullptr, (bf16*)(ws + WS_T1)};
        pg8::gemm_phase<EpiGate, DenseOrder, true, false>(L + RING_OFF, g, S, E);
        if (BOTH(5)) GRID_BAR();
        STAMP();
    }
    if (IN(6)) {
        pg8::Gemm g{(const bf16*)(ws + WS_ATT), (const bf16*)(ws + WS_WA), D, 0}; DenseOrder S; S.init(NVALID, D, G, bx, 1);
        EpiGate E{(const bf16*)(ws + WS_GA), (const bf16*)(ws + WS_T1), (bf16*)(ws + WS_U)};
        pg8::gemm_phase<EpiGate, DenseOrder, true, false>(L + RING_OFF, g, S, E);
        if (BOTH(6)) GRID_BAR();
        STAMP();
    }
    if (IN(7)) {
        pg8::Gemm g{(const bf16*)(ws + WS_U), (const bf16*)(ws + WS_WO), D, 0}; DenseOrder S; S.init(NVALID, D, G, bx, 0);
        EpiZ E{x, args.in[2], args.in[3], (const float*)(ws + WS_ROWSTAT), (float*)(ws + WS_Z)};
        pg8::gemm_phase<EpiZ, DenseOrder, true, false>(L + RING_OFF, g, S, E);
        if (BOTH(7)) GRID_BAR();
        STAMP();
    }
    if (IN(8)) {
        for (int m = gw; m < NVALID; m += NGW) ln_row_to_bf16((const float*)(ws + WS_Z) + (size_t)m * D, args.in[21], args.in[22], (bf16*)(ws + WS_H1B) + (size_t)m * D, nullptr, lane);
        if (BOTH(8)) GRID_BAR();
        STAMP();
    }
    if (IN(9)) {
        { pg8::Gemm g{(const bf16*)(ws + WS_H1B), (const bf16*)(ws + WS_WROUT), D, 0}; DenseOrder S; S.init(NVALID, NE, G, bx, 0);
          EpiF32 E{(float*)(ws + WS_LOGITS), NE};
          pg8::gemm_phase<EpiF32, DenseOrder, false, false>(L + RING_OFF, g, S, E); }
        LAS float* scr = (LAS float*)(L + RING_OFF + wave * 16384);
        constexpr int IPE = 128;
        for (int it = gw; it < 257 * 3 * IPE; it += NGW) { const int e = it / (3 * IPE), r = it - e * 3 * IPE, which = r / IPE, i2 = r - which * IPE;
            if (which < 2) { const float* W = (e < NE) ? args.in[25 + which] + (size_t)e * D * DE : args.in[28 + which];
                transpose_item(W, D, DE, (bf16*)(ws + WS_WGU), e * 512 + which * 128, 1, scr, i2, lane); }
            else { const float* W = (e < NE) ? args.in[27] + (size_t)e * DE * D : args.in[30];
                transpose_item(W, DE, D, (bf16*)(ws + WS_WD) + (size_t)e * D * DE, 0, 0, scr, i2, lane); } }
        if (BOTH(9)) GRID_BAR();
        STAMP();
    }
    if (IN(10)) {
        for (int p = gw; p < NVALID; p += NGW) { const int row = p;
            route_token((const float*)(ws + WS_LOGITS), args.in[24], row, (unsigned*)(ctl + CW_CNT), (int*)(ws + WS_LIST), (float*)(ws + WS_TOKW), lane); }
        if (BOTH(10)) GRID_BAR();
        STAMP();
    }
    if (IN(11) || IN(12)) {
        volatile LAS unsigned* TT = (volatile LAS unsigned*)(L + TT_OFF); volatile LAS int* UB = (volatile LAS int*)(L + UB_OFF);
        const unsigned* cnt = (const unsigned*)(ctl + CW_CNT);
        volatile LAS int* CN = (volatile LAS int*)(L + CN_OFF); volatile LAS int* TB = (volatile LAS int*)(L + TB_OFF);
        if (tid <= NE) { int c = (tid == NE) ? NVALID : (int)__hip_atomic_load(cnt + tid, RLX_AGENT); if (c > CAP) c = CAP; CN[tid] = c; }
        __syncthreads();
        if (tid == 0) { int tb = 0, ub = 0;
            for (int e = 0; e <= NE; ++e) { const int c = CN[e]; int ntl = (c + 255) >> 8; if (tb + ntl > MAXTILES) ntl = MAXTILES - tb; UB[e] = ub; TB[e] = tb; ub += c; tb += ntl; }
            TB[NE + 1] = tb; MISC[16] = (unsigned)tb; }
        __syncthreads();
        if (tid <= NE) { const int t0 = TB[tid], t1 = TB[tid + 1]; for (int t = t0; t < t1; ++t) TT[t] = (unsigned)tid | ((unsigned)(t - t0) << 16); }
        __syncthreads();
        const int ntiles = (int)MISC[16];
        if (IN(11)) {
            pg8::Gemm g{(const bf16*)(ws + WS_H1B), (const bf16*)(ws + WS_WGU), D, (size_t)512 * D};
            MoeOrder<2> S{ntiles, G, vcu, TT, UB, CN, (const int*)(ws + WS_LIST), (int*)(ws + WS_TOKSLOT), 1};
            EpiAct E{(bf16*)(ws + WS_ACT)};
            pg8::gemm_phase<EpiAct, MoeOrder<2>, true, true>(L + RING_OFF, g, S, E);
            if (BOTH(11)) GRID_BAR();
            STAMP();
        STAMP();
        }
        if (IN(12)) {
            pg8::Gemm g{(const bf16*)(ws + WS_ACT), (const bf16*)(ws + WS_WD), DE, (size_t)D * DE};
            MoeOrder<4> S{ntiles, G, vcu, TT, UB, CN, (const int*)(ws + WS_LIST), (int*)(ws + WS_TOKSLOT), 0};
            EpiY E{(bf16*)(ws + WS_Y)};
            pg8::gemm_phase<EpiY, MoeOrder<4>, true, false>(L + RING_OFF, g, S, E);
            if (BOTH(12)) GRID_BAR();
            STAMP();
        STAMP();
        }
    }
    if (IN(13)) {
        const bf16* H1 = (const bf16*)(ws + WS_H1B); const bf16* Y = (const bf16*)(ws + WS_Y); const int* tokslot = (const int*)(ws + WS_TOKSLOT); const float* tokw = (const float*)(ws + WS_TOKW);
        unsigned poison = __hip_atomic_load(ctl + CW_BAR + XB_TMO, RLX_AGENT) != 0u;
        for (int p = gw; p < NVALID; p += NGW) { const int row = p;
            float z[2][8];
#pragma unroll
            for (int j = 0; j < 2; ++j) { const int c = j * 512 + lane * 8; const v4u a = *(const v4u*)(H1 + (size_t)row * D + c);
                z[j][0] = ALPHA * bfl(a.x); z[j][1] = ALPHA * bfh(a.x); z[j][2] = ALPHA * bfl(a.y); z[j][3] = ALPHA * bfh(a.y); z[j][4] = ALPHA * bfl(a.z); z[j][5] = ALPHA * bfh(a.z); z[j][6] = ALPHA * bfl(a.w); z[j][7] = ALPHA * bfh(a.w); }
#pragma unroll
            for (int k = 0; k <= TOPK; ++k) { const int yr = (k < TOPK) ? tokslot[(size_t)row * 16 + k] : YSHARED + p; const float w = (k < TOPK) ? tokw[(size_t)row * 16 + k] : 1.0f;
#pragma unroll
                for (int j = 0; j < 2; ++j) { const int c = j * 512 + lane * 8; const v4u a = *(const v4u*)(Y + (size_t)yr * D + c);
                    z[j][0] += w * bfl(a.x); z[j][1] += w * bfh(a.x); z[j][2] += w * bfl(a.y); z[j][3] += w * bfh(a.y); z[j][4] += w * bfl(a.z); z[j][5] += w * bfh(a.z); z[j][6] += w * bfl(a.w); z[j][7] += w * bfh(a.w); } }
            float s = 0.f;
#pragma unroll
            for (int j = 0; j < 2; ++j)
#pragma unroll
                for (int q = 0; q < 8; ++q) s += z[j][q];
            const float mean = wave_sum(s) * (1.f / D); float s2 = 0.f;
#pragma unroll
            for (int j = 0; j < 2; ++j)
#pragma unroll
                for (int q = 0; q < 8; ++q) { z[j][q] -= mean; s2 += z[j][q] * z[j][q]; }
            const float rstd = 1.f / sqrtf(wave_sum(s2) * (1.f / D) + LN_EPS);
            float* orow = args.out + (size_t)p * D;
#pragma unroll
            for (int j = 0; j < 2; ++j) { const int c = j * 512 + lane * 8;
#pragma unroll
                for (int q4 = 0; q4 < 2; ++q4) { const f32x4 gg = *(const f32x4*)(args.in[31] + c + 4 * q4), bb = *(const f32x4*)(args.in[32] + c + 4 * q4);
                    f32x4 o; o.x = z[j][4 * q4] * rstd * gg.x + bb.x; o.y = z[j][4 * q4 + 1] * rstd * gg.y + bb.y; o.z = z[j][4 * q4 + 2] * rstd * gg.z + bb.z; o.w = z[j][4 * q4 + 3] * rstd * gg.w + bb.w;
                    if (poison) o = (f32x4){__builtin_nanf(""), __builtin_nanf(""), __builtin_nanf(""), __builtin_nanf("")};
                    *(f32x4*)(orow + c + 4 * q4) = o; } } }
    }
#if MK_DIAG
    GRID_BAR(); STAMP();
    if (blockIdx.x == 0 && tid == 0) { const unsigned long long* ts = (const unsigned long long*)(ctl + CW_DIAG);
      const unsigned long long a0 = __hip_atomic_load(ts + MK_DIAG_S1, RLX_AGENT), a1 = __hip_atomic_load(ts + MK_DIAG_S1 + 1, RLX_AGENT);
      args.out[0] = 40.0f + (float)(a1 - a0) * 0.01f; }
#endif
#undef IN
#undef BOTH
#undef GRID_BAR
}

extern "C" void kernel_launch(void* const* d_in, const int* in_sizes, int n_in, void* d_out, int out_size, void* d_ws, size_t ws_size, hipStream_t stream) {
    static int grid = 0;
    if (grid == 0) {
        if (n_in != 33 || in_sizes[0] != NB * SEQ * D || out_size != NB * SEQ * D || ws_size < WS_END) { fprintf(stderr, "kernel_launch: unexpected shapes / workspace (n_in %d, in0 %d, out %d, ws %zu < %zu); nothing launched\n", n_in, n_in > 0 ? in_sizes[0] : -1, out_size, ws_size, (size_t)WS_END); grid = -1; return; }
        int dev = 0, cus = 0;
        if (hipGetDevice(&dev) != hipSuccess || hipDeviceGetAttribute(&cus, hipDeviceAttributeMultiprocessorCount, dev) != hipSuccess) { grid = -1; return; }
        if (hipFuncSetAttribute((const void*)mega_fwd, hipFuncAttributeMaxDynamicSharedMemorySize, LDS_BYTES) != hipSuccess) { fprintf(stderr, "kernel_launch: hipFuncSetAttribute failed\n"); grid = -1; return; }
        int per_cu = 0;
        if (hipOccupancyMaxActiveBlocksPerMultiprocessor(&per_cu, (const void*)mega_fwd, NWAVES * 64, LDS_BYTES) != hipSuccess || per_cu < 1) fprintf(stderr, "kernel_launch: occupancy query says %d\n", per_cu);
        (void)hipGetLastError();
        grid = cus;
    }
    if (grid < 0) return;
    if (hipMemsetAsync((char*)d_ws + WS_CTL, 0, CTL_ZERO_BYTES, stream) != hipSuccess) return;
    Args a{};
    for (int i = 0; i < 33; ++i) a.in[i] = (const float*)d_in[i];
    a.out = (float*)d_out; a.ws = (unsigned char*)d_ws;
    if (N_LAUNCHES == 1) { a.ph_lo = 0; a.ph_hi = NPHASE; a.li = 0; hipLaunchKernelGGL(mega_fwd, dim3(grid), dim3(NWAVES * 64), LDS_BYTES, stream, a); }
    else for (int li = 0; li < NPHASE; ++li) { a.ph_lo = li; a.ph_hi = li + 1; a.li = li; for (int rep = 0; rep < (((MK_REPEAT_MASK) >> li) & 1) + 1; ++rep) hipLaunchKernelGGL(mega_fwd, dim3(grid), dim3(NWAVES * 64), LDS_BYTES, stream, a); }
}
```

```cpp
#include <hip/hip_runtime.h>
#include <hip/hip_bf16.h>
#include <cstdio>
#include <cstdint>
#include <cmath>
namespace pg8 {
#define PG8_LAS __attribute__((address_space(3)))
typedef unsigned short bf16_t;
typedef short bf16x8 __attribute__((ext_vector_type(8)));
typedef float f32x4 __attribute__((ext_vector_type(4)));
typedef float f32x2 __attribute__((ext_vector_type(2)));
typedef unsigned u32x4 __attribute__((ext_vector_type(4)));
constexpr int BM = 256, BK = 64, HALF = 128, HTB = HALF * BK * 2  , STAGE_BYTES = 8 * HTB;

__host__ __device__ __forceinline__ int lds_byte(int r, int c) { const int st = (r >> 4) * 2 + (c >> 5), rr = r & 15, cc = c & 31, ob = rr * 64 + cc * 2; return st * 1024 + (ob ^ (((ob >> 9) & 1) << 5)); }
__host__ __device__ __forceinline__ void stage_rc(int b, int& R, int& C) { const int st = b / 1024, sb = b % 1024, swz = sb ^ (((sb >> 9) & 1) << 5); R = (st >> 1) * 16 + swz / 64; C = (st & 1) * 32 + (swz % 64) / 2; }
__host__ __device__ __forceinline__ int perm32(int rho) { const int n = rho >> 4, i = rho & 15; return 8 * (i >> 2) + 4 * n + (i & 3); }

struct Unit { int pm, pn, e, mt, nv, aux, ar; };
struct Gemm { const bf16_t* A; const bf16_t* Bt; int K; size_t b_estride; };

__device__ __forceinline__ unsigned cvt_pk_bf16(float lo, float hi) { unsigned r; asm volatile("v_cvt_pk_bf16_f32 %0, %1, %2" : "=v"(r) : "v"(lo), "v"(hi)); return r; }
__device__ __forceinline__ float bf_lo(unsigned w) { return __builtin_bit_cast(float, w << 16); }
__device__ __forceinline__ float bf_hi(unsigned w) { return __builtin_bit_cast(float, w & 0xffff0000u); }
__device__ __forceinline__ float fast_sigmoid(float x) { return __builtin_amdgcn_rcpf(1.0f + __builtin_amdgcn_exp2f(-1.4426950408889634f * x)); }
__device__ __forceinline__ float gelu_tanh(float v) { const float y = 1.5957691216057308f * (v + 0.044715f * v * v * v); return v * fast_sigmoid(y); }

template <class Epi, class Sched, bool ALIGN_EPI, bool GATHER>
__device__ __forceinline__ void gemm_phase(PG8_LAS unsigned char* lds, const Gemm g, const Sched& S, const Epi& E) {
    const int tid = threadIdx.x, wid = __builtin_amdgcn_readfirstlane(tid >> 6), lane = tid & 63, wr = wid >> 2, wc = wid & 3, fr = lane & 15, fq = lane >> 4;
    const int K = g.K, nt = K / BK;
    unsigned voffA[2], voffB[2]; int RA[2]; unsigned CA2[2];
#pragma unroll
    for (int i = 0; i < 2; ++i) { int R, C; stage_rc(tid * 16 + i * 8192, R, C); const int Rb = Epi::PERM ? ((R & ~31) + perm32(R & 31)) : R;
        voffA[i] = (unsigned)(R * K + C) * 2u; voffB[i] = (unsigned)(Rb * K + C) * 2u; RA[i] = R; CA2[i] = (unsigned)C * 2u; }
    const size_t kstep = (size_t)(BK * 2);
    const size_t hstep = (size_t)HALF * K * 2;
    const size_t tstep = 2 * hstep;
    const unsigned ldsw = (unsigned)wid * 1024u;
    const int aoff = lds_byte(wr * 64 + fr, fq * 8), boff = lds_byte(wc * 32 + fr, fq * 8);
#define PG8_SA(b, h) (((b) * 2 + (h)) * HTB)
#define PG8_SB(b, h) ((4 + (b) * 2 + (h)) * HTB)
#define PG8_STAGE2(bufoff, gbase, v0, v1) do { \
        __builtin_amdgcn_global_load_lds((const unsigned*)((const char*)(gbase) + (v0)), (PG8_LAS unsigned*)(lds + (bufoff) + ldsw), 16, 0, 0); \
        __builtin_amdgcn_global_load_lds((const unsigned*)((const char*)(gbase) + (v1)), (PG8_LAS unsigned*)(lds + (bufoff) + ldsw + 8192), 16, 0, 0); } while (0)
#define PG8_STAGEB(bufoff, gbase) PG8_STAGE2(bufoff, gbase, voffB[0], voffB[1])
#define PG8_LDA(dst, b, h) do { _Pragma("unroll") for (int m = 0; m < 4; ++m) _Pragma("unroll") for (int k = 0; k < 2; ++k) dst[m][k] = *(const PG8_LAS bf16x8*)(lds + PG8_SA(b, h) + aoff + m * 2048 + k * 1024); } while (0)
#define PG8_LDB(dst, b, h) do { _Pragma("unroll") for (int n = 0; n < 2; ++n) _Pragma("unroll") for (int k = 0; k < 2; ++k) dst[n][k] = *(const PG8_LAS bf16x8*)(lds + PG8_SB(b, h) + boff + n * 2048 + k * 1024); } while (0)
#define PG8_MMA(ai, bj, At, Bt) do { __builtin_amdgcn_s_setprio(1); _Pragma("unroll") for (int m = 0; m < 4; ++m) _Pragma("unroll") for (int n = 0; n < 2; ++n) _Pragma("unroll") for (int k = 0; k < 2; ++k) \
        acc[ai][bj][m][n] = __builtin_amdgcn_mfma_f32_16x16x32_bf16(Bt[n][k], At[m][k], acc[ai][bj][m][n], 0, 0, 0); __builtin_amdgcn_s_setprio(0); } while (0)
#define PG8_WAIT_V(n) asm volatile("s_waitcnt vmcnt(" #n ")" ::: "memory")
#define PG8_WAIT_L(n) asm volatile("s_waitcnt lgkmcnt(" #n ")" ::: "memory")
#define PG8_BAR __builtin_amdgcn_s_barrier()
#define PG8_SCHED __builtin_amdgcn_sched_barrier(0)
    Unit cur, nxt; int ui = 0;
    if (!S.next(0, cur)) return;
    f32x4 acc[2][2][4][2];
#pragma unroll
    for (int a = 0; a < 2; ++a)
#pragma unroll
        for (int b = 0; b < 2; ++b)
#pragma unroll
            for (int m = 0; m < 4; ++m)
#pragma unroll
                for (int n = 0; n < 2; ++n) acc[a][b][m][n] = (f32x4){0.f, 0.f, 0.f, 0.f};
    bf16x8 At[4][2], B0[2][2], B1[2][2];
    const char* const gA = (const char*)g.A;
    unsigned roC[2][2], roN[2][2];
    const char* cA; const char* cB = (const char*)g.Bt + ((size_t)cur.e * g.b_estride) * 2 + (size_t)cur.pn * tstep;
    if constexpr (GATHER) {
#pragma unroll
        for (int h = 0; h < 2; ++h)
#pragma unroll
            for (int i = 0; i < 2; ++i) roC[h][i] = (unsigned)S.row_of(cur, h * HALF + RA[i]) * (unsigned)(K * 2) + CA2[i];
        cA = gA;
    } else {
#pragma unroll
        for (int h = 0; h < 2; ++h)
#pragma unroll
            for (int i = 0; i < 2; ++i) roC[h][i] = voffA[i] + (unsigned)(h * hstep);
        cA = gA + (size_t)cur.ar * (size_t)(K * 2);
    }
    S.a_ready(cur);
    PG8_STAGEB(PG8_SB(0, 0), cB); PG8_STAGEB(PG8_SB(0, 1), cB + hstep); PG8_STAGE2(PG8_SA(0, 0), cA, roC[0][0], roC[0][1]); PG8_STAGE2(PG8_SA(0, 1), cA, roC[1][0], roC[1][1]);
    if (wr == 1) PG8_BAR;
    PG8_WAIT_V(2); PG8_BAR;
    PG8_STAGEB(PG8_SB(1, 0), cB + kstep); PG8_STAGE2(PG8_SA(1, 0), cA + kstep, roC[0][0], roC[0][1]); PG8_STAGEB(PG8_SB(1, 1), cB + hstep + kstep);
    PG8_WAIT_V(6); PG8_BAR;
    for (;;) {
        const bool has_next = S.next(ui + 1, nxt);
        const char* nA; const char* nB = has_next ? (const char*)g.Bt + ((size_t)nxt.e * g.b_estride) * 2 + (size_t)nxt.pn * tstep : cB;
        if constexpr (GATHER) {
            nA = gA;
            if (has_next) {
#pragma unroll
                for (int h = 0; h < 2; ++h)
#pragma unroll
                    for (int i = 0; i < 2; ++i) roN[h][i] = (unsigned)S.row_of(nxt, h * HALF + RA[i]) * (unsigned)(K * 2) + CA2[i];
            } else {
#pragma unroll
                for (int h = 0; h < 2; ++h)
#pragma unroll
                    for (int i = 0; i < 2; ++i) roN[h][i] = roC[h][i];
            }
        } else {
            nA = has_next ? gA + (size_t)nxt.ar * (size_t)(K * 2) : cA;
        }
#pragma clang loop unroll(disable)
        for (int t = 0; t < nt; t += 2) {
            const bool last = (t == nt - 2);
            const char* a1 = cA + (size_t)(t + 1) * kstep;
            const char* a2 = last ? nA : cA + (size_t)(t + 2) * kstep; const char* b2 = last ? nB : cB + (size_t)(t + 2) * kstep;
            const char* a3 = a2 + kstep; const char* b3 = b2 + kstep;
            unsigned s00, s01, s10, s11;
            if constexpr (GATHER) { s00 = last ? roN[0][0] : roC[0][0]; s01 = last ? roN[0][1] : roC[0][1]; s10 = last ? roN[1][0] : roC[1][0]; s11 = last ? roN[1][1] : roC[1][1]; }
            else { s00 = roC[0][0]; s01 = roC[0][1]; s10 = roC[1][0]; s11 = roC[1][1]; }
            if (last && has_next) S.a_ready(nxt);
            PG8_LDB(B0, 0, 0); PG8_LDB(B1, 0, 1); PG8_SCHED; PG8_LDA(At, 0, 0); PG8_STAGE2(PG8_SA(1, 1), a1, roC[1][0], roC[1][1]);
            PG8_WAIT_V(8); PG8_WAIT_L(0); PG8_BAR; PG8_MMA(0, 0, At, B0); PG8_MMA(0, 1, At, B1); PG8_BAR; PG8_SCHED;
            PG8_LDA(At, 0, 1); PG8_STAGEB(PG8_SB(0, 0), b2); PG8_STAGEB(PG8_SB(0, 1), b2 + hstep); PG8_STAGE2(PG8_SA(0, 0), a2, s00, s01);
            PG8_WAIT_V(8); PG8_WAIT_L(0); PG8_BAR; PG8_MMA(1, 0, At, B0); PG8_MMA(1, 1, At, B1); PG8_BAR; PG8_SCHED;
            PG8_LDB(B0, 1, 0); PG8_LDB(B1, 1, 1); PG8_SCHED; PG8_LDA(At, 1, 0); PG8_STAGE2(PG8_SA(0, 1), a2, s10, s11);
            PG8_WAIT_V(8); PG8_WAIT_L(0); PG8_BAR; PG8_MMA(0, 0, At, B0); PG8_MMA(0, 1, At, B1); PG8_BAR; PG8_SCHED;
            PG8_LDA(At, 1, 1); PG8_STAGEB(PG8_SB(1, 0), b3); PG8_STAGEB(PG8_SB(1, 1), b3 + hstep); PG8_STAGE2(PG8_SA(1, 0), a3, s00, s01);
            PG8_WAIT_V(8); PG8_WAIT_L(0); PG8_BAR; PG8_MMA(1, 0, At, B0); PG8_MMA(1, 1, At, B1); PG8_BAR; PG8_SCHED;
        }
        if constexpr (ALIGN_EPI) { if (wr == 0) PG8_BAR; }
        E(acc, cur, wr, wc, fr, fq); S.done(cur);
        if (!has_next) break;
#pragma unroll
        for (int a = 0; a < 2; ++a)
#pragma unroll
            for (int b = 0; b < 2; ++b)
#pragma unroll
                for (int m = 0; m < 4; ++m)
#pragma unroll
                    for (int n = 0; n < 2; ++n) acc[a][b][m][n] = (f32x4){0.f, 0.f, 0.f, 0.f};
        cur = nxt; cA = nA; cB = nB; ++ui;
        if constexpr (GATHER) {
#pragma unroll
            for (int h = 0; h < 2; ++h)
#pragma unroll
                for (int i = 0; i < 2; ++i) roC[h][i] = roN[h][i];
        }
        if constexpr (ALIGN_EPI) { if (wr == 1) PG8_BAR; }
    }
    PG8_WAIT_V(0);
    if constexpr (!ALIGN_EPI) { if (wr == 0) PG8_BAR; }
    PG8_BAR;
#undef PG8_SA
#undef PG8_SB
#undef PG8_STAGE2
#undef PG8_STAGEB
#undef PG8_LDA
#undef PG8_LDB
#undef PG8_MMA
#undef PG8_WAIT_V
#undef PG8_WAIT_L
#undef PG8_BAR
#undef PG8_SCHED
}
}
namespace attn2 {
using bf16=__hip_bfloat16;
using bf16x8=__attribute__((ext_vector_type(8)))short;
using s16x4=__attribute__((ext_vector_type(4)))short;
using f32x16=__attribute__((ext_vector_type(16)))float;
using u32x4=__attribute__((ext_vector_type(4)))unsigned;
constexpr int BATCH=8,NHEAD=16,SEQ=4352,D=64,DM=NHEAD*D;
constexpr int NW=8,QBLK=32,QB=QBLK*NW,KVBLK=64,NQB=SEQ/QB;
constexpr int ATTN_PITCH=DM, ATTN_UNIT_ROWS=QB;
__device__ __forceinline__ int crow(int r,int hi){return (r&3)+8*(r>>2)+4*hi;}
#define SBAR() __builtin_amdgcn_sched_barrier(0)
__device__ __forceinline__ void cmask(f32x16&p0,f32x16&p1,int jb,int qrel,int hi){
  const float NEG=-INFINITY; int kb=64*jb+4*hi;
  #pragma unroll
  for(int r=0;r<16;++r){int kv=kb+(r&3)+8*(r>>2); if(kv>qrel)p0[r]=NEG; if(kv+32>qrel)p1[r]=NEG;}
}

constexpr int NSLOT=3, SLOTB=8192, QPW=4608;
constexpr int LDS_K=0, LDS_V=NSLOT*SLOTB, LDS_WS=3*NSLOT*SLOTB, LDS_QP=LDS_WS+NW*64*4, LDS_BYTES=LDS_QP+NW*QPW;
constexpr float C2=0.125f*1.4426950408889634f;
__device__ __forceinline__ void glds16(const void*gsrc,unsigned lds_dst){unsigned keep;
  asm volatile("s_mov_b32 %0, m0\n\ts_mov_b32 m0, %2\n\ts_nop 0\n\tglobal_load_lds_dwordx4 %1, off\n\ts_mov_b32 m0, %0":"=&s"(keep):"v"(gsrc),"s"(lds_dst):"memory");}
__device__ __forceinline__ float max3f(float a,float b,float c){float r;asm("v_max3_f32 %0, %1, %2, %3":"=v"(r):"v"(a),"v"(b),"v"(c));return r;}
__device__ __forceinline__ float max2f(float a,float b){float r;asm("v_max_f32_e32 %0, %1, %2":"=v"(r):"v"(a),"v"(b));return r;}
__device__ __forceinline__ float fadd_s(float a,float b){float r;asm("v_add_f32_e32 %0, %1, %2":"=v"(r):"v"(a),"v"(b));return r;}
__device__ __forceinline__ float fsub_s(float a,float b){float r;asm("v_sub_f32_e32 %0, %1, %2":"=v"(r):"v"(a),"v"(b));return r;}
typedef float f32x2_t __attribute__((ext_vector_type(2))); typedef __bf16 bf16x2_t __attribute__((ext_vector_type(2)));
__device__ __forceinline__ unsigned cvtpk_s(float lo,float hi){f32x2_t v={lo,hi};bf16x2_t b=__builtin_convertvector(v,bf16x2_t);return __builtin_bit_cast(unsigned,b);}
#define WAIT_BAR(N) asm volatile("s_waitcnt vmcnt(" #N ") lgkmcnt(0)\n\ts_barrier":::"memory")

__device__ __forceinline__ void qkt(f32x16&p0,f32x16&p1,const char*Kslot,const bf16x8*qr,int r32,int hi){ const f32x16 negm=f32x16{};
  const char*kb=Kslot+hi*1024+r32*16;
  #pragma unroll
  for(int d0=0;d0<4;++d0){
    const bf16x8 b0=*reinterpret_cast<const bf16x8*>(kb+d0*2048);
    const bf16x8 b1=*reinterpret_cast<const bf16x8*>(kb+d0*2048+512);
    if(d0==0){p0=__builtin_amdgcn_mfma_f32_32x32x16_bf16(b0,qr[0],negm,0,0,0);p1=__builtin_amdgcn_mfma_f32_32x32x16_bf16(b1,qr[0],negm,0,0,0);}
    else{p0=__builtin_amdgcn_mfma_f32_32x32x16_bf16(b0,qr[d0],p0,0,0,0);p1=__builtin_amdgcn_mfma_f32_32x32x16_bf16(b1,qr[d0],p1,0,0,0);}}
}
typedef __attribute__((address_space(3))) const char* lds_cptr;
typedef short v4i16_t __attribute__((ext_vector_type(4)));
__device__ __forceinline__ void kload8(bf16x8*kf,lds_cptr kp){
  kf[0]=*(const __attribute__((address_space(3))) bf16x8*)(kp);      kf[1]=*(const __attribute__((address_space(3))) bf16x8*)(kp+512);
  kf[2]=*(const __attribute__((address_space(3))) bf16x8*)(kp+2048); kf[3]=*(const __attribute__((address_space(3))) bf16x8*)(kp+2560);
  kf[4]=*(const __attribute__((address_space(3))) bf16x8*)(kp+4096); kf[5]=*(const __attribute__((address_space(3))) bf16x8*)(kp+4608);
  kf[6]=*(const __attribute__((address_space(3))) bf16x8*)(kp+6144); kf[7]=*(const __attribute__((address_space(3))) bf16x8*)(kp+6656);
}
__device__ __forceinline__ void kload2(bf16x8*kf,lds_cptr kp,int j){ kf[2*j]=*(const __attribute__((address_space(3))) bf16x8*)(kp+j*2048); kf[2*j+1]=*(const __attribute__((address_space(3))) bf16x8*)(kp+j*2048+512); }
__device__ __forceinline__ s16x4 vtr(lds_cptr p){ return __builtin_bit_cast(s16x4,__builtin_amdgcn_ds_read_tr16_b64_v4i16((__attribute__((address_space(3))) v4i16_t*)p)); }
__device__ __forceinline__ float rowmax(const f32x16&p0,const f32x16&p1){
  float a=max3f(p0[0],p0[1],p1[0]),b=max3f(p0[2],p0[3],p1[1]);a=max3f(a,p1[2],p1[3]);
  #pragma unroll
  for(int r=4;r<16;r+=4){a=max3f(a,p0[r],p0[r+1]);b=max3f(b,p0[r+2],p0[r+3]);a=max3f(a,p1[r],p1[r+1]);b=max3f(b,p1[r+2],p1[r+3]);}
  const float m=max2f(a,b);
  auto rr=__builtin_amdgcn_permlane32_swap(__float_as_uint(m),__float_as_uint(m),false,false);
  return max2f(__uint_as_float(rr[0]),__uint_as_float(rr[1]));
}
__device__ __forceinline__ void pv(f32x16*o,int vb,bf16x8 pa0,bf16x8 pa1,bf16x8 pa2,bf16x8 pa3){
  #pragma unroll
  for(int d0=0;d0<4;++d0){s16x4 lo[4],hi[4];
    #pragma unroll
    for(int ks=0;ks<4;++ks){
      asm volatile("ds_read_b64_tr_b16 %0,%1 offset:%c2":"=&v"(lo[ks]):"v"(vb),"i"(d0*4096+ks*1024):"memory");
      asm volatile("ds_read_b64_tr_b16 %0,%1 offset:%c2":"=&v"(hi[ks]):"v"(vb),"i"(d0*4096+ks*1024+512):"memory");}
    asm volatile("s_waitcnt lgkmcnt(0)":::"memory");SBAR();
    #define PK(k) (bf16x8){lo[k][0],lo[k][1],lo[k][2],lo[k][3],hi[k][0],hi[k][1],hi[k][2],hi[k][3]}
    o[d0]=__builtin_amdgcn_mfma_f32_32x32x16_bf16(pa0,PK(0),o[d0],0,0,0);
    o[d0]=__builtin_amdgcn_mfma_f32_32x32x16_bf16(pa1,PK(1),o[d0],0,0,0);
    o[d0]=__builtin_amdgcn_mfma_f32_32x32x16_bf16(pa2,PK(2),o[d0],0,0,0);
    o[d0]=__builtin_amdgcn_mfma_f32_32x32x16_bf16(pa3,PK(3),o[d0],0,0,0);
    #undef PK
  }
}

#ifndef ATTN_STORE16
#define ATTN_STORE16(p,v) (*(u32x4*)(p)=(v))
#endif
template<int THRL> __device__ __forceinline__ void attn_unit(int b,int h,int hv,int qb,const bf16*Q,const bf16*__restrict__ K,const bf16*__restrict__ V,bf16*O,char*shm){
  const int tid=threadIdx.x,lane=tid&63,r32=lane&31,hi=lane>>5; const int wid=__builtin_amdgcn_readfirstlane(tid>>6);
  const long rowbase=(long)b*SEQ; const int q0=qb*QB;
  const bf16*Qw=Q+(rowbase+q0+wid*QBLK)*DM+h*D;
  const bf16*Kh=K+rowbase*DM+h*D,*Vh=V+rowbase*DM+hv*128;
  const unsigned lds0=(unsigned)(uintptr_t)shm;
  float*wsf=(float*)(shm+LDS_WS)+wid*64;
  const bf16*ksrc=Kh+(long)lane*DM+wid*8;
  const bf16*vsrc=Vh+(long)(16*(wid&3)+(lane>>2))*DM+(wid>>2)*32+(lane&3)*8;
  const unsigned kdst=lds0+LDS_K+wid*1024, vdst=lds0+LDS_V+wid*1024;
  #define DMA_K(t,slot) glds16(ksrc+(long)(t)*KVBLK*DM,(unsigned)__builtin_amdgcn_readfirstlane(kdst+(slot)))
  #define DMA_V(t,slot) do{ glds16(vsrc+(long)(t)*KVBLK*DM,(unsigned)__builtin_amdgcn_readfirstlane(vdst+2*(slot))); glds16(vsrc+64+(long)(t)*KVBLK*DM,(unsigned)__builtin_amdgcn_readfirstlane(vdst+2*(slot)+8192)); }while(0)
  const int vb0=(int)(lds0+LDS_V)+((lane>>4)&1)*32+(lane&3)*8+(4*hi+((lane&15)>>2))*64;
  const char*Kbase=shm+LDS_K; bf16x8 kf[8];
  const lds_cptr shm3=(lds_cptr)shm; const lds_cptr kp0=shm3+LDS_K+hi*1024+r32*16; const lds_cptr vp0=shm3+LDS_V+((lane>>4)&1)*32+(lane&3)*8+(4*hi+((lane&15)>>2))*64;
  const int NT=(q0+QB)/KVBLK;
  DMA_K(0,0);DMA_V(0,0);DMA_K(1,SLOTB);
  typedef __attribute__((address_space(3))) bf16x8* lds_q8; const lds_q8 qpl=(lds_q8)((__attribute__((address_space(3))) char*)shm3+LDS_QP+wid*QPW+r32*144+hi*16);
  { bf16x8 qr[4];
  #pragma unroll
  for(int d0=0;d0<4;++d0)qr[d0]=*reinterpret_cast<const bf16x8*>(&Qw[(long)r32*DM+d0*16+hi*8]);
  #pragma unroll
  for(int d0=0;d0<4;++d0)qpl[2*d0]=qr[d0]; }
  float mhat=0.f,l_reg=0.f;f32x16 o[4];o[0]=f32x16{};o[1]=f32x16{};o[2]=f32x16{};o[3]=f32x16{};
  const int qrel=wid*QBLK+r32;
  #define CMASK(P0,P1,t) do{int jb_=(t)-(NT-4); if(jb_>=0)cmask(P0,P1,jb_,qrel,hi);}while(0)
  bool resc=false;
  #define START(P0,P1) do{ const float rm=rowmax(P0,P1); resc=false; mhat=rm; \
    _Pragma("unroll") for(int r=0;r<16;++r)P0[r]=__builtin_amdgcn_exp2f(P0[r]-mhat); }while(0)
  #define RESC() do{ if(resc){ asm volatile("s_waitcnt lgkmcnt(0)":::"memory"); \
      _Pragma("unroll") for(int d_=0;d_<4;++d_) _Pragma("unroll") for(int r=0;r<16;++r)o[d_][r]*=wsf[crow(r,hi)]; } }while(0)
  f32x16 pA0,pA1,pB0,pB1;
  int sl_prev=0,sl_cur=0,sl_next=SLOTB;
  #define ROT() do{sl_prev=sl_cur;sl_cur=sl_next;sl_next=(sl_next==(NSLOT-1)*SLOTB)?0:sl_next+SLOTB;}while(0)
  DMA_K(2,2*SLOTB);
  WAIT_BAR(4);
  { bf16x8 qf[4]; _Pragma("unroll") for(int d0=0;d0<4;++d0)qf[d0]=qpl[2*d0]; qkt(pA0,pA1,Kbase,qf,r32,hi); } asm volatile("s_nop 15\n\ts_nop 7":"+v"(pA0),"+v"(pA1));CMASK(pA0,pA1,0);
  START(pA0,pA1);
  _Pragma("unroll") for(int r=0;r<16;++r)pA1[r]=__builtin_amdgcn_exp2f(pA1[r]-mhat);
  WAIT_BAR(0);
  DMA_K(3,0);DMA_V(1,SLOTB);
  ROT();
  kload8(kf,kp0+sl_cur);
  WAIT_BAR(3);
  s16x4 vlo[8],vhi[8],wlo[8],whi[8]; u32x4 pw0,pw1,pw2,pw3; const f32x16 zero16=f32x16{};
  #define PKW(P,B) cvtpk_s(P[B],P[B+1])
  #define PAF(k) __builtin_bit_cast(bf16x8,pw##k)
  #define VFR(i) (bf16x8){vlo[i][0],vlo[i][1],vlo[i][2],vlo[i][3],vhi[i][0],vhi[i][1],vhi[i][2],vhi[i][3]}
  #define PIN(x) asm volatile("":"+v"(x))
  #define MX3(a,b,c) __builtin_fmaxf(__builtin_fmaxf((a),(b)),(c))
  #define GAPA(MF,A0,A1,A2,A3,W0,W1,PW) do{ MF; sacc+=A0; sacc+=A1; sacc+=A2; sacc+=A3; PIN(sacc); W0; W1; PIN(PW); SBAR(); }while(0)
  #define EX(v) __builtin_amdgcn_exp2f(v)
  #define EXM(v) __builtin_amdgcn_exp2f((v)-mhat)
  #define GAPB2(MF,X,B) do{ MF; X[B]=EXM(X[B]); X[B+1]=EXM(X[B+1]); PIN(X); SBAR(); }while(0)
  #define VRD2(i) do{ wlo[i]=vtr(vp_+((((i)>>2)+2)*4096+((i)&3)*1024)); whi[i]=vtr(vp_+((((i)>>2)+2)*4096+((i)&3)*1024+512)); }while(0)
  #define WFR(i) (bf16x8){wlo[i][0],wlo[i][1],wlo[i][2],wlo[i][3],whi[i][0],whi[i][1],whi[i][2],whi[i][3]}
  #define VRD(i) do{ vlo[i]=vtr(vp_+(((i)>>2)*4096+((i)&3)*1024)); vhi[i]=vtr(vp_+(((i)>>2)*4096+((i)&3)*1024+512)); }while(0)
  #define KRD(G,j) do{ if(G){ kload2(kf,kp0+sl_next,j); SBAR(); } }while(0)
  #define STEP(C0,C1,P0,P1,t,GK,GV,GL) do{ SBAR(); \
    const lds_cptr vp_=vp0+2*sl_prev; const bf16x8 qf0=qpl[0],qf1=qpl[2],qf2=qpl[4],qf3=qpl[6]; \
    VRD(0); SBAR(); float sacc=(P0[0]+P0[1]); \
    GAPA(C0=__builtin_amdgcn_mfma_f32_32x32x16_bf16(kf[0],qf0,zero16,0,0,0), P0[2],P0[3],P0[4],P0[5],     pw0[0]=PKW(P0,0), pw0[1]=PKW(P0,2), pw0); \
    VRD(4); SBAR(); GAPA(C1=__builtin_amdgcn_mfma_f32_32x32x16_bf16(kf[1],qf0,zero16,0,0,0), P0[6],P0[7],P0[8],P0[9],     pw0[2]=PKW(P0,4), pw0[3]=PKW(P0,6), pw0); \
    VRD(1); SBAR(); GAPA(C0=__builtin_amdgcn_mfma_f32_32x32x16_bf16(kf[2],qf1,C0,0,0,0),   P0[10],P0[11],P0[12],P0[13], pw1[0]=PKW(P0,8), pw1[1]=PKW(P0,10), pw1); \
    VRD(5); SBAR(); GAPA(C1=__builtin_amdgcn_mfma_f32_32x32x16_bf16(kf[3],qf1,C1,0,0,0),   P0[14],P0[15],P1[0],P1[1],   pw1[2]=PKW(P0,12),pw1[3]=PKW(P0,14), pw1); \
    VRD(2); SBAR(); GAPA(C0=__builtin_amdgcn_mfma_f32_32x32x16_bf16(kf[4],qf2,C0,0,0,0),   P1[2],P1[3],P1[4],P1[5],     pw2[0]=PKW(P1,0), pw2[1]=PKW(P1,2), pw2); \
    VRD(6); SBAR(); GAPA(C1=__builtin_amdgcn_mfma_f32_32x32x16_bf16(kf[5],qf2,C1,0,0,0),   P1[6],P1[7],P1[8],P1[9],     pw2[2]=PKW(P1,4), pw2[3]=PKW(P1,6), pw2); \
    VRD(3); SBAR(); GAPA(C0=__builtin_amdgcn_mfma_f32_32x32x16_bf16(kf[6],qf3,C0,0,0,0),   P1[10],P1[11],P1[12],P1[13], pw3[0]=PKW(P1,8), pw3[1]=PKW(P1,10), pw3); \
    VRD(7); SBAR(); GAPA(C1=__builtin_amdgcn_mfma_f32_32x32x16_bf16(kf[7],qf3,C1,0,0,0),   P1[14],P1[15],0.f,0.f,       pw3[2]=PKW(P1,12),pw3[3]=PKW(P1,14), pw3); \
    l_reg+=sacc; \
    if(GK){DMA_K((t)+3,sl_cur);} if(GV){DMA_V((t)+1,sl_next);} \
    CMASK(C0,C1,t); \
    { float a=MX3(C0[0],C0[1],C1[0]),b=MX3(C0[2],C0[3],C1[1]); a=MX3(a,C1[2],C1[3]); \
      _Pragma("unroll") for(int r=4;r<16;r+=4){a=MX3(a,C0[r],C0[r+1]);b=MX3(b,C0[r+2],C0[r+3]);a=MX3(a,C1[r],C1[r+1]);b=MX3(b,C1[r+2],C1[r+3]);} \
      float rm=__builtin_fmaxf(a,b); { auto rr=__builtin_amdgcn_permlane32_swap(__float_as_uint(rm),__float_as_uint(rm),false,false); rm=__builtin_fmaxf(__uint_as_float(rr[0]),__uint_as_float(rr[1])); } \
      rm-=mhat; resc=false; \
      if(__builtin_expect(__any(rm>(float)THRL),0)){ const float dl=__builtin_fmaxf(rm,0.f); mhat+=dl; \
        const float f=__builtin_amdgcn_exp2f(-dl); l_reg*=f; if(hi==0)wsf[r32]=f; resc=true; } } \
    SBAR(); \
    VRD2(0); SBAR(); GAPB2(o[0]=__builtin_amdgcn_mfma_f32_32x32x16_bf16(PAF(0),VFR(0),o[0],0,0,0), C0,0); \
    VRD2(4); SBAR(); GAPB2(o[1]=__builtin_amdgcn_mfma_f32_32x32x16_bf16(PAF(0),VFR(4),o[1],0,0,0), C0,2); \
    KRD(GL,0); VRD2(1); SBAR(); GAPB2(o[0]=__builtin_amdgcn_mfma_f32_32x32x16_bf16(PAF(1),VFR(1),o[0],0,0,0), C0,4); \
    KRD(GL,1); VRD2(5); SBAR(); GAPB2(o[1]=__builtin_amdgcn_mfma_f32_32x32x16_bf16(PAF(1),VFR(5),o[1],0,0,0), C0,6); \
    KRD(GL,2); VRD2(2); SBAR(); GAPB2(o[0]=__builtin_amdgcn_mfma_f32_32x32x16_bf16(PAF(2),VFR(2),o[0],0,0,0), C0,8); \
    KRD(GL,3); VRD2(6); SBAR(); GAPB2(o[1]=__builtin_amdgcn_mfma_f32_32x32x16_bf16(PAF(2),VFR(6),o[1],0,0,0), C0,10); \
    VRD2(3); SBAR(); GAPB2(o[0]=__builtin_amdgcn_mfma_f32_32x32x16_bf16(PAF(3),VFR(3),o[0],0,0,0), C0,12); \
    VRD2(7); SBAR(); GAPB2(o[1]=__builtin_amdgcn_mfma_f32_32x32x16_bf16(PAF(3),VFR(7),o[1],0,0,0), C0,14); \
    GAPB2(o[2]=__builtin_amdgcn_mfma_f32_32x32x16_bf16(PAF(0),WFR(0),o[2],0,0,0), C1,0); \
    GAPB2(o[3]=__builtin_amdgcn_mfma_f32_32x32x16_bf16(PAF(0),WFR(4),o[3],0,0,0), C1,2); \
    GAPB2(o[2]=__builtin_amdgcn_mfma_f32_32x32x16_bf16(PAF(1),WFR(1),o[2],0,0,0), C1,4); \
    GAPB2(o[3]=__builtin_amdgcn_mfma_f32_32x32x16_bf16(PAF(1),WFR(5),o[3],0,0,0), C1,6); \
    GAPB2(o[2]=__builtin_amdgcn_mfma_f32_32x32x16_bf16(PAF(2),WFR(2),o[2],0,0,0), C1,8); \
    GAPB2(o[3]=__builtin_amdgcn_mfma_f32_32x32x16_bf16(PAF(2),WFR(6),o[3],0,0,0), C1,10); \
    GAPB2(o[2]=__builtin_amdgcn_mfma_f32_32x32x16_bf16(PAF(3),WFR(3),o[2],0,0,0), C1,12); \
    GAPB2(o[3]=__builtin_amdgcn_mfma_f32_32x32x16_bf16(PAF(3),WFR(7),o[3],0,0,0), C1,14); \
    }while(0)
  int t=1;
  #undef CMASK
  #define CMASK(P0,P1,t) do{}while(0)
  for(;t+5<NT;t+=2){
    STEP(pB0,pB1,pA0,pA1,t,true,true,true);     WAIT_BAR(3); RESC(); ROT();
    STEP(pA0,pA1,pB0,pB1,t+1,true,true,true);   WAIT_BAR(3); RESC(); ROT();
  }
  #undef CMASK
  #define CMASK(P0,P1,t) do{int jb_=(t)-(NT-4); if(jb_>=0)cmask(P0,P1,jb_,qrel,hi);}while(0)
  #define ENDW(tt) do{ if((tt)+3<NT){WAIT_BAR(3);} else if((tt)+2<NT){WAIT_BAR(2);} else {WAIT_BAR(0);} }while(0)
  for(;t+1<NT;t+=2){
    STEP(pB0,pB1,pA0,pA1,t,(t+3<NT),(t+1<NT),(t+1<NT));       ENDW(t);   RESC(); ROT();
    STEP(pA0,pA1,pB0,pB1,t+1,(t+4<NT),(t+2<NT),(t+2<NT));     ENDW(t+1); RESC(); ROT();
  }
  STEP(pB0,pB1,pA0,pA1,NT-1,false,false,false); RESC();
  { float sacc=pB0[0]+pB0[1]; _Pragma("unroll") for(int r=2;r<16;++r)sacc+=pB0[r]; _Pragma("unroll") for(int r=0;r<16;++r)sacc+=pB1[r]; l_reg+=sacc;
    pw0=(u32x4){PKW(pB0,0),PKW(pB0,2),PKW(pB0,4),PKW(pB0,6)};pw1=(u32x4){PKW(pB0,8),PKW(pB0,10),PKW(pB0,12),PKW(pB0,14)};pw2=(u32x4){PKW(pB1,0),PKW(pB1,2),PKW(pB1,4),PKW(pB1,6)};pw3=(u32x4){PKW(pB1,8),PKW(pB1,10),PKW(pB1,12),PKW(pB1,14)};
    SBAR(); pv(o,vb0+2*sl_cur,PAF(0),PAF(1),PAF(2),PAF(3)); }
  #undef PKW
  #undef PAF
  #undef VFR
  #undef PIN
  #undef MX3
  #undef GAPA
  #undef GAPB2
  #undef EXM
  #undef VRD2
  #undef WFR
  #undef EX
  #undef VRD
  #undef KRD
  #undef STEP
  #undef ENDW
  {auto rr=__builtin_amdgcn_permlane32_swap(__float_as_uint(l_reg),__float_as_uint(l_reg),false,false);l_reg=__uint_as_float(rr[0])+__uint_as_float(rr[1]);}
  if(hi==0)wsf[32+r32]=l_reg;asm volatile("s_waitcnt lgkmcnt(0)":::"memory");
  float rli[16];
  #pragma unroll
  for(int r=0;r<16;++r)rli[r]=__builtin_amdgcn_rcpf(wsf[32+crow(r,hi)]);
  bf16*Ow=O+(rowbase+q0+wid*QBLK)*DM+hv*128;
  asm volatile("s_waitcnt lgkmcnt(0)\n\ts_barrier":::"memory");
  { bf16*stg=(bf16*)(shm)+wid*4096;
    int r32e=(int)(threadIdx.x&31u); asm volatile("":"+v"(r32e));
    #pragma unroll
    for(int r=0;r<16;++r){const int orow=crow(r,hi);
      #pragma unroll
      for(int d0=0;d0<4;++d0)stg[orow*128+d0*32+r32e]=__float2bfloat16(o[d0][r]*rli[r]);}
    asm volatile("s_waitcnt lgkmcnt(0)":::"memory");
    #pragma unroll
    for(int i=0;i<8;++i){const int row=i*4+(lane>>4),ch=lane&15; const u32x4 v=*(const u32x4*)(stg+row*128+ch*8); ATTN_STORE16(Ow+(long)row*DM+ch*8,v);} }
  asm volatile("s_waitcnt lgkmcnt(0)\n\ts_barrier":::"memory");
  #undef DMA_K
  #undef DMA_V
  #undef CMASK
  #undef START
  #undef RESC
  #undef ROT
}
constexpr int ATTN_LDS_BYTES=LDS_BYTES;
struct AttnTensors { const bf16* Q; const bf16* K; const bf16* V; bf16* O; };
struct AttnUnit { int b; int hq; int hv; int qb; };
struct SplitOrder {
  int b, hq, hv, part;
  __device__ __forceinline__ bool next(int i,AttnUnit&u)const{ if(i>=9-part)return false; u.b=b; u.hq=hq; u.hv=hv; u.qb=16-2*i-((i&1)^part); return true; }
};
template<class Sched,int THRL=8> __device__ __forceinline__ void attn_phase(char*lds,const AttnTensors&T,const Sched&S){
  AttnUnit u;
  for(int i=0;S.next(i,u);++i){ attn_unit<THRL>(u.b,u.hq,u.hv,u.qb,T.Q,T.K,T.V,T.O,lds); }
}
#undef SBAR
#undef WAIT_BAR
}

constexpr int NWAVES = 8;
#ifndef MK_N_LAUNCHES
#define MK_N_LAUNCHES 1
#endif
#ifndef MK_DIAG
#define MK_DIAG 0
#endif
constexpr int NPHASE = 14;
constexpr int N_LAUNCHES = MK_N_LAUNCHES;

constexpr int NB = 8, SEQ = 4096, NMETA = 16, TV = NMETA + SEQ, TA = 4352, MA = NB * TA, D = 1024;
constexpr int NIN = 7168, NE = 256, TOPK = 8, DE = 256;
constexpr int NCHUNK = 33;
constexpr float LN_EPS = 1e-5f, ALPHA = 1.189207115002721f;
constexpr float ROUTED_SCALE = 2.5f, LAMBDA_INIT = 0.2f, YSCALE = 16.0f;
constexpr int CAP = 32768;
constexpr int NVALID = NB * SEQ;
constexpr int YSHARED = NVALID * TOPK, YDUMMY = NVALID * (TOPK + 1);

constexpr size_t MiB = 1u << 20;
constexpr size_t SLOTB = 68 * MiB;
static_assert((size_t)MA * D * 2 == SLOTB, "slot size");
constexpr size_t WS_CTL = 0, CTL_ZERO_BYTES = 1 * MiB;
constexpr size_t WS_ROWSTAT = 1 * MiB;
constexpr size_t WS_SCANSUM = 1 * MiB + 320 * 1024;
constexpr size_t WS_LRUWT = 4 * MiB - 512 * 1024;
constexpr size_t WS_S0 = 26 * MiB;
#define WS_SLOT(i) (WS_S0 + (size_t)(i) * SLOTB)
constexpr size_t WS_XN = WS_SLOT(0), WS_XR = WS_SLOT(1), WS_YG = WS_SLOT(2), WS_Q = WS_SLOT(3), WS_K = WS_SLOT(4), WS_V = WS_SLOT(5), WS_GR = WS_SLOT(6), WS_GA = WS_SLOT(7),
                 WS_REC = WS_SLOT(8), WS_O0 = WS_SLOT(9), WS_O1 = WS_SLOT(10), WS_ATT = WS_SLOT(11);
constexpr size_t WS_T1 = WS_SLOT(0), WS_U = WS_SLOT(1), WS_Z = WS_SLOT(2)  , WS_LOGITS = WS_SLOT(5);
constexpr size_t WS_LIST = 262 * MiB;
constexpr size_t WS_WGU = 4 * MiB;
constexpr size_t WS_WD = 596 * MiB;
constexpr size_t WS_ACT = 725 * MiB;
constexpr size_t WS_H1B = 905 * MiB;
constexpr size_t WS_TOKSLOT = 973 * MiB;
constexpr size_t WS_TOKW = 975 * MiB + 256 * 1024;
constexpr size_t WS_WIN = 978 * MiB, WS_WR = 992 * MiB, WS_WA = 994 * MiB, WS_WO = 996 * MiB, WS_WROUT = 998 * MiB;
constexpr size_t WS_Y = 4 * MiB;
constexpr size_t WS_END = 1000 * MiB;
constexpr int MAXTILES = 1408;
static_assert(WS_Y + ((size_t)NVALID * 9 + 1) * D * 2 <= WS_WD && WS_WD + (size_t)257 * 1024 * 256 * 2 <= WS_ACT && WS_ACT + (size_t)MAXTILES * 256 * 256 * 2 <= WS_H1B, "moe map");
static_assert(WS_WGU + (size_t)257 * 512 * 1024 * 2 <= WS_LIST && WS_LIST + (size_t)NE * CAP * 4 <= WS_SLOT(4), "moe map 2");
static_assert(WS_SLOT(12) <= WS_H1B && WS_TOKW + (size_t)MA * 16 * 4 <= WS_WIN, "map 3");
constexpr int CW_TMO = 0, CW_CODE = 1;
constexpr int CW_BAR = 4096;
constexpr int CW_CNT = 16384;
constexpr int CW_DIAG = 20480;

constexpr int RING_OFF = 0, RING_BYTES = 131072;
constexpr int LDSCTL_OFF = RING_BYTES, MISC_OFF = LDSCTL_OFF + 320;
constexpr int TT_OFF = LDSCTL_OFF + 1024;
constexpr int UB_OFF = TT_OFF + MAXTILES * 4;
constexpr int LDS_BYTES = 147456;
constexpr int CN_OFF = UB_OFF + 260 * 4, TB_OFF = CN_OFF + 260 * 4;
static_assert(TB_OFF + 260 * 4 <= LDS_BYTES, "LDS map");

#define GAS __attribute__((address_space(1)))
#define LAS __attribute__((address_space(3)))
typedef unsigned short bf16;
typedef unsigned v4u __attribute__((ext_vector_type(4)));
typedef float f32x4 __attribute__((ext_vector_type(4)));
typedef short bf16x8 __attribute__((ext_vector_type(8)));
typedef GAS unsigned gu32;
typedef GAS unsigned long long gu64;
#define RLX_AGENT __ATOMIC_RELAXED, __HIP_MEMORY_SCOPE_AGENT
#define LDS_WAIT() asm volatile("s_waitcnt lgkmcnt(0)" ::: "memory")
#define VM_WAIT() asm volatile("s_waitcnt vmcnt(0)" ::: "memory")
__device__ __forceinline__ unsigned long long rt() { return __builtin_amdgcn_s_memrealtime(); }
__device__ __forceinline__ unsigned f2bf(float f) { unsigned u = __builtin_bit_cast(unsigned, f); return (u + 0x7fffu + ((u >> 16) & 1u)) >> 16; }
__device__ __forceinline__ unsigned pk2(float lo, float hi) { return f2bf(lo) | (f2bf(hi) << 16); }

#define XB_TMO      128
#define XB_XCNT(j)  (256  + 64 * (j))
#define XB_XSUB(j)  (1280 + 64 * (j))
#define XB_XGEN(j)  (2304 + 64 * (j))
#define XB_TOP      3328
#define XB_TOPGEN   3392
#define XCD_BAR_WORDS 3456
#define XB_SPIN_CAP (1u << 18)

__device__ __forceinline__ unsigned xb_ld(unsigned* p)              { return __hip_atomic_load(p, __ATOMIC_RELAXED, __HIP_MEMORY_SCOPE_AGENT); }
__device__ __forceinline__ unsigned xb_add(unsigned* p, unsigned v) { return __hip_atomic_fetch_add(p, v, __ATOMIC_RELAXED, __HIP_MEMORY_SCOPE_AGENT); }
__device__ __forceinline__ unsigned xb_xcc_id() { return (unsigned)__builtin_amdgcn_s_getreg((3 << 11) | 20) & 0xFu; }
#define XB_SPIN(cond, bar) do { unsigned _sp = 0; while (cond) { __builtin_amdgcn_s_sleep(1); \
    if ((++_sp & 255u) == 0u) { if (xb_ld(&(bar)[XB_TMO])) break; if (_sp > XB_SPIN_CAP) { atomicAdd(&(bar)[XB_TMO], 1u); break; } } } } while (0)

struct XcdBarrier {
    unsigned* bar; unsigned x;
    volatile LAS unsigned* st;
};

__device__ __forceinline__ XcdBarrier xcd_barrier_post(unsigned* bar, volatile LAS unsigned* st) {
    XcdBarrier b; b.bar = bar; b.x = xb_xcc_id(); b.st = st;
    if (threadIdx.x == 0) (void)xb_add(&bar[XB_XCNT(b.x)], 1u);
    return b;
}
__device__ __forceinline__ void xcd_barrier_complete(unsigned* bar, unsigned x, unsigned& nloc, unsigned& nx) {
    const unsigned G = gridDim.x * gridDim.y * gridDim.z;
    unsigned sum, cnt, mine, sp = 0u;
    for (;;) {
        sum = 0u; cnt = 0u; mine = 0u;
#pragma unroll
        for (unsigned j = 0; j < 16; ++j) { const unsigned c = xb_ld(&bar[XB_XCNT(j)]); sum += c; cnt += (c > 0u) ? 1u : 0u; mine = (j == x) ? c : mine; }
        if (sum == G) break;
        __builtin_amdgcn_s_sleep(1);
        if ((++sp & 255u) == 0u) { if (xb_ld(&bar[XB_TMO])) break; if (sp > XB_SPIN_CAP) { atomicAdd(&bar[XB_TMO], 1u); break; } }
    }
    nloc = mine > 0u ? mine : 1u; nx = cnt > 0u ? cnt : 1u;
}

__device__ __forceinline__ void xcd_barrier(const XcdBarrier& b) {
    asm volatile("s_waitcnt vmcnt(0)" ::: "memory");
    __syncthreads();
    if (threadIdx.x == 0) {
        unsigned* bar = b.bar;
        __builtin_amdgcn_s_waitcnt(0);
        unsigned nloc = b.st[0], nx = b.st[1];
        if (nloc == 0u) { xcd_barrier_complete(bar, b.x, nloc, nx); b.st[0] = nloc; b.st[1] = nx; }
        const unsigned old = xb_add(&bar[XB_XSUB(b.x)], 1u);
        const unsigned gen = old / nloc;
        if (old + 1u == (gen + 1u) * nloc) {
            __builtin_amdgcn_fence(__ATOMIC_RELEASE, "agent");
            asm volatile("s_waitcnt vmcnt(0)" ::: "memory");
            const unsigned og = xb_add(&bar[XB_TOP], 1u);
            const unsigned tg = og / nx;
            if (og + 1u == (tg + 1u) * nx) xb_add(&bar[XB_TOPGEN], 1u);
            else XB_SPIN(xb_ld(&bar[XB_TOPGEN]) == tg, bar);
            __builtin_amdgcn_fence(__ATOMIC_ACQUIRE, "agent");
            xb_add(&bar[XB_XGEN(b.x)], 1u);
            asm volatile("s_waitcnt vmcnt(0)" ::: "memory");
        } else {
            XB_SPIN(xb_ld(&bar[XB_XGEN(b.x)]) == gen, bar);
            __builtin_amdgcn_fence(__ATOMIC_ACQUIRE, "agent");
            asm volatile("s_waitcnt vmcnt(0)" ::: "memory");
        }
    }
    __syncthreads();
}


__device__ __forceinline__ float wave_sum(float v) {
#pragma unroll
    for (int o = 1; o < 64; o <<= 1) v += __shfl_xor(v, o);
    return v;
}
__device__ __forceinline__ float bfl(unsigned w) { return __builtin_bit_cast(float, w << 16); }
__device__ __forceinline__ float bfh(unsigned w) { return __builtin_bit_cast(float, w & 0xffff0000u); }
__device__ __forceinline__ float bf1(bf16 h) { return __builtin_bit_cast(float, (unsigned)h << 16); }

struct DenseOrder {
    int nM, nN, nwg, G, c, valid;
    __device__ void init(int M, int N, int G_, int c_, int valid_ = 0) { nM = M / 256; nN = N / 256; nwg = nM * nN; G = G_; c = c_; valid = valid_; }
    __device__ bool next(int i, pg8::Unit& u) const {
        const long L = (long)i * G + c; if (L >= nwg) return false;
        int wgid = (int)L; { const int q = nwg / 8, r = nwg % 8, xcd = wgid % 8, off = wgid / 8; wgid = (xcd < r ? xcd * (q + 1) : r * (q + 1) + (xcd - r) * q) + off; }
        const int WGM = 8; const int nig = WGM * nN, gid = wgid / nig, fm = gid * WGM, gsz = (nM - fm) < WGM ? (nM - fm) : WGM;
        u.pm = fm + ((wgid % nig) % gsz); u.pn = (wgid % nig) / gsz; u.e = 0; u.mt = 0; u.nv = 256; u.aux = 0;
        u.ar = valid ? (u.pm >> 4) * TA + NMETA + (u.pm & 15) * 256 : u.pm * 256; return true;
    }
    __device__ __forceinline__ int row_of(const pg8::Unit&, int) const { return 0; }
    __device__ __forceinline__ void a_ready(const pg8::Unit&) const {}
    __device__ __forceinline__ void done(const pg8::Unit&) const {}
};
template <int NPN> struct MoeOrder {
    int ntiles, G, vcu; volatile LAS unsigned* TT; volatile LAS int* UB; volatile LAS int* CN; const int* list; int* tokslot; int write_slots;
    __device__ bool next(int i, pg8::Unit& u) const {
        const long L = (long)i * G + vcu; if (L >= (long)ntiles * NPN) return false;
        const int tile = (int)(L / NPN); u.pn = (int)(L % NPN); u.pm = tile;
        const unsigned tt = __builtin_amdgcn_readfirstlane(TT[tile]); u.e = (int)(tt & 0xffffu); u.mt = (int)(tt >> 16);
        const int ce = __builtin_amdgcn_readfirstlane(CN[u.e]);
        const int rem = ce - u.mt * 256; u.nv = rem < 256 ? rem : 256;
        u.aux = __builtin_amdgcn_readfirstlane(UB[u.e]) + u.mt * 256; u.ar = tile * 256; return true;
    }
    __device__ __forceinline__ int row_of(const pg8::Unit& u, int r) const {
        if (u.e == NE) return u.mt * 256 + r;
        return (r < u.nv) ? (list[(size_t)u.e * CAP + u.mt * 256 + r] >> 4) : 0;
    }
    __device__ __forceinline__ void a_ready(const pg8::Unit&) const {}
    __device__ __forceinline__ void done(const pg8::Unit& u) const {
        if (write_slots && u.pn == 0 && u.e < NE) { const int r = threadIdx.x; if (r < u.nv) { const int en = list[(size_t)u.e * CAP + u.mt * 256 + r]; tokslot[(size_t)(en >> 4) * 16 + (en & 15)] = u.aux + r; } }
    }
};

using pg8::u32x4;
typedef unsigned u32x2v __attribute__((ext_vector_type(2)));
typedef float f32x2v __attribute__((ext_vector_type(2)));
struct EpiIn {
    static constexpr bool PERM = true;
    bf16* base0; const float* b_gate; float qscale;
    __device__ __forceinline__ void operator()(const f32x4 (&acc)[2][2][4][2], const pg8::Unit& u, int wr, int wc, int fr, int fq) const {
        const int colt = u.pn * 256, t = colt >> 10, colw = colt & 1023;
        bf16* base = base0 + (size_t)t * (SLOTB / 2);
        const int row0 = u.pm * 256 + wr * 64 + fr, col0 = colw + wc * 32 + 8 * fq;
        f32x4 bv[2][2];
#pragma unroll
        for (int bj = 0; bj < 2; ++bj)
#pragma unroll
            for (int n = 0; n < 2; ++n) bv[bj][n] = (t >= 5) ? *(const f32x4*)(b_gate + (t - 5) * 1024 + col0 + bj * 128 + 4 * n) : (f32x4){0.f, 0.f, 0.f, 0.f};
#pragma unroll
        for (int ai = 0; ai < 2; ++ai)
#pragma unroll
            for (int m = 0; m < 4; ++m) { bf16* rowp = base + (size_t)(row0 + ai * 128 + m * 16) * D + col0;
#pragma unroll
                for (int bj = 0; bj < 2; ++bj) { f32x4 v0 = acc[ai][bj][m][0], v1 = acc[ai][bj][m][1];
                    if (t == 1) {
#pragma unroll
                        for (int j = 0; j < 4; ++j) { v0[j] = pg8::gelu_tanh(v0[j]); v1[j] = pg8::gelu_tanh(v1[j]); }
                    } else if (t == 2) { v0 = v0 * qscale; v1 = v1 * qscale; }
                    else if (t >= 5) { v0 = v0 + bv[bj][0]; v1 = v1 + bv[bj][1];
#pragma unroll
                        for (int j = 0; j < 4; ++j) { v0[j] = pg8::fast_sigmoid(v0[j]); v1[j] = pg8::fast_sigmoid(v1[j]); } }
                    u32x4 w; w.x = pg8::cvt_pk_bf16(v0[0], v0[1]); w.y = pg8::cvt_pk_bf16(v0[2], v0[3]); w.z = pg8::cvt_pk_bf16(v1[0], v1[1]); w.w = pg8::cvt_pk_bf16(v1[2], v1[3]);
                    *(u32x4*)(rowp + bj * 128) = w; } }
    }
};
struct EpiGate {
    static constexpr bool PERM = true;
    const bf16* gate; const bf16* add; bf16* out;
    __device__ __forceinline__ void operator()(const f32x4 (&acc)[2][2][4][2], const pg8::Unit& u, int wr, int wc, int fr, int fq) const {
        const int rl = wr * 64 + fr, col0 = u.pn * 256 + wc * 32 + 8 * fq;
#pragma unroll
        for (int ai = 0; ai < 2; ++ai)
#pragma unroll
            for (int m = 0; m < 4; ++m) { const int r = rl + ai * 128 + m * 16; const size_t off = (size_t)(u.pm * 256 + r) * D + col0, goff = (size_t)(u.ar + r) * D + col0;
#pragma unroll
                for (int bj = 0; bj < 2; ++bj) { const f32x4 a0 = acc[ai][bj][m][0], a1 = acc[ai][bj][m][1];
                    const u32x4 gw = *(const u32x4*)(gate + goff + bj * 128);
                    u32x4 aw = (u32x4){0u, 0u, 0u, 0u}; if (add) aw = *(const u32x4*)(add + off + bj * 128);
                    const float r0 = bfl(aw.x) + bfl(gw.x) * a0[0], r1 = bfh(aw.x) + bfh(gw.x) * a0[1], r2 = bfl(aw.y) + bfl(gw.y) * a0[2], r3 = bfh(aw.y) + bfh(gw.y) * a0[3];
                    const float r4 = bfl(aw.z) + bfl(gw.z) * a1[0], r5 = bfh(aw.z) + bfh(gw.z) * a1[1], r6 = bfl(aw.w) + bfl(gw.w) * a1[2], r7 = bfh(aw.w) + bfh(gw.w) * a1[3];
                    u32x4 w; w.x = pg8::cvt_pk_bf16(r0, r1); w.y = pg8::cvt_pk_bf16(r2, r3); w.z = pg8::cvt_pk_bf16(r4, r5); w.w = pg8::cvt_pk_bf16(r6, r7);
                    *(u32x4*)(out + off + bj * 128) = w; } }
    }
};
struct EpiZ {
    static constexpr bool PERM = false;
    const float* x; const float* g0; const float* b0; const float* rowstat; float* Z;
    __device__ __forceinline__ void operator()(const f32x4 (&acc)[2][2][4][2], const pg8::Unit& u, int wr, int wc, int fr, int fq) const {
        const int col0 = u.pn * 256 + wc * 32 + 4 * fq;
        f32x4 gv[2][2], bv[2][2];
#pragma unroll
        for (int bj = 0; bj < 2; ++bj)
#pragma unroll
            for (int n = 0; n < 2; ++n) { gv[bj][n] = *(const f32x4*)(g0 + col0 + bj * 128 + n * 16); bv[bj][n] = *(const f32x4*)(b0 + col0 + bj * 128 + n * 16); }
#pragma unroll
        for (int ai = 0; ai < 2; ++ai)
#pragma unroll
            for (int m = 0; m < 4; ++m) { const int r = ai * 128 + wr * 64 + m * 16 + fr; const int p = u.pm * 256 + r, rt = (p >> 12) * TA + NMETA + (p & 4095);
                const float* xr = x + (size_t)p * D; const float mean = rowstat[2 * rt], rstd = rowstat[2 * rt + 1];
#pragma unroll
                for (int bj = 0; bj < 2; ++bj)
#pragma unroll
                    for (int n = 0; n < 2; ++n) { const int c = col0 + bj * 128 + n * 16; const f32x4 xv = *(const f32x4*)(xr + c);
                        const f32x4 h0 = (xv - mean) * rstd * gv[bj][n] + bv[bj][n];
                        *(f32x4*)(Z + (size_t)p * D + c) = h0 * ALPHA + acc[ai][bj][m][n]; } }
    }
};
struct EpiF32 {
    static constexpr bool PERM = false;
    float* out; int ldc;
    __device__ __forceinline__ void operator()(const f32x4 (&acc)[2][2][4][2], const pg8::Unit& u, int wr, int wc, int fr, int fq) const {
        const int col0 = u.pn * 256 + wc * 32 + 4 * fq;
#pragma unroll
        for (int ai = 0; ai < 2; ++ai)
#pragma unroll
            for (int m = 0; m < 4; ++m) { const int row = u.pm * 256 + ai * 128 + wr * 64 + m * 16 + fr;
#pragma unroll
                for (int bj = 0; bj < 2; ++bj)
#pragma unroll
                    for (int n = 0; n < 2; ++n) *(f32x4*)(out + (size_t)row * ldc + col0 + bj * 128 + n * 16) = acc[ai][bj][m][n]; }
    }
};
struct EpiAct {
    static constexpr bool PERM = true;
    bf16* act;
    __device__ __forceinline__ void operator()(const f32x4 (&acc)[2][2][4][2], const pg8::Unit& u, int wr, int wc, int fr, int fq) const {
        const int row0 = u.pm * 256 + wr * 64 + fr, col0 = u.pn * 128 + wc * 32 + 8 * fq;
#pragma unroll
        for (int ai = 0; ai < 2; ++ai)
#pragma unroll
            for (int m = 0; m < 4; ++m) { float r[8];
#pragma unroll
                for (int n = 0; n < 2; ++n)
#pragma unroll
                    for (int j = 0; j < 4; ++j) { const float gte = acc[ai][0][m][n][j], up = acc[ai][1][m][n][j]; r[n * 4 + j] = gte * pg8::fast_sigmoid(gte) * up; }
                u32x4 w; w.x = pg8::cvt_pk_bf16(r[0], r[1]); w.y = pg8::cvt_pk_bf16(r[2], r[3]); w.z = pg8::cvt_pk_bf16(r[4], r[5]); w.w = pg8::cvt_pk_bf16(r[6], r[7]);
                *(u32x4*)(act + (size_t)(row0 + ai * 128 + m * 16) * DE + col0) = w; }
    }
};
struct EpiY {
    static constexpr bool PERM = true;
    unsigned char* Y;
    __device__ __forceinline__ void operator()(const f32x4 (&acc)[2][2][4][2], const pg8::Unit& u, int wr, int wc, int fr, int fq) const {
        const int r0 = wr * 64 + fr, col0 = u.pn * 256 + wc * 32 + 8 * fq;
#pragma unroll
        for (int ai = 0; ai < 2; ++ai)
#pragma unroll
            for (int m = 0; m < 4; ++m) { const int r = r0 + ai * 128 + m * 16; const int yr = (r < u.nv) ? (u.aux + r) : YDUMMY;
                unsigned char* rowp = Y + (size_t)yr * D + col0;
#pragma unroll
                for (int bj = 0; bj < 2; ++bj) { const f32x4 v0 = acc[ai][bj][m][0] * YSCALE, v1 = acc[ai][bj][m][1] * YSCALE;
                    unsigned w0 = 0u, w1 = 0u;
                    w0 = __builtin_amdgcn_cvt_pk_fp8_f32(v0[0], v0[1], w0, false); w0 = __builtin_amdgcn_cvt_pk_fp8_f32(v0[2], v0[3], w0, true);
                    w1 = __builtin_amdgcn_cvt_pk_fp8_f32(v1[0], v1[1], w1, false); w1 = __builtin_amdgcn_cvt_pk_fp8_f32(v1[2], v1[3], w1, true);
                    *(u32x2v*)(rowp + bj * 128) = (u32x2v){w0, w1}; } }
    }
};

__device__ __forceinline__ void transpose_item(const float* W, int K, int N, bf16* WT, int row_base, int gu, LAS float* scr, int item, int lane) {
    const int nblk = N / 32, kb = item / nblk, nb = item % nblk, k0 = 64 * kb, n0 = 32 * nb;
    const int r0 = row_base + (gu ? ((n0 >> 7) * 256 + (n0 & 127)) : n0);
#pragma unroll 8
    for (int i = 0; i < 32; ++i) { const int kk = 2 * i + (lane >> 5); scr[kk * 33 + (lane & 31)] = W[(size_t)(k0 + kk) * N + n0 + (lane & 31)]; }
    LDS_WAIT(); asm volatile("" ::: "memory");
    const int c = lane & 7;
#pragma unroll
    for (int j = 0; j < 4; ++j) { const int n = (lane >> 3) + 8 * j; const LAS float* s = scr + (8 * c) * 33 + n;
        v4u o; o.x = pk2(s[0 * 33], s[1 * 33]); o.y = pk2(s[2 * 33], s[3 * 33]); o.z = pk2(s[4 * 33], s[5 * 33]); o.w = pk2(s[6 * 33], s[7 * 33]);
        *(GAS v4u*)(WT + (size_t)(r0 + n) * K + k0 + 8 * c) = o; }
    LDS_WAIT(); asm volatile("" ::: "memory");
}
__device__ __forceinline__ void ln_row_to_bf16(const float* xrow, const float* g, const float* b, bf16* orow, float* stat, int lane) {
    const GAS f32x4* xr = (const GAS f32x4*)xrow + lane;
    f32x4 v[4]; float s = 0.f;
#pragma unroll
    for (int j = 0; j < 4; ++j) { v[j] = xr[64 * j]; s += (v[j].x + v[j].y) + (v[j].z + v[j].w); }
    const float mean = wave_sum(s) * (1.f / D); float s2 = 0.f;
#pragma unroll
    for (int j = 0; j < 4; ++j) { v[j] = v[j] - mean; s2 += (v[j].x * v[j].x + v[j].y * v[j].y) + (v[j].z * v[j].z + v[j].w * v[j].w); }
    const float rstd = 1.f / sqrtf(wave_sum(s2) * (1.f / D) + LN_EPS);
    if (stat && lane == 0) { stat[0] = mean; stat[1] = rstd; }
    GAS unsigned long long* o8 = (GAS unsigned long long*)orow + lane;
#pragma unroll
    for (int j = 0; j < 4; ++j) { const f32x4 gg = *((const f32x4*)g + lane + 64 * j), bb = *((const f32x4*)b + lane + 64 * j); const f32x4 y = v[j] * rstd * gg + bb;
        o8[64 * j] = (unsigned long long)pk2(y.x, y.y) | ((unsigned long long)pk2(y.z, y.w) << 32); }
}

__device__ __forceinline__ int crow16(int r, int hi) { return (r & 3) + 8 * (r >> 2) + 4 * hi; }
typedef float f32x16 __attribute__((ext_vector_type(16)));
struct ScanArgs { const bf16* XR; const bf16* YG; bf16* REC; const float* conv_w; const float* conv_b; const bf16* lruwt; const float* b_a; const float* b_i; const float* lam; float* scansum; };
__device__ __forceinline__ float xlane32(float v) { return __shfl_xor(v, 32); }
template <bool FINAL>
__device__ __forceinline__ void scan_phase(const ScanArgs& A, LAS unsigned char* lds, int vcu, int G) {
    const int tid = threadIdx.x, lane = tid & 63, wave = __builtin_amdgcn_readfirstlane(tid >> 6);
    const int nb = vcu & 7, cun = vcu >> 3, nslots = (G >> 3) * 8;
    const int cc = lane & 15, rg = lane >> 4;
    const int l31 = lane & 31, hi = lane >> 5;
#pragma unroll
    for (int i = 0; i < 8; ++i) { const int idx = tid + 512 * i, n = idx >> 4, ch = idx & 15; const int gt = n >> 7, col = n & 127;
        const v4u w = *(const v4u*)(A.lruwt + ((size_t)((gt * 8 + nb) * 128 + col)) * 128 + ch * 8);
        *(LAS v4u*)(lds + n * 272 + ch * 16) = w; }
    __syncthreads();
    constexpr int SPW = 272;
    LAS unsigned char* TL = lds + (wave < 7 ? 256 * SPW + wave * 32 * SPW : LDSCTL_OFF + 1024);
    LAS unsigned char* const WLb = lds + l31 * SPW + hi * 16;
    LAS unsigned char* const TLa = TL + l31 * SPW + hi * 16;
    LAS unsigned char* const TLx = TL + hi * (4 * SPW) + l31 * 2;
    LAS unsigned char* const TLs = TL + rg * (8 * SPW) + cc * 16;
    LAS float* CWL = (LAS float*)(lds + LDSCTL_OFF + 1024 + 32 * SPW);
    if (tid < 160) { const int k = tid >> 5, c4 = (tid & 31) * 4; const f32x4 w = (k < 4) ? *(const f32x4*)(A.conv_w + k * D + nb * 128 + c4) : *(const f32x4*)(A.conv_b + nb * 128 + c4); *(LAS f32x4*)(CWL + k * 128 + c4) = w; }
    __syncthreads();
    float gba[4], gbi[4], gk8[4];
#pragma unroll
    for (int q = 0; q < 4; ++q) { const int C = nb * 128 + 32 * q + l31; gba[q] = A.b_a[C]; gbi[q] = A.b_i[C]; const float lm = A.lam[C];
        const float sp = (-lm > 20.f) ? -lm : log1pf(__expf(-lm)); gk8[q] = -8.0f * sp * 1.4426950408889634f; }
    for (int wv = cun * 8 + wave; wv < 256; wv += nslots) {
        const int b = wv >> 5, ri = wv & 31; const int sb0 = ri == 0 ? 0 : 4 * ri + 1, nsb = ri == 0 ? 5 : 4;
        const size_t rowb = (size_t)b * TA;
        float hc[4], Ac[4];
#pragma unroll
        for (int q = 0; q < 4; ++q) { hc[q] = 0.f; Ac[q] = 1.f; }
        if (FINAL) {
            float h0 = 0.f, h1 = 0.f;
#pragma unroll 1
            for (int j0 = 0; j0 < ri; j0 += 8) { f32x4 s[8];
#pragma unroll
                for (int i = 0; i < 8; ++i) { const int j = j0 + i; const int jc = j < ri ? j : 0; s[i] = *(const f32x4*)(A.scansum + ((size_t)(b * 32 + jc) * D + nb * 128 + 2 * lane) * 2); if (j >= ri) s[i] = (f32x4){1.f, 0.f, 1.f, 0.f}; }
#pragma unroll
                for (int i = 0; i < 8; ++i) { h0 = s[i].x * h0 + s[i].y; h1 = s[i].z * h1 + s[i].w; } }
            ((LAS float*)TL)[2 * lane] = h0; ((LAS float*)TL)[2 * lane + 1] = h1;
            asm volatile("s_waitcnt lgkmcnt(0)" ::: "memory");
#pragma unroll
            for (int q = 0; q < 4; ++q) hc[q] = ((LAS float*)TL)[32 * q + l31];
            asm volatile("s_waitcnt lgkmcnt(0)" ::: "memory");
        }
#pragma unroll 1
        for (int s = 0; s < nsb; ++s) {
            const int t0 = 32 * (sb0 + s);
            v4u xv[11];
#pragma unroll
            for (int i = 0; i < 11; ++i) { int tt = t0 + 8 * rg - 3 + i; const bool neg = tt < 0; tt = neg ? 0 : tt; xv[i] = *(const v4u*)(A.XR + (rowb + tt) * D + nb * 128 + cc * 8); if (i < 3 && neg) xv[i] = (v4u){0u, 0u, 0u, 0u}; }
            { f32x4 w0[4], w1[4];
#pragma unroll
              for (int k = 0; k < 4; ++k) { w0[k] = *(const LAS f32x4*)(CWL + k * 128 + cc * 8); w1[k] = *(const LAS f32x4*)(CWL + k * 128 + cc * 8 + 4); }
              const f32x4 cb0 = *(const LAS f32x4*)(CWL + 4 * 128 + cc * 8), cb1 = *(const LAS f32x4*)(CWL + 4 * 128 + cc * 8 + 4);
#pragma unroll
              for (int i = 0; i < 8; ++i) { float o[8]; o[0] = cb0.x; o[1] = cb0.y; o[2] = cb0.z; o[3] = cb0.w; o[4] = cb1.x; o[5] = cb1.y; o[6] = cb1.z; o[7] = cb1.w;
#pragma unroll
                for (int k = 0; k < 4; ++k) { const v4u x4 = xv[i + k]; const f32x4 a0 = w0[k], a1 = w1[k];
                    o[0] += a0.x * bfl(x4.x); o[1] += a0.y * bfh(x4.x); o[2] += a0.z * bfl(x4.y); o[3] += a0.w * bfh(x4.y);
                    o[4] += a1.x * bfl(x4.z); o[5] += a1.y * bfh(x4.z); o[6] += a1.z * bfl(x4.w); o[7] += a1.w * bfh(x4.w); }
                v4u w; w.x = pk2(o[0], o[1]); w.y = pk2(o[2], o[3]); w.z = pk2(o[4], o[5]); w.w = pk2(o[6], o[7]);
                *(LAS v4u*)(TLs + i * SPW) = w; } }
            asm volatile("s_waitcnt lgkmcnt(0)" ::: "memory");
            bf16x8 af[8];
#pragma unroll
            for (int k8 = 0; k8 < 8; ++k8) af[k8] = *(const LAS bf16x8*)(TLa + k8 * 32);
#pragma unroll
            for (int hh = 0; hh < 2; ++hh) {
                f32x16 acc[2][2];
#pragma unroll
                for (int gt = 0; gt < 2; ++gt)
#pragma unroll
                    for (int cb = 0; cb < 2; ++cb) acc[gt][cb] = f32x16{};
#pragma unroll
                for (int k8 = 0; k8 < 8; ++k8) {
#pragma unroll
                    for (int gt = 0; gt < 2; ++gt)
#pragma unroll
                        for (int cb = 0; cb < 2; ++cb) {
                            const bf16x8 bfv = *(const LAS bf16x8*)(WLb + (gt * 128 + 64 * hh + 32 * cb) * SPW + k8 * 32);
                            acc[gt][cb] = __builtin_amdgcn_mfma_f32_32x32x16_bf16(af[k8], bfv, acc[gt][cb], 0, 0, 0); }
                }
#pragma unroll
                for (int cb = 0; cb < 2; ++cb) { const int q = 2 * hh + cb, c = 32 * q + l31;
                    float av[16], bt[16];
#pragma unroll
                    for (int rr = 0; rr < 16; ++rr) { const int row = crow16(rr, hi);
                        const float rgt = pg8::fast_sigmoid(acc[0][cb][rr] + gba[q]), igt = pg8::fast_sigmoid(acc[1][cb][rr] + gbi[q]);
                        const float a = __builtin_amdgcn_exp2f(gk8[q] * rgt); float mult = __builtin_amdgcn_sqrtf(fmaxf(1.0f - a * a, 0.f));
                        if (rr == 0 && t0 == 0 && hi == 0) mult = 1.0f;
                        const float xc = bf1(*(const LAS bf16*)(TLx + crow16(rr, 0) * SPW + q * 64));
                        av[rr] = a; bt[rr] = mult * igt * xc; }
                    float Ao[4], Bo[4], Ap[4], Bp[4];
#pragma unroll
                    for (int j = 0; j < 4; ++j) { float Ag = av[4 * j], Bg = bt[4 * j];
#pragma unroll
                        for (int k = 1; k < 4; ++k) { Bg = av[4 * j + k] * Bg + bt[4 * j + k]; Ag *= av[4 * j + k]; }
                        Ao[j] = Ag; Bo[j] = Bg; Ap[j] = xlane32(Ag); Bp[j] = xlane32(Bg); }
                    float h = hc[q]; float hin[4];
#pragma unroll
                    for (int j = 0; j < 4; ++j) {
                        const float Ae = hi ? Ap[j] : Ao[j], Be = hi ? Bp[j] : Bo[j], Aod = hi ? Ao[j] : Ap[j], Bod = hi ? Bo[j] : Bp[j];
                        const float h_even_in = h; const float h_odd_in = Ae * h + Be; h = Aod * h_odd_in + Bod;
                        hin[j] = hi ? h_odd_in : h_even_in; Ac[q] *= Ae * Aod; }
                    hc[q] = h;
                    if (FINAL) {
#pragma unroll
                        for (int j = 0; j < 4; ++j) { float hh2 = hin[j];
#pragma unroll
                            for (int k = 0; k < 4; ++k) { const int rr = 4 * j + k, row = crow16(rr, hi); hh2 = av[rr] * hh2 + bt[rr];
                                *(LAS bf16*)(TLx + crow16(rr, 0) * SPW + q * 64) = (bf16)f2bf(hh2); } } }
                }
            }
            if (FINAL) {
                v4u yv[8];
#pragma unroll
                for (int i = 0; i < 8; ++i) yv[i] = *(const v4u*)(A.YG + (rowb + t0 + 8 * rg + i) * D + nb * 128 + cc * 8);
                asm volatile("s_waitcnt lgkmcnt(0)" ::: "memory");
#pragma unroll
                for (int i = 0; i < 8; ++i) { const int row = 8 * rg + i; const v4u hv = *(const LAS v4u*)(TLs + i * SPW); const v4u y = yv[i];
                    v4u o; o.x = pk2(bfl(hv.x) * bfl(y.x), bfh(hv.x) * bfh(y.x)); o.y = pk2(bfl(hv.y) * bfl(y.y), bfh(hv.y) * bfh(y.y)); o.z = pk2(bfl(hv.z) * bfl(y.z), bfh(hv.z) * bfh(y.z)); o.w = pk2(bfl(hv.w) * bfl(y.w), bfh(hv.w) * bfh(y.w));
                    *(v4u*)(A.REC + (rowb + t0 + row) * D + nb * 128 + cc * 8) = o; }
                asm volatile("s_waitcnt lgkmcnt(0)" ::: "memory");
            }
        }
        if (!FINAL && hi == 0) {
#pragma unroll
            for (int q = 0; q < 4; ++q) { float* sm = A.scansum + ((size_t)(b * 32 + ri) * D + nb * 128 + 32 * q + l31) * 2; sm[0] = Ac[q]; sm[1] = hc[q]; } }
    }
    __syncthreads();
}

__device__ __forceinline__ void route_token(const float* logits, const float* rbias, int row, unsigned* cnt, int* list, float* tokw, int lane) {
    const f32x4 lg = *((const f32x4*)(logits + (size_t)row * NE) + lane); const f32x4 rb = *((const f32x4*)rbias + lane);
    float sc[4], sel[4];
#pragma unroll
    for (int j = 0; j < 4; ++j) { sc[j] = 1.0f / (1.0f + expf(-lg[j])); sel[j] = sc[j] + rb[j]; }
    float m1 = fmaxf(sel[0], sel[1]), m2 = fminf(sel[0], sel[1]);
#pragma unroll
    for (int j = 2; j < 4; ++j) { const float v = sel[j]; m2 = fmaxf(m2, fminf(m1, v)); m1 = fmaxf(m1, v); }
#pragma unroll
    for (int o = 1; o < 8; o <<= 1) { const float o1 = __shfl_xor(m1, o), o2 = __shfl_xor(m2, o); m2 = fmaxf(fminf(m1, o1), fmaxf(m2, o2)); m1 = fmaxf(m1, o1); }
    const float gs = m1 + m2; const int g = lane >> 3; int rank = 0;
#pragma unroll
    for (int gg = 0; gg < 8; ++gg) { const float og = __shfl(gs, gg * 8); rank += (og > gs || (og == gs && gg < g)) ? 1 : 0; }
    const bool gsel = rank < 4;
#pragma unroll
    for (int j = 0; j < 4; ++j) if (!gsel) sel[j] = -INFINITY;
    float wk = 0.f; int ek = 0; float ssum = 0.f;
#pragma unroll 1
    for (int k = 0; k < TOPK; ++k) {
        float bv = sel[0]; int bi = 4 * lane;
#pragma unroll
        for (int j = 1; j < 4; ++j) if (sel[j] > bv) { bv = sel[j]; bi = 4 * lane + j; }
#pragma unroll
        for (int o = 1; o < 64; o <<= 1) { const float ov = __shfl_xor(bv, o); const int oi = __shfl_xor(bi, o); if (ov > bv || (ov == bv && oi < bi)) { bv = ov; bi = oi; } }
        const int own = bi >> 2, jj = bi & 3;
        float s = 0.f;
        if (lane == own) {
#pragma unroll
            for (int j = 0; j < 4; ++j) if (j == jj) { s = sc[j]; sel[j] = -INFINITY; } }
        s = __shfl(s, own);
        ssum += s; if (lane == k) { wk = s; ek = bi; }
    }
    if (lane < TOPK) { const float w = wk / ssum * ROUTED_SCALE; const unsigned pos = atomicAdd(cnt + ek, 1u); if (pos < (unsigned)CAP) list[(size_t)ek * CAP + pos] = (row << 4) | lane; tokw[(size_t)row * 16 + lane] = w; }
}

struct Args { const float* in[33]; float* out; unsigned char* ws; int ph_lo, ph_hi, li, pad; };
__global__ void __launch_bounds__(NWAVES * 64, 2) mega_fwd(Args args) {
    extern __shared__ __attribute__((aligned(16))) unsigned char lds[];
    LAS unsigned char* L = (LAS unsigned char*)lds;
    volatile LAS unsigned* MISC = (volatile LAS unsigned*)(L + MISC_OFF);
    const int tid = threadIdx.x, lane = tid & 63, wave = __builtin_amdgcn_readfirstlane(tid >> 6);
    const int G = gridDim.x; const int bx = blockIdx.x; const int vcu = (G % 8 == 0) ? (bx % 8) * (G / 8) + bx / 8 : bx;
    unsigned char* ws = args.ws;
    gu32* ctl = (gu32*)(ws + WS_CTL);
    for (int u = tid; u < (LDS_BYTES - LDSCTL_OFF) / 4; u += NWAVES * 64) ((LAS unsigned*)(L + LDSCTL_OFF))[u] = 0u;
    __syncthreads();
    XcdBarrier bar; bar.bar = (unsigned*)(ctl + CW_BAR); bar.x = 0; bar.st = nullptr;
    if (N_LAUNCHES == 1) bar = xcd_barrier_post((unsigned*)(ctl + CW_BAR), MISC + 8);
#define GRID_BAR() do { if (N_LAUNCHES == 1) xcd_barrier(bar); } while (0)
#if MK_DIAG
    int n_stamp = 0;
#define STAMP() do { if (blockIdx.x == 0 && tid == 0) { ((unsigned long long*)(ctl + CW_DIAG))[n_stamp] = __builtin_amdgcn_s_memrealtime(); } ++n_stamp; } while (0)
#else
#define STAMP() do {} while (0)
#endif
    STAMP();
    const int lo = args.ph_lo, hi = args.ph_hi;
#ifndef MK_REPEAT_MASK
#define MK_REPEAT_MASK 0
#endif
#ifndef MK_PHASE_MASK
#define MK_PHASE_MASK 0xffff
#endif
#define IN(k) ((((MK_PHASE_MASK) >> (k)) & 1) && lo <= (k) && (k) < hi)
#define BOTH(k) (IN(k) && IN((k) + 1))
    const int gw = vcu * NWAVES + wave, NGW = G * NWAVES;
    const float* x = args.in[0]; const float* meta = args.in[1];

    if (IN(0)) {
        LAS float* scr = (LAS float*)(L + RING_OFF + wave * 16384);
        constexpr int I_IN = 16 * (NIN / 32), I_SQ = 16 * 32, I_RT = 16 * 8, I_LRU = 2 * 8 * 2 * 4;
        constexpr int NITEMS = I_IN + 3 * I_SQ + I_RT + I_LRU;
        for (int it = gw; it < NITEMS; it += NGW) {
            int r = it;
            if (r < I_IN) { transpose_item(args.in[4], D, NIN, (bf16*)(ws + WS_WIN), 0, 0, scr, r, lane); continue; } r -= I_IN;
            if (r < I_SQ) { transpose_item(args.in[18], D, D, (bf16*)(ws + WS_WR), 0, 0, scr, r, lane); continue; } r -= I_SQ;
            if (r < I_SQ) { transpose_item(args.in[19], D, D, (bf16*)(ws + WS_WA), 0, 0, scr, r, lane); continue; } r -= I_SQ;
            if (r < I_SQ) { transpose_item(args.in[20], D, D, (bf16*)(ws + WS_WO), 0, 0, scr, r, lane); continue; } r -= I_SQ;
            if (r < I_RT) { transpose_item(args.in[23], D, NE, (bf16*)(ws + WS_WROUT), 0, 0, scr, r, lane); continue; } r -= I_RT;
            { const int m = r >> 3, it2 = r & 7, gt = m >> 3, blk = m & 7;
              transpose_item(args.in[gt ? 10 : 8] + (size_t)blk * 128 * 128, 128, 128, (bf16*)(ws + WS_LRUWT) + (size_t)(gt * 8 + blk) * 128 * 128, 0, 0, scr, it2, lane); }
        }
        for (int m = gw; m < MA; m += NGW) { const int b = m / TA, t = m - b * TA; bf16* orow = (bf16*)(ws + WS_XN) + (size_t)m * D;
            if (t < TV) { const float* xr = (t < NMETA) ? meta + (size_t)t * D : x + ((size_t)b * SEQ + (t - NMETA)) * D;
                ln_row_to_bf16(xr, args.in[2], args.in[3], orow, (float*)(ws + WS_ROWSTAT) + 2 * (size_t)m, lane); }
            else { GAS unsigned long long* o8 = (GAS unsigned long long*)orow + lane;
#pragma unroll
                for (int j = 0; j < 4; ++j) o8[64 * j] = 0ull; } }
        if (BOTH(0)) GRID_BAR();
        STAMP();
    }
    if (IN(1)) {
        pg8::Gemm g{(const bf16*)(ws + WS_XN), (const bf16*)(ws + WS_WIN), D, 0}; DenseOrder S; S.init(MA, NIN, G, bx);
        EpiIn E{(bf16*)(ws + WS_XR), args.in[5], 0.125f * 1.4426950408889634f};
        pg8::gemm_phase<EpiIn, DenseOrder, true, false>(L + RING_OFF, g, S, E);
        if (BOTH(1)) GRID_BAR();
        STAMP();
    }
    ScanArgs SA{(const bf16*)(ws + WS_XR), (const bf16*)(ws + WS_YG), (bf16*)(ws + WS_REC), args.in[6], args.in[7], (const bf16*)(ws + WS_LRUWT), args.in[9], args.in[11], args.in[12], (float*)(ws + WS_SCANSUM)};
    if (IN(2)) {
        scan_phase<false>(SA, L + RING_OFF, vcu, G);
        if (BOTH(2)) GRID_BAR();
        STAMP();
    }
    if (IN(3)) {
        scan_phase<true>(SA, L + RING_OFF, vcu, G);
        { const int bh = vcu >> 2, sub = vcu & 3, m = sub >> 1, part = sub & 1, b = bh >> 3, h = bh & 7;
          if (bh < NB * 8) {
              const attn2::AttnTensors AT{(const attn2::bf16*)(ws + WS_Q), (const attn2::bf16*)(ws + WS_K), (const attn2::bf16*)(ws + WS_V), (attn2::bf16*)(ws + (m ? WS_O1 : WS_O0))};
              const attn2::SplitOrder AS{b, 2 * h + m, h, part};
              attn2::attn_phase<attn2::SplitOrder>((char*)lds + RING_OFF, AT, AS);
          } }
        if (BOTH(3)) GRID_BAR();
        STAMP();
    }
    if (IN(4)) {
        const float lamq = wave_sum(args.in[13][lane] * args.in[14][lane]), lamq2 = wave_sum(args.in[15][lane] * args.in[16][lane]);
        const float lam = expf(lamq) - expf(lamq2) + LAMBDA_INIT;
        const bf16* O0 = (const bf16*)(ws + WS_O0); const bf16* O1 = (const bf16*)(ws + WS_O1); bf16* ATT = (bf16*)(ws + WS_ATT);
        for (int m = gw; m < MA; m += NGW) {
#pragma unroll
            for (int j = 0; j < 2; ++j) { const int c = j * 512 + lane * 8; const v4u a = *(const v4u*)(O0 + (size_t)m * D + c), bq = *(const v4u*)(O1 + (size_t)m * D + c);
                float d[8]; d[0] = bfl(a.x) - lam * bfl(bq.x); d[1] = bfh(a.x) - lam * bfh(bq.x); d[2] = bfl(a.y) - lam * bfl(bq.y); d[3] = bfh(a.y) - lam * bfh(bq.y);
                d[4] = bfl(a.z) - lam * bfl(bq.z); d[5] = bfh(a.z) - lam * bfh(bq.z); d[6] = bfl(a.w) - lam * bfl(bq.w); d[7] = bfh(a.w) - lam * bfh(bq.w);
                float ss = 0.f;
#pragma unroll
                for (int q = 0; q < 8; ++q) ss += d[q] * d[q];
                ss += __shfl_xor(ss, 1); ss += __shfl_xor(ss, 2); ss += __shfl_xor(ss, 4); ss += __shfl_xor(ss, 8);
                const float rs = (1.0f - LAMBDA_INIT) / sqrtf(ss * (1.0f / 128.f) + LN_EPS);
                const int e0 = c & 127; const f32x4 g0 = *(const f32x4*)(args.in[17] + e0), g1 = *(const f32x4*)(args.in[17] + e0 + 4);
                v4u w; w.x = pk2(d[0] * rs * g0.x, d[1] * rs * g0.y); w.y = pk2(d[2] * rs * g0.z, d[3] * rs * g0.w); w.z = pk2(d[4] * rs * g1.x, d[5] * rs * g1.y); w.w = pk2(d[6] * rs * g1.z, d[7] * rs * g1.w);
                *(v4u*)(ATT + (size_t)m * D + c) = w; } }
        if (BOTH(4)) GRID_BAR();
        STAMP();
    }
    if (IN(5)) {
        pg8::Gemm g{(const bf16*)(ws + WS_REC), (const bf16*)(ws + WS_WR), D, 0}; DenseOrder S; S.init(NVALID, D, G, bx, 1);
        EpiGate E{(const bf16*)(ws + WS_GR), nullptr, (bf16*)(ws + WS_T1)};
        pg8::gemm_phase<EpiGate, DenseOrder, true, false>(L + RING_OFF, g, S, E);
        if (BOTH(5)) GRID_BAR();
        STAMP();
    }
    if (IN(6)) {
        pg8::Gemm g{(const bf16*)(ws + WS_ATT), (const bf16*)(ws + WS_WA), D, 0}; DenseOrder S; S.init(NVALID, D, G, bx, 1);
        EpiGate E{(const bf16*)(ws + WS_GA), (const bf16*)(ws + WS_T1), (bf16*)(ws + WS_U)};
        pg8::gemm_phase<EpiGate, DenseOrder, true, false>(L + RING_OFF, g, S, E);
        if (BOTH(6)) GRID_BAR();
        STAMP();
    }
    if (IN(7)) {
        pg8::Gemm g{(const bf16*)(ws + WS_U), (const bf16*)(ws + WS_WO), D, 0}; DenseOrder S; S.init(NVALID, D, G, bx, 0);
        EpiZ E{x, args.in[2], args.in[3], (const float*)(ws + WS_ROWSTAT), (float*)(ws + WS_Z)};
        pg8::gemm_phase<EpiZ, DenseOrder, true, false>(L + RING_OFF, g, S, E);
        if (BOTH(7)) GRID_BAR();
        STAMP();
    }
    if (IN(8)) {
        for (int m = gw; m < NVALID; m += NGW) ln_row_to_bf16((const float*)(ws + WS_Z) + (size_t)m * D, args.in[21], args.in[22], (bf16*)(ws + WS_H1B) + (size_t)m * D, nullptr, lane);
        if (BOTH(8)) GRID_BAR();
        STAMP();
    }
    if (IN(9)) {
        { pg8::Gemm g{(const bf16*)(ws + WS_H1B), (const bf16*)(ws + WS_WROUT), D, 0}; DenseOrder S; S.init(NVALID, NE, G, bx, 0);
          EpiF32 E{(float*)(ws + WS_LOGITS), NE};
          pg8::gemm_phase<EpiF32, DenseOrder, false, false>(L + RING_OFF, g, S, E); }
        LAS float* scr = (LAS float*)(L + RING_OFF + wave * 16384);
        constexpr int IPE = 128;
        for (int it = gw; it < 257 * 3 * IPE; it += NGW) { const int e = it / (3 * IPE), r = it - e * 3 * IPE, which = r / IPE, i2 = r - which * IPE;
            if (which < 2) { const float* W = (e < NE) ? args.in[25 + which] + (size_t)e * D * DE : args.in[28 + which];
                transpose_item(W, D, DE, (bf16*)(ws + WS_WGU), e * 512 + which * 128, 1, scr, i2, lane); }
            else { const float* W = (e < NE) ? args.in[27] + (size_t)e * DE * D : args.in[30];
                transpose_item(W, DE, D, (bf16*)(ws + WS_WD) + (size_t)e * D * DE, 0, 0, scr, i2, lane); } }
        if (BOTH(9)) GRID_BAR();
        STAMP();
    }
    if (IN(10)) {
        for (int p = gw; p < NVALID; p += NGW) { const int row = p;
            route_token((const float*)(ws + WS_LOGITS), args.in[24], row, (unsigned*)(ctl + CW_CNT), (int*)(ws + WS_LIST), (float*)(ws + WS_TOKW), lane); }
        if (BOTH(10)) GRID_BAR();
        STAMP();
    }
    if (IN(11) || IN(12)) {
        volatile LAS unsigned* TT = (volatile LAS unsigned*)(L + TT_OFF); volatile LAS int* UB = (volatile LAS int*)(L + UB_OFF);
        const unsigned* cnt = (const unsigned*)(ctl + CW_CNT);
        volatile LAS int* CN = (volatile LAS int*)(L + CN_OFF); volatile LAS int* TB = (volatile LAS int*)(L + TB_OFF);
        if (tid <= NE) { int c = (tid == NE) ? NVALID : (int)__hip_atomic_load(cnt + tid, RLX_AGENT); if (c > CAP) c = CAP; CN[tid] = c; }
        __syncthreads();
        if (tid == 0) { int tb = 0, ub = 0;
            for (int e = 0; e <= NE; ++e) { const int c = CN[e]; int ntl = (c + 255) >> 8; if (tb + ntl > MAXTILES) ntl = MAXTILES - tb; UB[e] = ub; TB[e] = tb; ub += c; tb += ntl; }
            TB[NE + 1] = tb; MISC[16] = (unsigned)tb; }
        __syncthreads();
        if (tid <= NE) { const int t0 = TB[tid], t1 = TB[tid + 1]; for (int t = t0; t < t1; ++t) TT[t] = (unsigned)tid | ((unsigned)(t - t0) << 16); }
        __syncthreads();
        const int ntiles = (int)MISC[16];
        if (IN(11)) {
            pg8::Gemm g{(const bf16*)(ws + WS_H1B), (const bf16*)(ws + WS_WGU), D, (size_t)512 * D};
            MoeOrder<2> S{ntiles, G, vcu, TT, UB, CN, (const int*)(ws + WS_LIST), (int*)(ws + WS_TOKSLOT), 1};
            EpiAct E{(bf16*)(ws + WS_ACT)};
            pg8::gemm_phase<EpiAct, MoeOrder<2>, true, true>(L + RING_OFF, g, S, E);
            if (BOTH(11)) GRID_BAR();
            STAMP();
        STAMP();
        }
        if (IN(12)) {
            pg8::Gemm g{(const bf16*)(ws + WS_ACT), (const bf16*)(ws + WS_WD), DE, (size_t)D * DE};
            MoeOrder<4> S{ntiles, G, vcu, TT, UB, CN, (const int*)(ws + WS_LIST), (int*)(ws + WS_TOKSLOT), 0};
            EpiY E{(unsigned char*)(ws + WS_Y)};
            pg8::gemm_phase<EpiY, MoeOrder<4>, true, false>(L + RING_OFF, g, S, E);
            if (BOTH(12)) GRID_BAR();
            STAMP();
        STAMP();
        }
    }
    if (IN(13)) {
        const bf16* H1 = (const bf16*)(ws + WS_H1B); const unsigned char* Y = (const unsigned char*)(ws + WS_Y); const int* tokslot = (const int*)(ws + WS_TOKSLOT); const float* tokw = (const float*)(ws + WS_TOKW);
        unsigned poison = __hip_atomic_load(ctl + CW_BAR + XB_TMO, RLX_AGENT) != 0u;
        typedef float f32x2q __attribute__((ext_vector_type(2)));
        for (int p = gw; p < NVALID; p += NGW) { const int row = p; const int c = lane * 16;
            float z[16];
            { const v4u a = *(const v4u*)(H1 + (size_t)row * D + c), a2 = *(const v4u*)(H1 + (size_t)row * D + c + 8);
              z[0] = ALPHA * bfl(a.x); z[1] = ALPHA * bfh(a.x); z[2] = ALPHA * bfl(a.y); z[3] = ALPHA * bfh(a.y); z[4] = ALPHA * bfl(a.z); z[5] = ALPHA * bfh(a.z); z[6] = ALPHA * bfl(a.w); z[7] = ALPHA * bfh(a.w);
              z[8] = ALPHA * bfl(a2.x); z[9] = ALPHA * bfh(a2.x); z[10] = ALPHA * bfl(a2.y); z[11] = ALPHA * bfh(a2.y); z[12] = ALPHA * bfl(a2.z); z[13] = ALPHA * bfh(a2.z); z[14] = ALPHA * bfl(a2.w); z[15] = ALPHA * bfh(a2.w); }
            v4u yv[TOPK + 1]; float wv[TOPK + 1];
#pragma unroll
            for (int k = 0; k <= TOPK; ++k) { const int yr = (k < TOPK) ? tokslot[(size_t)row * 16 + k] : YSHARED + p; wv[k] = ((k < TOPK) ? tokw[(size_t)row * 16 + k] : 1.0f) * (1.0f / YSCALE);
                yv[k] = *(const v4u*)(Y + (size_t)yr * D + c); }
#pragma unroll
            for (int k = 0; k <= TOPK; ++k) { const float w = wv[k]; const unsigned q[4] = {yv[k].x, yv[k].y, yv[k].z, yv[k].w};
#pragma unroll
                for (int i = 0; i < 4; ++i) { const f32x2q lo = __builtin_amdgcn_cvt_pk_f32_fp8(q[i], false), hi2 = __builtin_amdgcn_cvt_pk_f32_fp8(q[i], true);
                    z[4 * i] += w * lo.x; z[4 * i + 1] += w * lo.y; z[4 * i + 2] += w * hi2.x; z[4 * i + 3] += w * hi2.y; } }
            float s = 0.f;
#pragma unroll
            for (int q = 0; q < 16; ++q) s += z[q];
            const float mean = wave_sum(s) * (1.f / D); float s2 = 0.f;
#pragma unroll
            for (int q = 0; q < 16; ++q) { z[q] -= mean; s2 += z[q] * z[q]; }
            const float rstd = 1.f / sqrtf(wave_sum(s2) * (1.f / D) + LN_EPS);
            float* orow = args.out + (size_t)p * D + c;
#pragma unroll
            for (int q4 = 0; q4 < 4; ++q4) { const f32x4 gg = *(const f32x4*)(args.in[31] + c + 4 * q4), bb = *(const f32x4*)(args.in[32] + c + 4 * q4);
                f32x4 o; o.x = z[4 * q4] * rstd * gg.x + bb.x; o.y = z[4 * q4 + 1] * rstd * gg.y + bb.y; o.z = z[4 * q4 + 2] * rstd * gg.z + bb.z; o.w = z[4 * q4 + 3] * rstd * gg.w + bb.w;
                if (poison) o = (f32x4){__builtin_nanf(""), __builtin_nanf(""), __builtin_nanf(""), __builtin_nanf("")};
                *(f32x4*)(orow + 4 * q4) = o; } }
    }
#if MK_DIAG
    GRID_BAR(); STAMP();
    if (blockIdx.x == 0 && tid == 0) { const unsigned long long* ts = (const unsigned long long*)(ctl + CW_DIAG);
      const unsigned long long a0 = __hip_atomic_load(ts + MK_DIAG_S1, RLX_AGENT), a1 = __hip_atomic_load(ts + MK_DIAG_S1 + 1, RLX_AGENT);
      args.out[0] = 40.0f + (float)(a1 - a0) * 0.01f; }
#endif
#undef IN
#undef BOTH
#undef GRID_BAR
}

extern "C" void kernel_launch(void* const* d_in, const int* in_sizes, int n_in, void* d_out, int out_size, void* d_ws, size_t ws_size, hipStream_t stream) {
    static int grid = 0;
    if (grid == 0) {
        if (n_in != 33 || in_sizes[0] != NB * SEQ * D || out_size != NB * SEQ * D || ws_size < WS_END) { fprintf(stderr, "kernel_launch: unexpected shapes / workspace (n_in %d, in0 %d, out %d, ws %zu < %zu); nothing launched\n", n_in, n_in > 0 ? in_sizes[0] : -1, out_size, ws_size, (size_t)WS_END); grid = -1; return; }
        int dev = 0, cus = 0;
        if (hipGetDevice(&dev) != hipSuccess || hipDeviceGetAttribute(&cus, hipDeviceAttributeMultiprocessorCount, dev) != hipSuccess) { grid = -1; return; }
        if (hipFuncSetAttribute((const void*)mega_fwd, hipFuncAttributeMaxDynamicSharedMemorySize, LDS_BYTES) != hipSuccess) { fprintf(stderr, "kernel_launch: hipFuncSetAttribute failed\n"); grid = -1; return; }
        int per_cu = 0;
        if (hipOccupancyMaxActiveBlocksPerMultiprocessor(&per_cu, (const void*)mega_fwd, NWAVES * 64, LDS_BYTES) != hipSuccess || per_cu < 1) fprintf(stderr, "kernel_launch: occupancy query says %d\n", per_cu);
        (void)hipGetLastError();
        grid = cus;
    }
    if (grid < 0) return;
    if (hipMemsetAsync((char*)d_ws + WS_CTL, 0, CTL_ZERO_BYTES, stream) != hipSuccess) return;
    Args a{};
    for (int i = 0; i < 33; ++i) a.in[i] = (const float*)d_in[i];
    a.out = (float*)d_out; a.ws = (unsigned char*)d_ws;
    if (N_LAUNCHES == 1) { a.ph_lo = 0; a.ph_hi = NPHASE; a.li = 0; hipLaunchKernelGGL(mega_fwd, dim3(grid), dim3(NWAVES * 64), LDS_BYTES, stream, a); }
    else for (int li = 0; li < NPHASE; ++li) { a.ph_lo = li; a.ph_hi = li + 1; a.li = li; for (int rep = 0; rep < (((MK_REPEAT_MASK) >> li) & 1) + 1; ++rep) hipLaunchKernelGGL(mega_fwd, dim3(grid), dim3(NWAVES * 64), LDS_BYTES, stream, a); }
}
```

```cpp
#include <hip/hip_runtime.h>
#include <hip/hip_bf16.h>
#include <cstdio>
#include <cstdint>
#include <cmath>
namespace pg8 {
#define PG8_LAS __attribute__((address_space(3)))
typedef unsigned short bf16_t;
typedef short bf16x8 __attribute__((ext_vector_type(8)));
typedef float f32x4 __attribute__((ext_vector_type(4)));
typedef float f32x2 __attribute__((ext_vector_type(2)));
typedef unsigned u32x4 __attribute__((ext_vector_type(4)));
constexpr int BM = 256, BK = 64, HALF = 128, HTB = HALF * BK * 2  , STAGE_BYTES = 8 * HTB;

__host__ __device__ __forceinline__ int lds_byte(int r, int c) { const int st = (r >> 4) * 2 + (c >> 5), rr = r & 15, cc = c & 31, ob = rr * 64 + cc * 2; return st * 1024 + (ob ^ (((ob >> 9) & 1) << 5)); }
__host__ __device__ __forceinline__ void stage_rc(int b, int& R, int& C) { const int st = b / 1024, sb = b % 1024, swz = sb ^ (((sb >> 9) & 1) << 5); R = (st >> 1) * 16 + swz / 64; C = (st & 1) * 32 + (swz % 64) / 2; }
__host__ __device__ __forceinline__ int perm32(int rho) { const int n = rho >> 4, i = rho & 15; return 8 * (i >> 2) + 4 * n + (i & 3); }

struct Unit { int pm, pn, e, mt, nv, aux, ar; };
struct Gemm { const bf16_t* A; const bf16_t* Bt; int K; size_t b_estride; };

__device__ __forceinline__ unsigned cvt_pk_bf16(float lo, float hi) { unsigned r; asm volatile("v_cvt_pk_bf16_f32 %0, %1, %2" : "=v"(r) : "v"(lo), "v"(hi)); return r; }
__device__ __forceinline__ float bf_lo(unsigned w) { return __builtin_bit_cast(float, w << 16); }
__device__ __forceinline__ float bf_hi(unsigned w) { return __builtin_bit_cast(float, w & 0xffff0000u); }
__device__ __forceinline__ float fast_sigmoid(float x) { return __builtin_amdgcn_rcpf(1.0f + __builtin_amdgcn_exp2f(-1.4426950408889634f * x)); }
__device__ __forceinline__ float gelu_tanh(float v) { const float y = 1.5957691216057308f * (v + 0.044715f * v * v * v); return v * fast_sigmoid(y); }

template <class Epi, class Sched, bool ALIGN_EPI, bool GATHER>
__device__ __forceinline__ void gemm_phase(PG8_LAS unsigned char* lds, const Gemm g, const Sched& S, const Epi& E) {
    const int tid = threadIdx.x, wid = __builtin_amdgcn_readfirstlane(tid >> 6), lane = tid & 63, wr = wid >> 2, wc = wid & 3, fr = lane & 15, fq = lane >> 4;
    const int K = g.K, nt = K / BK;
    unsigned voffA[2], voffB[2]; int RA[2]; unsigned CA2[2];
#pragma unroll
    for (int i = 0; i < 2; ++i) { int R, C; stage_rc(tid * 16 + i * 8192, R, C); const int Rb = Epi::PERM ? ((R & ~31) + perm32(R & 31)) : R;
        voffA[i] = (unsigned)(R * K + C) * 2u; voffB[i] = (unsigned)(Rb * K + C) * 2u; RA[i] = R; CA2[i] = (unsigned)C * 2u; }
    const size_t kstep = (size_t)(BK * 2);
    const size_t hstep = (size_t)HALF * K * 2;
    const size_t tstep = 2 * hstep;
    const unsigned ldsw = (unsigned)wid * 1024u;
    const int aoff = lds_byte(wr * 64 + fr, fq * 8), boff = lds_byte(wc * 32 + fr, fq * 8);
#define PG8_SA(b, h) (((b) * 2 + (h)) * HTB)
#define PG8_SB(b, h) ((4 + (b) * 2 + (h)) * HTB)
#define PG8_STAGE2(bufoff, gbase, v0, v1) do { \
        __builtin_amdgcn_global_load_lds((const unsigned*)((const char*)(gbase) + (v0)), (PG8_LAS unsigned*)(lds + (bufoff) + ldsw), 16, 0, 0); \
        __builtin_amdgcn_global_load_lds((const unsigned*)((const char*)(gbase) + (v1)), (PG8_LAS unsigned*)(lds + (bufoff) + ldsw + 8192), 16, 0, 0); } while (0)
#define PG8_STAGEB(bufoff, gbase) PG8_STAGE2(bufoff, gbase, voffB[0], voffB[1])
#define PG8_LDA(dst, b, h) do { _Pragma("unroll") for (int m = 0; m < 4; ++m) _Pragma("unroll") for (int k = 0; k < 2; ++k) dst[m][k] = *(const PG8_LAS bf16x8*)(lds + PG8_SA(b, h) + aoff + m * 2048 + k * 1024); } while (0)
#define PG8_LDB(dst, b, h) do { _Pragma("unroll") for (int n = 0; n < 2; ++n) _Pragma("unroll") for (int k = 0; k < 2; ++k) dst[n][k] = *(const PG8_LAS bf16x8*)(lds + PG8_SB(b, h) + boff + n * 2048 + k * 1024); } while (0)
#define PG8_MMA(ai, bj, At, Bt) do { __builtin_amdgcn_s_setprio(1); _Pragma("unroll") for (int m = 0; m < 4; ++m) _Pragma("unroll") for (int n = 0; n < 2; ++n) _Pragma("unroll") for (int k = 0; k < 2; ++k) \
        acc[ai][bj][m][n] = __builtin_amdgcn_mfma_f32_16x16x32_bf16(Bt[n][k], At[m][k], acc[ai][bj][m][n], 0, 0, 0); __builtin_amdgcn_s_setprio(0); } while (0)
#define PG8_WAIT_V(n) asm volatile("s_waitcnt vmcnt(" #n ")" ::: "memory")
#define PG8_WAIT_L(n) asm volatile("s_waitcnt lgkmcnt(" #n ")" ::: "memory")
#define PG8_BAR __builtin_amdgcn_s_barrier()
#define PG8_SCHED __builtin_amdgcn_sched_barrier(0)
    Unit cur, nxt; int ui = 0;
    if (!S.next(0, cur)) return;
    f32x4 acc[2][2][4][2];
#pragma unroll
    for (int a = 0; a < 2; ++a)
#pragma unroll
        for (int b = 0; b < 2; ++b)
#pragma unroll
            for (int m = 0; m < 4; ++m)
#pragma unroll
                for (int n = 0; n < 2; ++n) acc[a][b][m][n] = (f32x4){0.f, 0.f, 0.f, 0.f};
    bf16x8 At[4][2], B0[2][2], B1[2][2];
    const char* const gA = (const char*)g.A;
    unsigned roC[2][2], roN[2][2];
    const char* cA; const char* cB = (const char*)g.Bt + ((size_t)cur.e * g.b_estride) * 2 + (size_t)cur.pn * tstep;
    if constexpr (GATHER) {
#pragma unroll
        for (int h = 0; h < 2; ++h)
#pragma unroll
            for (int i = 0; i < 2; ++i) roC[h][i] = (unsigned)S.row_of(cur, h * HALF + RA[i]) * (unsigned)(K * 2) + CA2[i];
        cA = gA;
    } else {
#pragma unroll
        for (int h = 0; h < 2; ++h)
#pragma unroll
            for (int i = 0; i < 2; ++i) roC[h][i] = voffA[i] + (unsigned)(h * hstep);
        cA = gA + (size_t)cur.ar * (size_t)(K * 2);
    }
    S.a_ready(cur);
    PG8_STAGEB(PG8_SB(0, 0), cB); PG8_STAGEB(PG8_SB(0, 1), cB + hstep); PG8_STAGE2(PG8_SA(0, 0), cA, roC[0][0], roC[0][1]); PG8_STAGE2(PG8_SA(0, 1), cA, roC[1][0], roC[1][1]);
    if (wr == 1) PG8_BAR;
    PG8_WAIT_V(2); PG8_BAR;
    PG8_STAGEB(PG8_SB(1, 0), cB + kstep); PG8_STAGE2(PG8_SA(1, 0), cA + kstep, roC[0][0], roC[0][1]); PG8_STAGEB(PG8_SB(1, 1), cB + hstep + kstep);
    PG8_WAIT_V(6); PG8_BAR;
    for (;;) {
        const bool has_next = S.next(ui + 1, nxt);
        const char* nA; const char* nB = has_next ? (const char*)g.Bt + ((size_t)nxt.e * g.b_estride) * 2 + (size_t)nxt.pn * tstep : cB;
        if constexpr (GATHER) {
            nA = gA;
            if (has_next) {
#pragma unroll
                for (int h = 0; h < 2; ++h)
#pragma unroll
                    for (int i = 0; i < 2; ++i) roN[h][i] = (unsigned)S.row_of(nxt, h * HALF + RA[i]) * (unsigned)(K * 2) + CA2[i];
            } else {
#pragma unroll
                for (int h = 0; h < 2; ++h)
#pragma unroll
                    for (int i = 0; i < 2; ++i) roN[h][i] = roC[h][i];
            }
        } else {
            nA = has_next ? gA + (size_t)nxt.ar * (size_t)(K * 2) : cA;
        }
#pragma clang loop unroll(disable)
        for (int t = 0; t < nt; t += 2) {
            const bool last = (t == nt - 2);
            const char* a1 = cA + (size_t)(t + 1) * kstep;
            const char* a2 = last ? nA : cA + (size_t)(t + 2) * kstep; const char* b2 = last ? nB : cB + (size_t)(t + 2) * kstep;
            const char* a3 = a2 + kstep; const char* b3 = b2 + kstep;
            unsigned s00, s01, s10, s11;
            if constexpr (GATHER) { s00 = last ? roN[0][0] : roC[0][0]; s01 = last ? roN[0][1] : roC[0][1]; s10 = last ? roN[1][0] : roC[1][0]; s11 = last ? roN[1][1] : roC[1][1]; }
            else { s00 = roC[0][0]; s01 = roC[0][1]; s10 = roC[1][0]; s11 = roC[1][1]; }
            if (last && has_next) S.a_ready(nxt);
            if constexpr (Epi::MIDK > 0) { if (t == Epi::MIDK) E.mid(acc, cur, wr, wc, fr, fq); }
            PG8_LDB(B0, 0, 0); PG8_LDB(B1, 0, 1); PG8_SCHED; PG8_LDA(At, 0, 0); PG8_STAGE2(PG8_SA(1, 1), a1, roC[1][0], roC[1][1]);
            PG8_WAIT_V(8); PG8_WAIT_L(0); PG8_BAR; PG8_MMA(0, 0, At, B0); PG8_MMA(0, 1, At, B1); PG8_BAR; PG8_SCHED;
            PG8_LDA(At, 0, 1); PG8_STAGEB(PG8_SB(0, 0), b2); PG8_STAGEB(PG8_SB(0, 1), b2 + hstep); PG8_STAGE2(PG8_SA(0, 0), a2, s00, s01);
            PG8_WAIT_V(8); PG8_WAIT_L(0); PG8_BAR; PG8_MMA(1, 0, At, B0); PG8_MMA(1, 1, At, B1); PG8_BAR; PG8_SCHED;
            PG8_LDB(B0, 1, 0); PG8_LDB(B1, 1, 1); PG8_SCHED; PG8_LDA(At, 1, 0); PG8_STAGE2(PG8_SA(0, 1), a2, s10, s11);
            PG8_WAIT_V(8); PG8_WAIT_L(0); PG8_BAR; PG8_MMA(0, 0, At, B0); PG8_MMA(0, 1, At, B1); PG8_BAR; PG8_SCHED;
            PG8_LDA(At, 1, 1); PG8_STAGEB(PG8_SB(1, 0), b3); PG8_STAGEB(PG8_SB(1, 1), b3 + hstep); PG8_STAGE2(PG8_SA(1, 0), a3, s00, s01);
            PG8_WAIT_V(8); PG8_WAIT_L(0); PG8_BAR; PG8_MMA(1, 0, At, B0); PG8_MMA(1, 1, At, B1); PG8_BAR; PG8_SCHED;
        }
        if constexpr (ALIGN_EPI) { if (wr == 0) PG8_BAR; }
        E(acc, cur, wr, wc, fr, fq); S.done(cur);
        if (!has_next) break;
#pragma unroll
        for (int a = 0; a < 2; ++a)
#pragma unroll
            for (int b = 0; b < 2; ++b)
#pragma unroll
                for (int m = 0; m < 4; ++m)
#pragma unroll
                    for (int n = 0; n < 2; ++n) acc[a][b][m][n] = (f32x4){0.f, 0.f, 0.f, 0.f};
        cur = nxt; cA = nA; cB = nB; ++ui;
        if constexpr (GATHER) {
#pragma unroll
            for (int h = 0; h < 2; ++h)
#pragma unroll
                for (int i = 0; i < 2; ++i) roC[h][i] = roN[h][i];
        }
        if constexpr (ALIGN_EPI) { if (wr == 1) PG8_BAR; }
    }
    PG8_WAIT_V(0);
    if constexpr (!ALIGN_EPI) { if (wr == 0) PG8_BAR; }
    PG8_BAR;
#undef PG8_SA
#undef PG8_SB
#undef PG8_STAGE2
#undef PG8_STAGEB
#undef PG8_LDA
#undef PG8_LDB
#undef PG8_MMA
#undef PG8_WAIT_V
#undef PG8_WAIT_L
#undef PG8_BAR
#undef PG8_SCHED
}
}
namespace attn2 {
using bf16=__hip_bfloat16;
using bf16x8=__attribute__((ext_vector_type(8)))short;
using s16x4=__attribute__((ext_vector_type(4)))short;
using f32x16=__attribute__((ext_vector_type(16)))float;
using u32x4=__attribute__((ext_vector_type(4)))unsigned;
constexpr int BATCH=8,NHEAD=16,SEQ=4352,D=64,DM=NHEAD*D;
constexpr int NW=8,QBLK=32,QB=QBLK*NW,KVBLK=64,NQB=SEQ/QB;
constexpr int ATTN_PITCH=DM, ATTN_UNIT_ROWS=QB;
__device__ __forceinline__ int crow(int r,int hi){return (r&3)+8*(r>>2)+4*hi;}
#define SBAR() __builtin_amdgcn_sched_barrier(0)
__device__ __forceinline__ void cmask(f32x16&p0,f32x16&p1,int jb,int qrel,int hi){
  const float NEG=-INFINITY; int kb=64*jb+4*hi;
  #pragma unroll
  for(int r=0;r<16;++r){int kv=kb+(r&3)+8*(r>>2); if(kv>qrel)p0[r]=NEG; if(kv+32>qrel)p1[r]=NEG;}
}

constexpr int NSLOT=3, SLOTB=8192, QPW=4608;
constexpr int LDS_K=0, LDS_V=NSLOT*SLOTB, LDS_WS=3*NSLOT*SLOTB, LDS_QP=LDS_WS+NW*64*4, LDS_BYTES=LDS_QP+NW*QPW;
constexpr float C2=0.125f*1.4426950408889634f;
__device__ __forceinline__ void glds16(const void*gsrc,unsigned lds_dst){unsigned keep;
  asm volatile("s_mov_b32 %0, m0\n\ts_mov_b32 m0, %2\n\ts_nop 0\n\tglobal_load_lds_dwordx4 %1, off\n\ts_mov_b32 m0, %0":"=&s"(keep):"v"(gsrc),"s"(lds_dst):"memory");}
__device__ __forceinline__ float max3f(float a,float b,float c){float r;asm("v_max3_f32 %0, %1, %2, %3":"=v"(r):"v"(a),"v"(b),"v"(c));return r;}
__device__ __forceinline__ float max2f(float a,float b){float r;asm("v_max_f32_e32 %0, %1, %2":"=v"(r):"v"(a),"v"(b));return r;}
__device__ __forceinline__ float fadd_s(float a,float b){float r;asm("v_add_f32_e32 %0, %1, %2":"=v"(r):"v"(a),"v"(b));return r;}
__device__ __forceinline__ float fsub_s(float a,float b){float r;asm("v_sub_f32_e32 %0, %1, %2":"=v"(r):"v"(a),"v"(b));return r;}
typedef float f32x2_t __attribute__((ext_vector_type(2))); typedef __bf16 bf16x2_t __attribute__((ext_vector_type(2)));
__device__ __forceinline__ unsigned cvtpk_s(float lo,float hi){f32x2_t v={lo,hi};bf16x2_t b=__builtin_convertvector(v,bf16x2_t);return __builtin_bit_cast(unsigned,b);}
#define WAIT_BAR(N) asm volatile("s_waitcnt vmcnt(" #N ") lgkmcnt(0)\n\ts_barrier":::"memory")

__device__ __forceinline__ void qkt(f32x16&p0,f32x16&p1,const char*Kslot,const bf16x8*qr,int r32,int hi){ const f32x16 negm=f32x16{};
  const char*kb=Kslot+hi*1024+r32*16;
  #pragma unroll
  for(int d0=0;d0<4;++d0){
    const bf16x8 b0=*reinterpret_cast<const bf16x8*>(kb+d0*2048);
    const bf16x8 b1=*reinterpret_cast<const bf16x8*>(kb+d0*2048+512);
    if(d0==0){p0=__builtin_amdgcn_mfma_f32_32x32x16_bf16(b0,qr[0],negm,0,0,0);p1=__builtin_amdgcn_mfma_f32_32x32x16_bf16(b1,qr[0],negm,0,0,0);}
    else{p0=__builtin_amdgcn_mfma_f32_32x32x16_bf16(b0,qr[d0],p0,0,0,0);p1=__builtin_amdgcn_mfma_f32_32x32x16_bf16(b1,qr[d0],p1,0,0,0);}}
}
typedef __attribute__((address_space(3))) const char* lds_cptr;
typedef short v4i16_t __attribute__((ext_vector_type(4)));
__device__ __forceinline__ void kload8(bf16x8*kf,lds_cptr kp){
  kf[0]=*(const __attribute__((address_space(3))) bf16x8*)(kp);      kf[1]=*(const __attribute__((address_space(3))) bf16x8*)(kp+512);
  kf[2]=*(const __attribute__((address_space(3))) bf16x8*)(kp+2048); kf[3]=*(const __attribute__((address_space(3))) bf16x8*)(kp+2560);
  kf[4]=*(const __attribute__((address_space(3))) bf16x8*)(kp+4096); kf[5]=*(const __attribute__((address_space(3))) bf16x8*)(kp+4608);
  kf[6]=*(const __attribute__((address_space(3))) bf16x8*)(kp+6144); kf[7]=*(const __attribute__((address_space(3))) bf16x8*)(kp+6656);
}
__device__ __forceinline__ void kload2(bf16x8*kf,lds_cptr kp,int j){ kf[2*j]=*(const __attribute__((address_space(3))) bf16x8*)(kp+j*2048); kf[2*j+1]=*(const __attribute__((address_space(3))) bf16x8*)(kp+j*2048+512); }
__device__ __forceinline__ s16x4 vtr(lds_cptr p){ return __builtin_bit_cast(s16x4,__builtin_amdgcn_ds_read_tr16_b64_v4i16((__attribute__((address_space(3))) v4i16_t*)p)); }
__device__ __forceinline__ float rowmax(const f32x16&p0,const f32x16&p1){
  float a=max3f(p0[0],p0[1],p1[0]),b=max3f(p0[2],p0[3],p1[1]);a=max3f(a,p1[2],p1[3]);
  #pragma unroll
  for(int r=4;r<16;r+=4){a=max3f(a,p0[r],p0[r+1]);b=max3f(b,p0[r+2],p0[r+3]);a=max3f(a,p1[r],p1[r+1]);b=max3f(b,p1[r+2],p1[r+3]);}
  const float m=max2f(a,b);
  auto rr=__builtin_amdgcn_permlane32_swap(__float_as_uint(m),__float_as_uint(m),false,false);
  return max2f(__uint_as_float(rr[0]),__uint_as_float(rr[1]));
}
__device__ __forceinline__ void pv(f32x16*o,int vb,bf16x8 pa0,bf16x8 pa1,bf16x8 pa2,bf16x8 pa3){
  #pragma unroll
  for(int d0=0;d0<4;++d0){s16x4 lo[4],hi[4];
    #pragma unroll
    for(int ks=0;ks<4;++ks){
      asm volatile("ds_read_b64_tr_b16 %0,%1 offset:%c2":"=&v"(lo[ks]):"v"(vb),"i"(d0*4096+ks*1024):"memory");
      asm volatile("ds_read_b64_tr_b16 %0,%1 offset:%c2":"=&v"(hi[ks]):"v"(vb),"i"(d0*4096+ks*1024+512):"memory");}
    asm volatile("s_waitcnt lgkmcnt(0)":::"memory");SBAR();
    #define PK(k) (bf16x8){lo[k][0],lo[k][1],lo[k][2],lo[k][3],hi[k][0],hi[k][1],hi[k][2],hi[k][3]}
    o[d0]=__builtin_amdgcn_mfma_f32_32x32x16_bf16(pa0,PK(0),o[d0],0,0,0);
    o[d0]=__builtin_amdgcn_mfma_f32_32x32x16_bf16(pa1,PK(1),o[d0],0,0,0);
    o[d0]=__builtin_amdgcn_mfma_f32_32x32x16_bf16(pa2,PK(2),o[d0],0,0,0);
    o[d0]=__builtin_amdgcn_mfma_f32_32x32x16_bf16(pa3,PK(3),o[d0],0,0,0);
    #undef PK
  }
}

#ifndef ATTN_STORE16
#define ATTN_STORE16(p,v) (*(u32x4*)(p)=(v))
#endif
template<int THRL> __device__ __forceinline__ void attn_unit(int b,int h,int hv,int qb,const bf16*Q,const bf16*__restrict__ K,const bf16*__restrict__ V,bf16*O,char*shm){
  const int tid=threadIdx.x,lane=tid&63,r32=lane&31,hi=lane>>5; const int wid=__builtin_amdgcn_readfirstlane(tid>>6);
  const long rowbase=(long)b*SEQ; const int q0=qb*QB;
  const bf16*Qw=Q+(rowbase+q0+wid*QBLK)*DM+h*D;
  const bf16*Kh=K+rowbase*DM+h*D,*Vh=V+rowbase*DM+hv*128;
  const unsigned lds0=(unsigned)(uintptr_t)shm;
  float*wsf=(float*)(shm+LDS_WS)+wid*64;
  const bf16*ksrc=Kh+(long)lane*DM+wid*8;
  const bf16*vsrc=Vh+(long)(16*(wid&3)+(lane>>2))*DM+(wid>>2)*32+(lane&3)*8;
  const unsigned kdst=lds0+LDS_K+wid*1024, vdst=lds0+LDS_V+wid*1024;
  #define DMA_K(t,slot) glds16(ksrc+(long)(t)*KVBLK*DM,(unsigned)__builtin_amdgcn_readfirstlane(kdst+(slot)))
  #define DMA_V(t,slot) do{ glds16(vsrc+(long)(t)*KVBLK*DM,(unsigned)__builtin_amdgcn_readfirstlane(vdst+2*(slot))); glds16(vsrc+64+(long)(t)*KVBLK*DM,(unsigned)__builtin_amdgcn_readfirstlane(vdst+2*(slot)+8192)); }while(0)
  const int vb0=(int)(lds0+LDS_V)+((lane>>4)&1)*32+(lane&3)*8+(4*hi+((lane&15)>>2))*64;
  const char*Kbase=shm+LDS_K; bf16x8 kf[8];
  const lds_cptr shm3=(lds_cptr)shm; const lds_cptr kp0=shm3+LDS_K+hi*1024+r32*16; const lds_cptr vp0=shm3+LDS_V+((lane>>4)&1)*32+(lane&3)*8+(4*hi+((lane&15)>>2))*64;
  const int NT=(q0+QB)/KVBLK;
  DMA_K(0,0);DMA_V(0,0);DMA_K(1,SLOTB);
  typedef __attribute__((address_space(3))) bf16x8* lds_q8; const lds_q8 qpl=(lds_q8)((__attribute__((address_space(3))) char*)shm3+LDS_QP+wid*QPW+r32*144+hi*16);
  { bf16x8 qr[4];
  #pragma unroll
  for(int d0=0;d0<4;++d0)qr[d0]=*reinterpret_cast<const bf16x8*>(&Qw[(long)r32*DM+d0*16+hi*8]);
  #pragma unroll
  for(int d0=0;d0<4;++d0)qpl[2*d0]=qr[d0]; }
  float mhat=0.f,l_reg=0.f;f32x16 o[4];o[0]=f32x16{};o[1]=f32x16{};o[2]=f32x16{};o[3]=f32x16{};
  const int qrel=wid*QBLK+r32;
  #define CMASK(P0,P1,t) do{int jb_=(t)-(NT-4); if(jb_>=0)cmask(P0,P1,jb_,qrel,hi);}while(0)
  bool resc=false;
  #define START(P0,P1) do{ const float rm=rowmax(P0,P1); resc=false; mhat=rm; \
    _Pragma("unroll") for(int r=0;r<16;++r)P0[r]=__builtin_amdgcn_exp2f(P0[r]-mhat); }while(0)
  #define RESC() do{ if(resc){ asm volatile("s_waitcnt lgkmcnt(0)":::"memory"); \
      _Pragma("unroll") for(int d_=0;d_<4;++d_) _Pragma("unroll") for(int r=0;r<16;++r)o[d_][r]*=wsf[crow(r,hi)]; } }while(0)
  f32x16 pA0,pA1,pB0,pB1;
  int sl_prev=0,sl_cur=0,sl_next=SLOTB;
  #define ROT() do{sl_prev=sl_cur;sl_cur=sl_next;sl_next=(sl_next==(NSLOT-1)*SLOTB)?0:sl_next+SLOTB;}while(0)
  DMA_K(2,2*SLOTB);
  WAIT_BAR(4);
  { bf16x8 qf[4]; _Pragma("unroll") for(int d0=0;d0<4;++d0)qf[d0]=qpl[2*d0]; qkt(pA0,pA1,Kbase,qf,r32,hi); } asm volatile("s_nop 15\n\ts_nop 7":"+v"(pA0),"+v"(pA1));CMASK(pA0,pA1,0);
  START(pA0,pA1);
  _Pragma("unroll") for(int r=0;r<16;++r)pA1[r]=__builtin_amdgcn_exp2f(pA1[r]-mhat);
  WAIT_BAR(0);
  DMA_K(3,0);DMA_V(1,SLOTB);
  ROT();
  kload8(kf,kp0+sl_cur);
  WAIT_BAR(3);
  s16x4 vlo[8],vhi[8],wlo[8],whi[8]; u32x4 pw0,pw1,pw2,pw3; const f32x16 zero16=f32x16{};
  #define PKW(P,B) cvtpk_s(P[B],P[B+1])
  #define PAF(k) __builtin_bit_cast(bf16x8,pw##k)
  #define VFR(i) (bf16x8){vlo[i][0],vlo[i][1],vlo[i][2],vlo[i][3],vhi[i][0],vhi[i][1],vhi[i][2],vhi[i][3]}
  #define PIN(x) asm volatile("":"+v"(x))
  #define MX3(a,b,c) __builtin_fmaxf(__builtin_fmaxf((a),(b)),(c))
  #define GAPA(MF,A0,A1,A2,A3,W0,W1,PW) do{ MF; sacc+=A0; sacc+=A1; sacc+=A2; sacc+=A3; PIN(sacc); W0; W1; PIN(PW); SBAR(); }while(0)
  #define EX(v) __builtin_amdgcn_exp2f(v)
  #define EXM(v) __builtin_amdgcn_exp2f((v)-mhat)
  #define GAPB2(MF,X,B) do{ MF; X[B]=EXM(X[B]); X[B+1]=EXM(X[B+1]); PIN(X); SBAR(); }while(0)
  #define VRD2(i) do{ wlo[i]=vtr(vp_+((((i)>>2)+2)*4096+((i)&3)*1024)); whi[i]=vtr(vp_+((((i)>>2)+2)*4096+((i)&3)*1024+512)); }while(0)
  #define WFR(i) (bf16x8){wlo[i][0],wlo[i][1],wlo[i][2],wlo[i][3],whi[i][0],whi[i][1],whi[i][2],whi[i][3]}
  #define VRD(i) do{ vlo[i]=vtr(vp_+(((i)>>2)*4096+((i)&3)*1024)); vhi[i]=vtr(vp_+(((i)>>2)*4096+((i)&3)*1024+512)); }while(0)
  #define KRD(G,j) do{ if(G){ kload2(kf,kp0+sl_next,j); SBAR(); } }while(0)
  #define STEP(C0,C1,P0,P1,t,GK,GV,GL) do{ SBAR(); \
    const lds_cptr vp_=vp0+2*sl_prev; const bf16x8 qf0=qpl[0],qf1=qpl[2],qf2=qpl[4],qf3=qpl[6]; \
    VRD(0); SBAR(); float sacc=(P0[0]+P0[1]); \
    GAPA(C0=__builtin_amdgcn_mfma_f32_32x32x16_bf16(kf[0],qf0,zero16,0,0,0), P0[2],P0[3],P0[4],P0[5],     pw0[0]=PKW(P0,0), pw0[1]=PKW(P0,2), pw0); \
    VRD(4); SBAR(); GAPA(C1=__builtin_amdgcn_mfma_f32_32x32x16_bf16(kf[1],qf0,zero16,0,0,0), P0[6],P0[7],P0[8],P0[9],     pw0[2]=PKW(P0,4), pw0[3]=PKW(P0,6), pw0); \
    VRD(1); SBAR(); GAPA(C0=__builtin_amdgcn_mfma_f32_32x32x16_bf16(kf[2],qf1,C0,0,0,0),   P0[10],P0[11],P0[12],P0[13], pw1[0]=PKW(P0,8), pw1[1]=PKW(P0,10), pw1); \
    VRD(5); SBAR(); GAPA(C1=__builtin_amdgcn_mfma_f32_32x32x16_bf16(kf[3],qf1,C1,0,0,0),   P0[14],P0[15],P1[0],P1[1],   pw1[2]=PKW(P0,12),pw1[3]=PKW(P0,14), pw1); \
    VRD(2); SBAR(); GAPA(C0=__builtin_amdgcn_mfma_f32_32x32x16_bf16(kf[4],qf2,C0,0,0,0),   P1[2],P1[3],P1[4],P1[5],     pw2[0]=PKW(P1,0), pw2[1]=PKW(P1,2), pw2); \
    VRD(6); SBAR(); GAPA(C1=__builtin_amdgcn_mfma_f32_32x32x16_bf16(kf[5],qf2,C1,0,0,0),   P1[6],P1[7],P1[8],P1[9],     pw2[2]=PKW(P1,4), pw2[3]=PKW(P1,6), pw2); \
    VRD(3); SBAR(); GAPA(C0=__builtin_amdgcn_mfma_f32_32x32x16_bf16(kf[6],qf3,C0,0,0,0),   P1[10],P1[11],P1[12],P1[13], pw3[0]=PKW(P1,8), pw3[1]=PKW(P1,10), pw3); \
    VRD(7); SBAR(); GAPA(C1=__builtin_amdgcn_mfma_f32_32x32x16_bf16(kf[7],qf3,C1,0,0,0),   P1[14],P1[15],0.f,0.f,       pw3[2]=PKW(P1,12),pw3[3]=PKW(P1,14), pw3); \
    l_reg+=sacc; \
    if(GK){DMA_K((t)+3,sl_cur);} if(GV){DMA_V((t)+1,sl_next);} \
    CMASK(C0,C1,t); \
    { float a=MX3(C0[0],C0[1],C1[0]),b=MX3(C0[2],C0[3],C1[1]); a=MX3(a,C1[2],C1[3]); \
      _Pragma("unroll") for(int r=4;r<16;r+=4){a=MX3(a,C0[r],C0[r+1]);b=MX3(b,C0[r+2],C0[r+3]);a=MX3(a,C1[r],C1[r+1]);b=MX3(b,C1[r+2],C1[r+3]);} \
      float rm=__builtin_fmaxf(a,b); { auto rr=__builtin_amdgcn_permlane32_swap(__float_as_uint(rm),__float_as_uint(rm),false,false); rm=__builtin_fmaxf(__uint_as_float(rr[0]),__uint_as_float(rr[1])); } \
      rm-=mhat; resc=false; \
      if(__builtin_expect(__any(rm>(float)THRL),0)){ const float dl=__builtin_fmaxf(rm,0.f); mhat+=dl; \
        const float f=__builtin_amdgcn_exp2f(-dl); l_reg*=f; if(hi==0)wsf[r32]=f; resc=true; } } \
    SBAR(); \
    VRD2(0); SBAR(); GAPB2(o[0]=__builtin_amdgcn_mfma_f32_32x32x16_bf16(PAF(0),VFR(0),o[0],0,0,0), C0,0); \
    VRD2(4); SBAR(); GAPB2(o[1]=__builtin_amdgcn_mfma_f32_32x32x16_bf16(PAF(0),VFR(4),o[1],0,0,0), C0,2); \
    KRD(GL,0); VRD2(1); SBAR(); GAPB2(o[0]=__builtin_amdgcn_mfma_f32_32x32x16_bf16(PAF(1),VFR(1),o[0],0,0,0), C0,4); \
    KRD(GL,1); VRD2(5); SBAR(); GAPB2(o[1]=__builtin_amdgcn_mfma_f32_32x32x16_bf16(PAF(1),VFR(5),o[1],0,0,0), C0,6); \
    KRD(GL,2); VRD2(2); SBAR(); GAPB2(o[0]=__builtin_amdgcn_mfma_f32_32x32x16_bf16(PAF(2),VFR(2),o[0],0,0,0), C0,8); \
    KRD(GL,3); VRD2(6); SBAR(); GAPB2(o[1]=__builtin_amdgcn_mfma_f32_32x32x16_bf16(PAF(2),VFR(6),o[1],0,0,0), C0,10); \
    VRD2(3); SBAR(); GAPB2(o[0]=__builtin_amdgcn_mfma_f32_32x32x16_bf16(PAF(3),VFR(3),o[0],0,0,0), C0,12); \
    VRD2(7); SBAR(); GAPB2(o[1]=__builtin_amdgcn_mfma_f32_32x32x16_bf16(PAF(3),VFR(7),o[1],0,0,0), C0,14); \
    GAPB2(o[2]=__builtin_amdgcn_mfma_f32_32x32x16_bf16(PAF(0),WFR(0),o[2],0,0,0), C1,0); \
    GAPB2(o[3]=__builtin_amdgcn_mfma_f32_32x32x16_bf16(PAF(0),WFR(4),o[3],0,0,0), C1,2); \
    GAPB2(o[2]=__builtin_amdgcn_mfma_f32_32x32x16_bf16(PAF(1),WFR(1),o[2],0,0,0), C1,4); \
    GAPB2(o[3]=__builtin_amdgcn_mfma_f32_32x32x16_bf16(PAF(1),WFR(5),o[3],0,0,0), C1,6); \
    GAPB2(o[2]=__builtin_amdgcn_mfma_f32_32x32x16_bf16(PAF(2),WFR(2),o[2],0,0,0), C1,8); \
    GAPB2(o[3]=__builtin_amdgcn_mfma_f32_32x32x16_bf16(PAF(2),WFR(6),o[3],0,0,0), C1,10); \
    GAPB2(o[2]=__builtin_amdgcn_mfma_f32_32x32x16_bf16(PAF(3),WFR(3),o[2],0,0,0), C1,12); \
    GAPB2(o[3]=__builtin_amdgcn_mfma_f32_32x32x16_bf16(PAF(3),WFR(7),o[3],0,0,0), C1,14); \
    }while(0)
  int t=1;
  #undef CMASK
  #define CMASK(P0,P1,t) do{}while(0)
  for(;t+5<NT;t+=2){
    STEP(pB0,pB1,pA0,pA1,t,true,true,true);     WAIT_BAR(3); RESC(); ROT();
    STEP(pA0,pA1,pB0,pB1,t+1,true,true,true);   WAIT_BAR(3); RESC(); ROT();
  }
  #undef CMASK
  #define CMASK(P0,P1,t) do{int jb_=(t)-(NT-4); if(jb_>=0)cmask(P0,P1,jb_,qrel,hi);}while(0)
  #define ENDW(tt) do{ if((tt)+3<NT){WAIT_BAR(3);} else if((tt)+2<NT){WAIT_BAR(2);} else {WAIT_BAR(0);} }while(0)
  for(;t+1<NT;t+=2){
    STEP(pB0,pB1,pA0,pA1,t,(t+3<NT),(t+1<NT),(t+1<NT));       ENDW(t);   RESC(); ROT();
    STEP(pA0,pA1,pB0,pB1,t+1,(t+4<NT),(t+2<NT),(t+2<NT));     ENDW(t+1); RESC(); ROT();
  }
  STEP(pB0,pB1,pA0,pA1,NT-1,false,false,false); RESC();
  { float sacc=pB0[0]+pB0[1]; _Pragma("unroll") for(int r=2;r<16;++r)sacc+=pB0[r]; _Pragma("unroll") for(int r=0;r<16;++r)sacc+=pB1[r]; l_reg+=sacc;
    pw0=(u32x4){PKW(pB0,0),PKW(pB0,2),PKW(pB0,4),PKW(pB0,6)};pw1=(u32x4){PKW(pB0,8),PKW(pB0,10),PKW(pB0,12),PKW(pB0,14)};pw2=(u32x4){PKW(pB1,0),PKW(pB1,2),PKW(pB1,4),PKW(pB1,6)};pw3=(u32x4){PKW(pB1,8),PKW(pB1,10),PKW(pB1,12),PKW(pB1,14)};
    SBAR(); pv(o,vb0+2*sl_cur,PAF(0),PAF(1),PAF(2),PAF(3)); }
  #undef PKW
  #undef PAF
  #undef VFR
  #undef PIN
  #undef MX3
  #undef GAPA
  #undef GAPB2
  #undef EXM
  #undef VRD2
  #undef WFR
  #undef EX
  #undef VRD
  #undef KRD
  #undef STEP
  #undef ENDW
  {auto rr=__builtin_amdgcn_permlane32_swap(__float_as_uint(l_reg),__float_as_uint(l_reg),false,false);l_reg=__uint_as_float(rr[0])+__uint_as_float(rr[1]);}
  if(hi==0)wsf[32+r32]=l_reg;asm volatile("s_waitcnt lgkmcnt(0)":::"memory");
  float rli[16];
  #pragma unroll
  for(int r=0;r<16;++r)rli[r]=__builtin_amdgcn_rcpf(wsf[32+crow(r,hi)]);
  bf16*Ow=O+(rowbase+q0+wid*QBLK)*DM+hv*128;
  asm volatile("s_waitcnt lgkmcnt(0)\n\ts_barrier":::"memory");
  { bf16*stg=(bf16*)(shm)+wid*4096;
    int r32e=(int)(threadIdx.x&31u); asm volatile("":"+v"(r32e));
    #pragma unroll
    for(int r=0;r<16;++r){const int orow=crow(r,hi);
      #pragma unroll
      for(int d0=0;d0<4;++d0)stg[orow*128+d0*32+r32e]=__float2bfloat16(o[d0][r]*rli[r]);}
    asm volatile("s_waitcnt lgkmcnt(0)":::"memory");
    #pragma unroll
    for(int i=0;i<8;++i){const int row=i*4+(lane>>4),ch=lane&15; const u32x4 v=*(const u32x4*)(stg+row*128+ch*8); ATTN_STORE16(Ow+(long)row*DM+ch*8,v);} }
  asm volatile("s_waitcnt lgkmcnt(0)\n\ts_barrier":::"memory");
  #undef DMA_K
  #undef DMA_V
  #undef CMASK
  #undef START
  #undef RESC
  #undef ROT
}
constexpr int ATTN_LDS_BYTES=LDS_BYTES;
struct AttnTensors { const bf16* Q; const bf16* K; const bf16* V; bf16* O; };
struct AttnUnit { int b; int hq; int hv; int qb; };
struct SplitOrder {
  int b, hq, hv, part;
  __device__ __forceinline__ bool next(int i,AttnUnit&u)const{ if(i>=9-part)return false; u.b=b; u.hq=hq; u.hv=hv; u.qb=16-2*i-((i&1)^part); return true; }
};
template<class Sched,int THRL=8> __device__ __forceinline__ void attn_phase(char*lds,const AttnTensors&T,const Sched&S){
  AttnUnit u;
  for(int i=0;S.next(i,u);++i){ attn_unit<THRL>(u.b,u.hq,u.hv,u.qb,T.Q,T.K,T.V,T.O,lds); }
}
#undef SBAR
#undef WAIT_BAR
}

constexpr int NWAVES = 8;
#ifndef MK_N_LAUNCHES
#define MK_N_LAUNCHES 1
#endif
#ifndef MK_DIAG
#define MK_DIAG 0
#endif
constexpr int NPHASE = 14;
constexpr int N_LAUNCHES = MK_N_LAUNCHES;

constexpr int NB = 8, SEQ = 4096, NMETA = 16, TV = NMETA + SEQ, TA = 4352, MA = NB * TA, D = 1024;
constexpr int NIN = 7168, NE = 256, TOPK = 8, DE = 256;
constexpr int NCHUNK = 33;
constexpr float LN_EPS = 1e-5f, ALPHA = 1.189207115002721f;
constexpr float ROUTED_SCALE = 2.5f, LAMBDA_INIT = 0.2f, YSCALE = 16.0f;
constexpr int CAP = 32768;
constexpr int NVALID = NB * SEQ;
constexpr int YSHARED = NVALID * TOPK, YDUMMY = NVALID * (TOPK + 1);

constexpr size_t MiB = 1u << 20;
constexpr size_t SLOTB = 68 * MiB;
static_assert((size_t)MA * D * 2 == SLOTB, "slot size");
constexpr size_t WS_CTL = 0, CTL_ZERO_BYTES = 1 * MiB;
constexpr size_t WS_ROWSTAT = 1 * MiB;
constexpr size_t WS_SCANSUM = 1 * MiB + 320 * 1024;
constexpr size_t WS_LRUWT = 4 * MiB - 512 * 1024;
constexpr size_t WS_S0 = 26 * MiB;
#define WS_SLOT(i) (WS_S0 + (size_t)(i) * SLOTB)
constexpr size_t WS_XN = WS_SLOT(0), WS_XR = WS_SLOT(1), WS_YG = WS_SLOT(2), WS_Q = WS_SLOT(3), WS_K = WS_SLOT(4), WS_V = WS_SLOT(5), WS_GR = WS_SLOT(6), WS_GA = WS_SLOT(7),
                 WS_RA = WS_SLOT(8)  , WS_O0 = WS_SLOT(10), WS_O1 = WS_SLOT(11);
constexpr size_t WS_T1 = WS_SLOT(0), WS_U = WS_SLOT(1), WS_Z = WS_SLOT(2)  , WS_LOGITS = WS_SLOT(5);
constexpr size_t WS_LIST = 262 * MiB;
constexpr size_t WS_WGU = 4 * MiB;
constexpr size_t WS_WD = 596 * MiB;
constexpr size_t WS_ACT = 725 * MiB;
constexpr size_t WS_H1B = 905 * MiB;
constexpr size_t WS_TOKSLOT = 973 * MiB;
constexpr size_t WS_TOKW = 975 * MiB + 256 * 1024;
constexpr size_t WS_WIN = 978 * MiB, WS_WR = 992 * MiB, WS_WA = 994 * MiB, WS_WO = 996 * MiB, WS_WROUT = 998 * MiB;
constexpr size_t WS_Y = 4 * MiB;
constexpr size_t WS_END = 1000 * MiB;
constexpr int MAXTILES = 1408;
static_assert(WS_Y + ((size_t)NVALID * 9 + 1) * D * 2 <= WS_WD && WS_WD + (size_t)257 * 1024 * 256 * 2 <= WS_ACT && WS_ACT + (size_t)MAXTILES * 256 * 256 * 2 <= WS_H1B, "moe map");
static_assert(WS_WGU + (size_t)257 * 512 * 1024 * 2 <= WS_LIST && WS_LIST + (size_t)NE * CAP * 4 <= WS_SLOT(4), "moe map 2");
static_assert(WS_SLOT(12) <= WS_H1B && WS_TOKW + (size_t)MA * 16 * 4 <= WS_WIN, "map 3");
constexpr int CW_TMO = 0, CW_CODE = 1;
constexpr int CW_BAR = 4096;
constexpr int CW_CNT = 16384;
constexpr int CW_DIAG = 20480;

constexpr int RING_OFF = 0, RING_BYTES = 131072;
constexpr int LDSCTL_OFF = RING_BYTES, MISC_OFF = LDSCTL_OFF + 320;
constexpr int TT_OFF = LDSCTL_OFF + 1024;
constexpr int UB_OFF = TT_OFF + MAXTILES * 4;
constexpr int LDS_BYTES = 147456;
constexpr int CN_OFF = UB_OFF + 260 * 4, TB_OFF = CN_OFF + 260 * 4;
static_assert(TB_OFF + 260 * 4 <= LDS_BYTES, "LDS map");

#define GAS __attribute__((address_space(1)))
#define LAS __attribute__((address_space(3)))
typedef unsigned short bf16;
typedef unsigned v4u __attribute__((ext_vector_type(4)));
typedef float f32x4 __attribute__((ext_vector_type(4)));
typedef short bf16x8 __attribute__((ext_vector_type(8)));
typedef GAS unsigned gu32;
typedef GAS unsigned long long gu64;
#define RLX_AGENT __ATOMIC_RELAXED, __HIP_MEMORY_SCOPE_AGENT
#define LDS_WAIT() asm volatile("s_waitcnt lgkmcnt(0)" ::: "memory")
#define VM_WAIT() asm volatile("s_waitcnt vmcnt(0)" ::: "memory")
__device__ __forceinline__ unsigned long long rt() { return __builtin_amdgcn_s_memrealtime(); }
__device__ __forceinline__ unsigned f2bf(float f) { unsigned u = __builtin_bit_cast(unsigned, f); return (u + 0x7fffu + ((u >> 16) & 1u)) >> 16; }
__device__ __forceinline__ unsigned pk2(float lo, float hi) { return f2bf(lo) | (f2bf(hi) << 16); }

#define XB_TMO      128
#define XB_XCNT(j)  (256  + 64 * (j))
#define XB_XSUB(j)  (1280 + 64 * (j))
#define XB_XGEN(j)  (2304 + 64 * (j))
#define XB_TOP      3328
#define XB_TOPGEN   3392
#define XCD_BAR_WORDS 3456
#define XB_SPIN_CAP (1u << 18)

__device__ __forceinline__ unsigned xb_ld(unsigned* p)              { return __hip_atomic_load(p, __ATOMIC_RELAXED, __HIP_MEMORY_SCOPE_AGENT); }
__device__ __forceinline__ unsigned xb_add(unsigned* p, unsigned v) { return __hip_atomic_fetch_add(p, v, __ATOMIC_RELAXED, __HIP_MEMORY_SCOPE_AGENT); }
__device__ __forceinline__ unsigned xb_xcc_id() { return (unsigned)__builtin_amdgcn_s_getreg((3 << 11) | 20) & 0xFu; }
#define XB_SPIN(cond, bar) do { unsigned _sp = 0; while (cond) { __builtin_amdgcn_s_sleep(1); \
    if ((++_sp & 255u) == 0u) { if (xb_ld(&(bar)[XB_TMO])) break; if (_sp > XB_SPIN_CAP) { atomicAdd(&(bar)[XB_TMO], 1u); break; } } } } while (0)

struct XcdBarrier {
    unsigned* bar; unsigned x;
    volatile LAS unsigned* st;
};

__device__ __forceinline__ XcdBarrier xcd_barrier_post(unsigned* bar, volatile LAS unsigned* st) {
    XcdBarrier b; b.bar = bar; b.x = xb_xcc_id(); b.st = st;
    if (threadIdx.x == 0) (void)xb_add(&bar[XB_XCNT(b.x)], 1u);
    return b;
}
__device__ __forceinline__ void xcd_barrier_complete(unsigned* bar, unsigned x, unsigned& nloc, unsigned& nx) {
    const unsigned G = gridDim.x * gridDim.y * gridDim.z;
    unsigned sum, cnt, mine, sp = 0u;
    for (;;) {
        sum = 0u; cnt = 0u; mine = 0u;
#pragma unroll
        for (unsigned j = 0; j < 16; ++j) { const unsigned c = xb_ld(&bar[XB_XCNT(j)]); sum += c; cnt += (c > 0u) ? 1u : 0u; mine = (j == x) ? c : mine; }
        if (sum == G) break;
        __builtin_amdgcn_s_sleep(1);
        if ((++sp & 255u) == 0u) { if (xb_ld(&bar[XB_TMO])) break; if (sp > XB_SPIN_CAP) { atomicAdd(&bar[XB_TMO], 1u); break; } }
    }
    nloc = mine > 0u ? mine : 1u; nx = cnt > 0u ? cnt : 1u;
}

__device__ __forceinline__ void xcd_barrier(const XcdBarrier& b) {
    asm volatile("s_waitcnt vmcnt(0)" ::: "memory");
    __syncthreads();
    if (threadIdx.x == 0) {
        unsigned* bar = b.bar;
        __builtin_amdgcn_s_waitcnt(0);
        unsigned nloc = b.st[0], nx = b.st[1];
        if (nloc == 0u) { xcd_barrier_complete(bar, b.x, nloc, nx); b.st[0] = nloc; b.st[1] = nx; }
        const unsigned old = xb_add(&bar[XB_XSUB(b.x)], 1u);
        const unsigned gen = old / nloc;
        if (old + 1u == (gen + 1u) * nloc) {
            __builtin_amdgcn_fence(__ATOMIC_RELEASE, "agent");
            asm volatile("s_waitcnt vmcnt(0)" ::: "memory");
            const unsigned og = xb_add(&bar[XB_TOP], 1u);
            const unsigned tg = og / nx;
            if (og + 1u == (tg + 1u) * nx) xb_add(&bar[XB_TOPGEN], 1u);
            else XB_SPIN(xb_ld(&bar[XB_TOPGEN]) == tg, bar);
            __builtin_amdgcn_fence(__ATOMIC_ACQUIRE, "agent");
            xb_add(&bar[XB_XGEN(b.x)], 1u);
            asm volatile("s_waitcnt vmcnt(0)" ::: "memory");
        } else {
            XB_SPIN(xb_ld(&bar[XB_XGEN(b.x)]) == gen, bar);
            __builtin_amdgcn_fence(__ATOMIC_ACQUIRE, "agent");
            asm volatile("s_waitcnt vmcnt(0)" ::: "memory");
        }
    }
    __syncthreads();
}


__device__ __forceinline__ float wave_sum(float v) {
#pragma unroll
    for (int o = 1; o < 64; o <<= 1) v += __shfl_xor(v, o);
    return v;
}
__device__ __forceinline__ float bfl(unsigned w) { return __builtin_bit_cast(float, w << 16); }
__device__ __forceinline__ float bfh(unsigned w) { return __builtin_bit_cast(float, w & 0xffff0000u); }
__device__ __forceinline__ float bf1(bf16 h) { return __builtin_bit_cast(float, (unsigned)h << 16); }

struct DenseOrder {
    int nM, nN, nwg, G, c, valid;
    __device__ void init(int M, int N, int G_, int c_, int valid_ = 0) { nM = M / 256; nN = N / 256; nwg = nM * nN; G = G_; c = c_; valid = valid_; }
    __device__ bool next(int i, pg8::Unit& u) const {
        const long L = (long)i * G + c; if (L >= nwg) return false;
        int wgid = (int)L; { const int q = nwg / 8, r = nwg % 8, xcd = wgid % 8, off = wgid / 8; wgid = (xcd < r ? xcd * (q + 1) : r * (q + 1) + (xcd - r) * q) + off; }
        const int WGM = 8; const int nig = WGM * nN, gid = wgid / nig, fm = gid * WGM, gsz = (nM - fm) < WGM ? (nM - fm) : WGM;
        u.pm = fm + ((wgid % nig) % gsz); u.pn = (wgid % nig) / gsz; u.e = 0; u.mt = 0; u.nv = 256; u.aux = 0;
        u.ar = valid ? (u.pm >> 4) * TA + NMETA + (u.pm & 15) * 256 : u.pm * 256; return true;
    }
    __device__ __forceinline__ int row_of(const pg8::Unit&, int) const { return 0; }
    __device__ __forceinline__ void a_ready(const pg8::Unit&) const {}
    __device__ __forceinline__ void done(const pg8::Unit&) const {}
};
template <int NPN> struct MoeOrder {
    int ntiles, G, vcu; volatile LAS unsigned* TT; volatile LAS int* UB; volatile LAS int* CN; const int* list; int* tokslot; int write_slots;
    __device__ bool next(int i, pg8::Unit& u) const {
        const long L = (long)i * G + vcu; if (L >= (long)ntiles * NPN) return false;
        const int tile = (int)(L / NPN); u.pn = (int)(L % NPN); u.pm = tile;
        const unsigned tt = __builtin_amdgcn_readfirstlane(TT[tile]); u.e = (int)(tt & 0xffffu); u.mt = (int)(tt >> 16);
        const int ce = __builtin_amdgcn_readfirstlane(CN[u.e]);
        const int rem = ce - u.mt * 256; u.nv = rem < 256 ? rem : 256;
        u.aux = __builtin_amdgcn_readfirstlane(UB[u.e]) + u.mt * 256; u.ar = tile * 256; return true;
    }
    __device__ __forceinline__ int row_of(const pg8::Unit& u, int r) const {
        if (u.e == NE) return u.mt * 256 + r;
        return (r < u.nv) ? (list[(size_t)u.e * CAP + u.mt * 256 + r] >> 4) : 0;
    }
    __device__ __forceinline__ void a_ready(const pg8::Unit&) const {}
    __device__ __forceinline__ void done(const pg8::Unit& u) const {
        if (write_slots && u.pn == 0 && u.e < NE) { const int r = threadIdx.x; if (r < u.nv) { const int en = list[(size_t)u.e * CAP + u.mt * 256 + r]; tokslot[(size_t)(en >> 4) * 16 + (en & 15)] = u.aux + r; } }
    }
};

using pg8::u32x4;
typedef unsigned u32x2v __attribute__((ext_vector_type(2)));
typedef float f32x2v __attribute__((ext_vector_type(2)));
struct EpiIn {
    static constexpr bool PERM = true; static constexpr int MIDK = 0;
    bf16* base0; const float* b_gate; float qscale;
    __device__ __forceinline__ void operator()(const f32x4 (&acc)[2][2][4][2], const pg8::Unit& u, int wr, int wc, int fr, int fq) const {
        const int colt = u.pn * 256, t = colt >> 10, colw = colt & 1023;
        bf16* base = base0 + (size_t)t * (SLOTB / 2);
        const int row0 = u.pm * 256 + wr * 64 + fr, col0 = colw + wc * 32 + 8 * fq;
        f32x4 bv[2][2];
#pragma unroll
        for (int bj = 0; bj < 2; ++bj)
#pragma unroll
            for (int n = 0; n < 2; ++n) bv[bj][n] = (t >= 5) ? *(const f32x4*)(b_gate + (t - 5) * 1024 + col0 + bj * 128 + 4 * n) : (f32x4){0.f, 0.f, 0.f, 0.f};
#pragma unroll
        for (int ai = 0; ai < 2; ++ai)
#pragma unroll
            for (int m = 0; m < 4; ++m) { bf16* rowp = base + (size_t)(row0 + ai * 128 + m * 16) * D + col0;
#pragma unroll
                for (int bj = 0; bj < 2; ++bj) { f32x4 v0 = acc[ai][bj][m][0], v1 = acc[ai][bj][m][1];
                    if (t == 1) {
#pragma unroll
                        for (int j = 0; j < 4; ++j) { v0[j] = pg8::gelu_tanh(v0[j]); v1[j] = pg8::gelu_tanh(v1[j]); }
                    } else if (t == 2) { v0 = v0 * qscale; v1 = v1 * qscale; }
                    else if (t >= 5) { v0 = v0 + bv[bj][0]; v1 = v1 + bv[bj][1];
#pragma unroll
                        for (int j = 0; j < 4; ++j) { v0[j] = pg8::fast_sigmoid(v0[j]); v1[j] = pg8::fast_sigmoid(v1[j]); } }
                    u32x4 w; w.x = pg8::cvt_pk_bf16(v0[0], v0[1]); w.y = pg8::cvt_pk_bf16(v0[2], v0[3]); w.z = pg8::cvt_pk_bf16(v1[0], v1[1]); w.w = pg8::cvt_pk_bf16(v1[2], v1[3]);
                    *(u32x4*)(rowp + bj * 128) = w; } }
    }
};
struct EpiGate {
    static constexpr bool PERM = true; static constexpr int MIDK = 0;
    const bf16* gate; const bf16* add; bf16* out;
    __device__ __forceinline__ void operator()(const f32x4 (&acc)[2][2][4][2], const pg8::Unit& u, int wr, int wc, int fr, int fq) const {
        const int rl = wr * 64 + fr, col0 = u.pn * 256 + wc * 32 + 8 * fq;
#pragma unroll
        for (int ai = 0; ai < 2; ++ai)
#pragma unroll
            for (int m = 0; m < 4; ++m) { const int r = rl + ai * 128 + m * 16; const size_t off = (size_t)(u.pm * 256 + r) * D + col0, goff = (size_t)(u.ar + r) * D + col0;
#pragma unroll
                for (int bj = 0; bj < 2; ++bj) { const f32x4 a0 = acc[ai][bj][m][0], a1 = acc[ai][bj][m][1];
                    const u32x4 gw = *(const u32x4*)(gate + goff + bj * 128);
                    u32x4 aw = (u32x4){0u, 0u, 0u, 0u}; if (add) aw = *(const u32x4*)(add + off + bj * 128);
                    const float r0 = bfl(aw.x) + bfl(gw.x) * a0[0], r1 = bfh(aw.x) + bfh(gw.x) * a0[1], r2 = bfl(aw.y) + bfl(gw.y) * a0[2], r3 = bfh(aw.y) + bfh(gw.y) * a0[3];
                    const float r4 = bfl(aw.z) + bfl(gw.z) * a1[0], r5 = bfh(aw.z) + bfh(gw.z) * a1[1], r6 = bfl(aw.w) + bfl(gw.w) * a1[2], r7 = bfh(aw.w) + bfh(gw.w) * a1[3];
                    u32x4 w; w.x = pg8::cvt_pk_bf16(r0, r1); w.y = pg8::cvt_pk_bf16(r2, r3); w.z = pg8::cvt_pk_bf16(r4, r5); w.w = pg8::cvt_pk_bf16(r6, r7);
                    *(u32x4*)(out + off + bj * 128) = w; } }
    }
};
struct EpiGate2 {
    static constexpr bool PERM = true; static constexpr int MIDK = 16;
    const bf16* gr; const bf16* ga; bf16* out;
    __device__ __forceinline__ void mid(f32x4 (&acc)[2][2][4][2], const pg8::Unit& u, int wr, int wc, int fr, int fq) const {
        int rl = wr * 64 + fr; asm volatile("" : "+v"(rl));
        const int col0 = u.pn * 256 + wc * 32 + 8 * fq;
#pragma unroll
        for (int ai = 0; ai < 2; ++ai)
#pragma unroll
            for (int m = 0; m < 4; ++m) { const size_t goff = (size_t)(u.ar + rl + ai * 128 + m * 16) * D + col0;
#pragma unroll
                for (int bj = 0; bj < 2; ++bj) { const u32x4 a = *(const u32x4*)(gr + goff + bj * 128), b = *(const u32x4*)(ga + goff + bj * 128);
                    f32x4 r0, r1;
                    r0[0] = bfl(a.x) * __builtin_amdgcn_rcpf(bfl(b.x)); r0[1] = bfh(a.x) * __builtin_amdgcn_rcpf(bfh(b.x)); r0[2] = bfl(a.y) * __builtin_amdgcn_rcpf(bfl(b.y)); r0[3] = bfh(a.y) * __builtin_amdgcn_rcpf(bfh(b.y));
                    r1[0] = bfl(a.z) * __builtin_amdgcn_rcpf(bfl(b.z)); r1[1] = bfh(a.z) * __builtin_amdgcn_rcpf(bfh(b.z)); r1[2] = bfl(a.w) * __builtin_amdgcn_rcpf(bfl(b.w)); r1[3] = bfh(a.w) * __builtin_amdgcn_rcpf(bfh(b.w));
                    acc[ai][bj][m][0] = acc[ai][bj][m][0] * r0; acc[ai][bj][m][1] = acc[ai][bj][m][1] * r1; }
                asm volatile("" ::: "memory"); }
    }
    __device__ __forceinline__ void operator()(const f32x4 (&acc)[2][2][4][2], const pg8::Unit& u, int wr, int wc, int fr, int fq) const {
        const int rl = wr * 64 + fr, col0 = u.pn * 256 + wc * 32 + 8 * fq;
#pragma unroll
        for (int ai = 0; ai < 2; ++ai)
#pragma unroll
            for (int m = 0; m < 4; ++m) { const int r = rl + ai * 128 + m * 16; const size_t off = (size_t)(u.pm * 256 + r) * D + col0, goff = (size_t)(u.ar + r) * D + col0;
#pragma unroll
                for (int bj = 0; bj < 2; ++bj) { const f32x4 a0 = acc[ai][bj][m][0], a1 = acc[ai][bj][m][1]; const u32x4 gw = *(const u32x4*)(ga + goff + bj * 128);
                    u32x4 w; w.x = pg8::cvt_pk_bf16(bfl(gw.x) * a0[0], bfh(gw.x) * a0[1]); w.y = pg8::cvt_pk_bf16(bfl(gw.y) * a0[2], bfh(gw.y) * a0[3]);
                    w.z = pg8::cvt_pk_bf16(bfl(gw.z) * a1[0], bfh(gw.z) * a1[1]); w.w = pg8::cvt_pk_bf16(bfl(gw.w) * a1[2], bfh(gw.w) * a1[3]);
                    *(u32x4*)(out + off + bj * 128) = w; } }
    }
};
struct EpiZ {
    static constexpr bool PERM = false; static constexpr int MIDK = 0;
    const float* x; const float* g0; const float* b0; const float* rowstat; float* Z;
    __device__ __forceinline__ void operator()(const f32x4 (&acc)[2][2][4][2], const pg8::Unit& u, int wr, int wc, int fr, int fq) const {
        const int col0 = u.pn * 256 + wc * 32 + 4 * fq;
        f32x4 gv[2][2], bv[2][2];
#pragma unroll
        for (int bj = 0; bj < 2; ++bj)
#pragma unroll
            for (int n = 0; n < 2; ++n) { gv[bj][n] = *(const f32x4*)(g0 + col0 + bj * 128 + n * 16); bv[bj][n] = *(const f32x4*)(b0 + col0 + bj * 128 + n * 16); }
#pragma unroll
        for (int ai = 0; ai < 2; ++ai)
#pragma unroll
            for (int m = 0; m < 4; ++m) { const int r = ai * 128 + wr * 64 + m * 16 + fr; const int p = u.pm * 256 + r, rt = (p >> 12) * TA + NMETA + (p & 4095);
                const float* xr = x + (size_t)p * D; const float mean = rowstat[2 * rt], rstd = rowstat[2 * rt + 1];
#pragma unroll
                for (int bj = 0; bj < 2; ++bj)
#pragma unroll
                    for (int n = 0; n < 2; ++n) { const int c = col0 + bj * 128 + n * 16; const f32x4 xv = *(const f32x4*)(xr + c);
                        const f32x4 h0 = (xv - mean) * rstd * gv[bj][n] + bv[bj][n];
                        *(f32x4*)(Z + (size_t)p * D + c) = h0 * ALPHA + acc[ai][bj][m][n]; } }
    }
};
struct EpiF32 {
    static constexpr bool PERM = false; static constexpr int MIDK = 0;
    float* out; int ldc;
    __device__ __forceinline__ void operator()(const f32x4 (&acc)[2][2][4][2], const pg8::Unit& u, int wr, int wc, int fr, int fq) const {
        const int col0 = u.pn * 256 + wc * 32 + 4 * fq;
#pragma unroll
        for (int ai = 0; ai < 2; ++ai)
#pragma unroll
            for (int m = 0; m < 4; ++m) { const int row = u.pm * 256 + ai * 128 + wr * 64 + m * 16 + fr;
#pragma unroll
                for (int bj = 0; bj < 2; ++bj)
#pragma unroll
                    for (int n = 0; n < 2; ++n) *(f32x4*)(out + (size_t)row * ldc + col0 + bj * 128 + n * 16) = acc[ai][bj][m][n]; }
    }
};
struct EpiAct {
    static constexpr bool PERM = true; static constexpr int MIDK = 0;
    bf16* act;
    __device__ __forceinline__ void operator()(const f32x4 (&acc)[2][2][4][2], const pg8::Unit& u, int wr, int wc, int fr, int fq) const {
        const int row0 = u.pm * 256 + wr * 64 + fr, col0 = u.pn * 128 + wc * 32 + 8 * fq;
#pragma unroll
        for (int ai = 0; ai < 2; ++ai)
#pragma unroll
            for (int m = 0; m < 4; ++m) { float r[8];
#pragma unroll
                for (int n = 0; n < 2; ++n)
#pragma unroll
                    for (int j = 0; j < 4; ++j) { const float gte = acc[ai][0][m][n][j], up = acc[ai][1][m][n][j]; r[n * 4 + j] = gte * pg8::fast_sigmoid(gte) * up; }
                u32x4 w; w.x = pg8::cvt_pk_bf16(r[0], r[1]); w.y = pg8::cvt_pk_bf16(r[2], r[3]); w.z = pg8::cvt_pk_bf16(r[4], r[5]); w.w = pg8::cvt_pk_bf16(r[6], r[7]);
                *(u32x4*)(act + (size_t)(row0 + ai * 128 + m * 16) * DE + col0) = w; }
    }
};
struct EpiY {
    static constexpr bool PERM = true; static constexpr int MIDK = 0;
    unsigned char* Y;
    __device__ __forceinline__ void operator()(const f32x4 (&acc)[2][2][4][2], const pg8::Unit& u, int wr, int wc, int fr, int fq) const {
        const int r0 = wr * 64 + fr, col0 = u.pn * 256 + wc * 32 + 8 * fq;
#pragma unroll
        for (int ai = 0; ai < 2; ++ai)
#pragma unroll
            for (int m = 0; m < 4; ++m) { const int r = r0 + ai * 128 + m * 16; const int yr = (r < u.nv) ? (u.aux + r) : YDUMMY;
                unsigned char* rowp = Y + (size_t)yr * D + col0;
#pragma unroll
                for (int bj = 0; bj < 2; ++bj) { const f32x4 v0 = acc[ai][bj][m][0] * YSCALE, v1 = acc[ai][bj][m][1] * YSCALE;
                    unsigned w0 = 0u, w1 = 0u;
                    w0 = __builtin_amdgcn_cvt_pk_fp8_f32(v0[0], v0[1], w0, false); w0 = __builtin_amdgcn_cvt_pk_fp8_f32(v0[2], v0[3], w0, true);
                    w1 = __builtin_amdgcn_cvt_pk_fp8_f32(v1[0], v1[1], w1, false); w1 = __builtin_amdgcn_cvt_pk_fp8_f32(v1[2], v1[3], w1, true);
                    *(u32x2v*)(rowp + bj * 128) = (u32x2v){w0, w1}; } }
    }
};

__device__ __forceinline__ void transpose_item(const float* W, int K, int N, bf16* WT, int row_base, int gu, LAS float* scr, int item, int lane, int ldk = 0, int koff = 0) {
    if (ldk == 0) ldk = K;
    const int nblk = N / 32, kb = item / nblk, nb = item % nblk, k0 = 64 * kb, n0 = 32 * nb;
    const int r0 = row_base + (gu ? ((n0 >> 7) * 256 + (n0 & 127)) : n0);
#pragma unroll 8
    for (int i = 0; i < 32; ++i) { const int kk = 2 * i + (lane >> 5); scr[kk * 33 + (lane & 31)] = W[(size_t)(k0 + kk) * N + n0 + (lane & 31)]; }
    LDS_WAIT(); asm volatile("" ::: "memory");
    const int c = lane & 7;
#pragma unroll
    for (int j = 0; j < 4; ++j) { const int n = (lane >> 3) + 8 * j; const LAS float* s = scr + (8 * c) * 33 + n;
        v4u o; o.x = pk2(s[0 * 33], s[1 * 33]); o.y = pk2(s[2 * 33], s[3 * 33]); o.z = pk2(s[4 * 33], s[5 * 33]); o.w = pk2(s[6 * 33], s[7 * 33]);
        *(GAS v4u*)(WT + (size_t)(r0 + n) * ldk + koff + k0 + 8 * c) = o; }
    LDS_WAIT(); asm volatile("" ::: "memory");
}
__device__ __forceinline__ void ln_row_to_bf16(const float* xrow, const float* g, const float* b, bf16* orow, float* stat, int lane) {
    const GAS f32x4* xr = (const GAS f32x4*)xrow + lane;
    f32x4 v[4]; float s = 0.f;
#pragma unroll
    for (int j = 0; j < 4; ++j) { v[j] = xr[64 * j]; s += (v[j].x + v[j].y) + (v[j].z + v[j].w); }
    const float mean = wave_sum(s) * (1.f / D); float s2 = 0.f;
#pragma unroll
    for (int j = 0; j < 4; ++j) { v[j] = v[j] - mean; s2 += (v[j].x * v[j].x + v[j].y * v[j].y) + (v[j].z * v[j].z + v[j].w * v[j].w); }
    const float rstd = 1.f / sqrtf(wave_sum(s2) * (1.f / D) + LN_EPS);
    if (stat && lane == 0) { stat[0] = mean; stat[1] = rstd; }
    GAS unsigned long long* o8 = (GAS unsigned long long*)orow + lane;
#pragma unroll
    for (int j = 0; j < 4; ++j) { const f32x4 gg = *((const f32x4*)g + lane + 64 * j), bb = *((const f32x4*)b + lane + 64 * j); const f32x4 y = v[j] * rstd * gg + bb;
        o8[64 * j] = (unsigned long long)pk2(y.x, y.y) | ((unsigned long long)pk2(y.z, y.w) << 32); }
}

__device__ __forceinline__ int crow16(int r, int hi) { return (r & 3) + 8 * (r >> 2) + 4 * hi; }
typedef float f32x16 __attribute__((ext_vector_type(16)));
struct ScanArgs { const bf16* XR; const bf16* YG; bf16* REC; const float* conv_w; const float* conv_b; const bf16* lruwt; const float* b_a; const float* b_i; const float* lam; float* scansum; };
__device__ __forceinline__ float xlane32(float v) { return __shfl_xor(v, 32); }
template <bool FINAL>
__device__ __forceinline__ void scan_phase(const ScanArgs& A, LAS unsigned char* lds, int vcu, int G) {
    const int tid = threadIdx.x, lane = tid & 63, wave = __builtin_amdgcn_readfirstlane(tid >> 6);
    const int nb = vcu & 7, cun = vcu >> 3, nslots = (G >> 3) * 8;
    const int cc = lane & 15, rg = lane >> 4;
    const int l31 = lane & 31, hi = lane >> 5;
#pragma unroll
    for (int i = 0; i < 8; ++i) { const int idx = tid + 512 * i, n = idx >> 4, ch = idx & 15; const int gt = n >> 7, col = n & 127;
        const v4u w = *(const v4u*)(A.lruwt + ((size_t)((gt * 8 + nb) * 128 + col)) * 128 + ch * 8);
        *(LAS v4u*)(lds + n * 272 + ch * 16) = w; }
    __syncthreads();
    constexpr int SPW = 272;
    LAS unsigned char* TL = lds + (wave < 7 ? 256 * SPW + wave * 32 * SPW : LDSCTL_OFF + 1024);
    LAS unsigned char* const WLb = lds + l31 * SPW + hi * 16;
    LAS unsigned char* const TLa = TL + l31 * SPW + hi * 16;
    LAS unsigned char* const TLx = TL + hi * (4 * SPW) + l31 * 2;
    LAS unsigned char* const TLs = TL + rg * (8 * SPW) + cc * 16;
    LAS float* CWL = (LAS float*)(lds + LDSCTL_OFF + 1024 + 32 * SPW);
    if (tid < 160) { const int k = tid >> 5, c4 = (tid & 31) * 4; const f32x4 w = (k < 4) ? *(const f32x4*)(A.conv_w + k * D + nb * 128 + c4) : *(const f32x4*)(A.conv_b + nb * 128 + c4); *(LAS f32x4*)(CWL + k * 128 + c4) = w; }
    __syncthreads();
    float gba[4], gbi[4], gk8[4];
#pragma unroll
    for (int q = 0; q < 4; ++q) { const int C = nb * 128 + 32 * q + l31; gba[q] = A.b_a[C]; gbi[q] = A.b_i[C]; const float lm = A.lam[C];
        const float sp = (-lm > 20.f) ? -lm : log1pf(__expf(-lm)); gk8[q] = -8.0f * sp * 1.4426950408889634f; }
    for (int wv = cun * 8 + wave; wv < 256; wv += nslots) {
        const int b = wv >> 5, ri = wv & 31; const int sb0 = ri == 0 ? 0 : 4 * ri + 1, nsb = ri == 0 ? 5 : 4;
        const size_t rowb = (size_t)b * TA;
        float hc[4], Ac[4];
#pragma unroll
        for (int q = 0; q < 4; ++q) { hc[q] = 0.f; Ac[q] = 1.f; }
        if (FINAL) {
            float h0 = 0.f, h1 = 0.f;
#pragma unroll 1
            for (int j0 = 0; j0 < ri; j0 += 8) { f32x4 s[8];
#pragma unroll
                for (int i = 0; i < 8; ++i) { const int j = j0 + i; const int jc = j < ri ? j : 0; s[i] = *(const f32x4*)(A.scansum + ((size_t)(b * 32 + jc) * D + nb * 128 + 2 * lane) * 2); if (j >= ri) s[i] = (f32x4){1.f, 0.f, 1.f, 0.f}; }
#pragma unroll
                for (int i = 0; i < 8; ++i) { h0 = s[i].x * h0 + s[i].y; h1 = s[i].z * h1 + s[i].w; } }
            ((LAS float*)TL)[2 * lane] = h0; ((LAS float*)TL)[2 * lane + 1] = h1;
            asm volatile("s_waitcnt lgkmcnt(0)" ::: "memory");
#pragma unroll
            for (int q = 0; q < 4; ++q) hc[q] = ((LAS float*)TL)[32 * q + l31];
            asm volatile("s_waitcnt lgkmcnt(0)" ::: "memory");
        }
#pragma unroll 1
        for (int s = 0; s < nsb; ++s) {
            const int t0 = 32 * (sb0 + s);
            v4u xv[11];
#pragma unroll
            for (int i = 0; i < 11; ++i) { int tt = t0 + 8 * rg - 3 + i; const bool neg = tt < 0; tt = neg ? 0 : tt; xv[i] = *(const v4u*)(A.XR + (rowb + tt) * D + nb * 128 + cc * 8); if (i < 3 && neg) xv[i] = (v4u){0u, 0u, 0u, 0u}; }
            { f32x4 w0[4], w1[4];
#pragma unroll
              for (int k = 0; k < 4; ++k) { w0[k] = *(const LAS f32x4*)(CWL + k * 128 + cc * 8); w1[k] = *(const LAS f32x4*)(CWL + k * 128 + cc * 8 + 4); }
              const f32x4 cb0 = *(const LAS f32x4*)(CWL + 4 * 128 + cc * 8), cb1 = *(const LAS f32x4*)(CWL + 4 * 128 + cc * 8 + 4);
#pragma unroll
              for (int i = 0; i < 8; ++i) { float o[8]; o[0] = cb0.x; o[1] = cb0.y; o[2] = cb0.z; o[3] = cb0.w; o[4] = cb1.x; o[5] = cb1.y; o[6] = cb1.z; o[7] = cb1.w;
#pragma unroll
                for (int k = 0; k < 4; ++k) { const v4u x4 = xv[i + k]; const f32x4 a0 = w0[k], a1 = w1[k];
                    o[0] += a0.x * bfl(x4.x); o[1] += a0.y * bfh(x4.x); o[2] += a0.z * bfl(x4.y); o[3] += a0.w * bfh(x4.y);
                    o[4] += a1.x * bfl(x4.z); o[5] += a1.y * bfh(x4.z); o[6] += a1.z * bfl(x4.w); o[7] += a1.w * bfh(x4.w); }
                v4u w; w.x = pk2(o[0], o[1]); w.y = pk2(o[2], o[3]); w.z = pk2(o[4], o[5]); w.w = pk2(o[6], o[7]);
                *(LAS v4u*)(TLs + i * SPW) = w; } }
            asm volatile("s_waitcnt lgkmcnt(0)" ::: "memory");
            bf16x8 af[8];
#pragma unroll
            for (int k8 = 0; k8 < 8; ++k8) af[k8] = *(const LAS bf16x8*)(TLa + k8 * 32);
#pragma unroll
            for (int hh = 0; hh < 2; ++hh) {
                f32x16 acc[2][2];
#pragma unroll
                for (int gt = 0; gt < 2; ++gt)
#pragma unroll
                    for (int cb = 0; cb < 2; ++cb) acc[gt][cb] = f32x16{};
#pragma unroll
                for (int k8 = 0; k8 < 8; ++k8) {
#pragma unroll
                    for (int gt = 0; gt < 2; ++gt)
#pragma unroll
                        for (int cb = 0; cb < 2; ++cb) {
                            const bf16x8 bfv = *(const LAS bf16x8*)(WLb + (gt * 128 + 64 * hh + 32 * cb) * SPW + k8 * 32);
                            acc[gt][cb] = __builtin_amdgcn_mfma_f32_32x32x16_bf16(af[k8], bfv, acc[gt][cb], 0, 0, 0); }
                }
#pragma unroll
                for (int cb = 0; cb < 2; ++cb) { const int q = 2 * hh + cb, c = 32 * q + l31;
                    float av[16], bt[16];
#pragma unroll
                    for (int rr = 0; rr < 16; ++rr) { const int row = crow16(rr, hi);
                        const float rgt = pg8::fast_sigmoid(acc[0][cb][rr] + gba[q]), igt = pg8::fast_sigmoid(acc[1][cb][rr] + gbi[q]);
                        const float a = __builtin_amdgcn_exp2f(gk8[q] * rgt); float mult = __builtin_amdgcn_sqrtf(fmaxf(1.0f - a * a, 0.f));
                        if (rr == 0 && t0 == 0 && hi == 0) mult = 1.0f;
                        const float xc = bf1(*(const LAS bf16*)(TLx + crow16(rr, 0) * SPW + q * 64));
                        av[rr] = a; bt[rr] = mult * igt * xc; }
                    float Ao[4], Bo[4], Ap[4], Bp[4];
#pragma unroll
                    for (int j = 0; j < 4; ++j) { float Ag = av[4 * j], Bg = bt[4 * j];
#pragma unroll
                        for (int k = 1; k < 4; ++k) { Bg = av[4 * j + k] * Bg + bt[4 * j + k]; Ag *= av[4 * j + k]; }
                        Ao[j] = Ag; Bo[j] = Bg; Ap[j] = xlane32(Ag); Bp[j] = xlane32(Bg); }
                    float h = hc[q]; float hin[4];
#pragma unroll
                    for (int j = 0; j < 4; ++j) {
                        const float Ae = hi ? Ap[j] : Ao[j], Be = hi ? Bp[j] : Bo[j], Aod = hi ? Ao[j] : Ap[j], Bod = hi ? Bo[j] : Bp[j];
                        const float h_even_in = h; const float h_odd_in = Ae * h + Be; h = Aod * h_odd_in + Bod;
                        hin[j] = hi ? h_odd_in : h_even_in; Ac[q] *= Ae * Aod; }
                    hc[q] = h;
                    if (FINAL) {
#pragma unroll
                        for (int j = 0; j < 4; ++j) { float hh2 = hin[j];
#pragma unroll
                            for (int k = 0; k < 4; ++k) { const int rr = 4 * j + k, row = crow16(rr, hi); hh2 = av[rr] * hh2 + bt[rr];
                                *(LAS bf16*)(TLx + crow16(rr, 0) * SPW + q * 64) = (bf16)f2bf(hh2); } } }
                }
            }
            if (FINAL) {
                v4u yv[8];
#pragma unroll
                for (int i = 0; i < 8; ++i) yv[i] = *(const v4u*)(A.YG + (rowb + t0 + 8 * rg + i) * D + nb * 128 + cc * 8);
                asm volatile("s_waitcnt lgkmcnt(0)" ::: "memory");
#pragma unroll
                for (int i = 0; i < 8; ++i) { const int row = 8 * rg + i; const v4u hv = *(const LAS v4u*)(TLs + i * SPW); const v4u y = yv[i];
                    v4u o; o.x = pk2(bfl(hv.x) * bfl(y.x), bfh(hv.x) * bfh(y.x)); o.y = pk2(bfl(hv.y) * bfl(y.y), bfh(hv.y) * bfh(y.y)); o.z = pk2(bfl(hv.z) * bfl(y.z), bfh(hv.z) * bfh(y.z)); o.w = pk2(bfl(hv.w) * bfl(y.w), bfh(hv.w) * bfh(y.w));
                    *(v4u*)(A.REC + (rowb + t0 + row) * (2 * D) + nb * 128 + cc * 8) = o; }
                asm volatile("s_waitcnt lgkmcnt(0)" ::: "memory");
            }
        }
        if (!FINAL && hi == 0) {
#pragma unroll
            for (int q = 0; q < 4; ++q) { float* sm = A.scansum + ((size_t)(b * 32 + ri) * D + nb * 128 + 32 * q + l31) * 2; sm[0] = Ac[q]; sm[1] = hc[q]; } }
    }
    __syncthreads();
}

__device__ __forceinline__ void route_token(const float* logits, const float* rbias, int row, unsigned* cnt, int* list, float* tokw, int lane) {
    const f32x4 lg = *((const f32x4*)(logits + (size_t)row * NE) + lane); const f32x4 rb = *((const f32x4*)rbias + lane);
    float sc[4], sel[4];
#pragma unroll
    for (int j = 0; j < 4; ++j) { sc[j] = 1.0f / (1.0f + expf(-lg[j])); sel[j] = sc[j] + rb[j]; }
    float m1 = fmaxf(sel[0], sel[1]), m2 = fminf(sel[0], sel[1]);
#pragma unroll
    for (int j = 2; j < 4; ++j) { const float v = sel[j]; m2 = fmaxf(m2, fminf(m1, v)); m1 = fmaxf(m1, v); }
#pragma unroll
    for (int o = 1; o < 8; o <<= 1) { const float o1 = __shfl_xor(m1, o), o2 = __shfl_xor(m2, o); m2 = fmaxf(fminf(m1, o1), fmaxf(m2, o2)); m1 = fmaxf(m1, o1); }
    const float gs = m1 + m2; const int g = lane >> 3; int rank = 0;
#pragma unroll
    for (int gg = 0; gg < 8; ++gg) { const float og = __shfl(gs, gg * 8); rank += (og > gs || (og == gs && gg < g)) ? 1 : 0; }
    const bool gsel = rank < 4;
#pragma unroll
    for (int j = 0; j < 4; ++j) if (!gsel) sel[j] = -INFINITY;
    float wk = 0.f; int ek = 0; float ssum = 0.f;
#pragma unroll 1
    for (int k = 0; k < TOPK; ++k) {
        float bv = sel[0]; int bi = 4 * lane;
#pragma unroll
        for (int j = 1; j < 4; ++j) if (sel[j] > bv) { bv = sel[j]; bi = 4 * lane + j; }
#pragma unroll
        for (int o = 1; o < 64; o <<= 1) { const float ov = __shfl_xor(bv, o); const int oi = __shfl_xor(bi, o); if (ov > bv || (ov == bv && oi < bi)) { bv = ov; bi = oi; } }
        const int own = bi >> 2, jj = bi & 3;
        float s = 0.f;
        if (lane == own) {
#pragma unroll
            for (int j = 0; j < 4; ++j) if (j == jj) { s = sc[j]; sel[j] = -INFINITY; } }
        s = __shfl(s, own);
        ssum += s; if (lane == k) { wk = s; ek = bi; }
    }
    if (lane < TOPK) { const float w = wk / ssum * ROUTED_SCALE; const unsigned pos = atomicAdd(cnt + ek, 1u); if (pos < (unsigned)CAP) list[(size_t)ek * CAP + pos] = (row << 4) | lane; tokw[(size_t)row * 16 + lane] = w; }
}

struct Args { const float* in[33]; float* out; unsigned char* ws; int ph_lo, ph_hi, li, pad; };
__global__ void __launch_bounds__(NWAVES * 64, 2) mega_fwd(Args args) {
    extern __shared__ __attribute__((aligned(16))) unsigned char lds[];
    LAS unsigned char* L = (LAS unsigned char*)lds;
    volatile LAS unsigned* MISC = (volatile LAS unsigned*)(L + MISC_OFF);
    const int tid = threadIdx.x, lane = tid & 63, wave = __builtin_amdgcn_readfirstlane(tid >> 6);
    const int G = gridDim.x; const int bx = blockIdx.x; const int vcu = (G % 8 == 0) ? (bx % 8) * (G / 8) + bx / 8 : bx;
    unsigned char* ws = args.ws;
    gu32* ctl = (gu32*)(ws + WS_CTL);
    for (int u = tid; u < (LDS_BYTES - LDSCTL_OFF) / 4; u += NWAVES * 64) ((LAS unsigned*)(L + LDSCTL_OFF))[u] = 0u;
    __syncthreads();
    XcdBarrier bar; bar.bar = (unsigned*)(ctl + CW_BAR); bar.x = 0; bar.st = nullptr;
    if (N_LAUNCHES == 1) bar = xcd_barrier_post((unsigned*)(ctl + CW_BAR), MISC + 8);
#define GRID_BAR() do { if (N_LAUNCHES == 1) xcd_barrier(bar); } while (0)
#if MK_DIAG
    int n_stamp = 0;
#define STAMP() do { if (blockIdx.x == 0 && tid == 0) { ((unsigned long long*)(ctl + CW_DIAG))[n_stamp] = __builtin_amdgcn_s_memrealtime(); } ++n_stamp; } while (0)
#else
#define STAMP() do {} while (0)
#endif
    STAMP();
    const int lo = args.ph_lo, hi = args.ph_hi;
#ifndef MK_REPEAT_MASK
#define MK_REPEAT_MASK 0
#endif
#ifndef MK_PHASE_MASK
#define MK_PHASE_MASK 0xffff
#endif
#define IN(k) ((((MK_PHASE_MASK) >> (k)) & 1) && lo <= (k) && (k) < hi)
#define BOTH(k) (IN(k) && IN((k) + 1))
    const int gw = vcu * NWAVES + wave, NGW = G * NWAVES;
    const float* x = args.in[0]; const float* meta = args.in[1];

    if (IN(0)) {
        LAS float* scr = (LAS float*)(L + RING_OFF + wave * 16384);
        constexpr int I_IN = 16 * (NIN / 32), I_SQ = 16 * 32, I_RT = 16 * 8, I_LRU = 2 * 8 * 2 * 4;
        constexpr int NITEMS = I_IN + 3 * I_SQ + I_RT + I_LRU;
        for (int it = gw; it < NITEMS; it += NGW) {
            int r = it;
            if (r < I_IN) { transpose_item(args.in[4], D, NIN, (bf16*)(ws + WS_WIN), 0, 0, scr, r, lane); continue; } r -= I_IN;
            if (r < I_SQ) { transpose_item(args.in[18], D, D, (bf16*)(ws + WS_WR), 0, 0, scr, r, lane, 2 * D, 0); continue; } r -= I_SQ;
            if (r < I_SQ) { transpose_item(args.in[19], D, D, (bf16*)(ws + WS_WR), 0, 0, scr, r, lane, 2 * D, D); continue; } r -= I_SQ;
            if (r < I_SQ) { transpose_item(args.in[20], D, D, (bf16*)(ws + WS_WO), 0, 0, scr, r, lane); continue; } r -= I_SQ;
            if (r < I_RT) { transpose_item(args.in[23], D, NE, (bf16*)(ws + WS_WROUT), 0, 0, scr, r, lane); continue; } r -= I_RT;
            { const int m = r >> 3, it2 = r & 7, gt = m >> 3, blk = m & 7;
              transpose_item(args.in[gt ? 10 : 8] + (size_t)blk * 128 * 128, 128, 128, (bf16*)(ws + WS_LRUWT) + (size_t)(gt * 8 + blk) * 128 * 128, 0, 0, scr, it2, lane); }
        }
        for (int m = gw; m < MA; m += NGW) { const int b = m / TA, t = m - b * TA; bf16* orow = (bf16*)(ws + WS_XN) + (size_t)m * D;
            if (t < TV) { const float* xr = (t < NMETA) ? meta + (size_t)t * D : x + ((size_t)b * SEQ + (t - NMETA)) * D;
                ln_row_to_bf16(xr, args.in[2], args.in[3], orow, (float*)(ws + WS_ROWSTAT) + 2 * (size_t)m, lane); }
            else { GAS unsigned long long* o8 = (GAS unsigned long long*)orow + lane;
#pragma unroll
                for (int j = 0; j < 4; ++j) o8[64 * j] = 0ull; } }
        if (BOTH(0)) GRID_BAR();
        STAMP();
    }
    if (IN(1)) {
        pg8::Gemm g{(const bf16*)(ws + WS_XN), (const bf16*)(ws + WS_WIN), D, 0}; DenseOrder S; S.init(MA, NIN, G, bx);
        EpiIn E{(bf16*)(ws + WS_XR), args.in[5], 0.125f * 1.4426950408889634f};
        pg8::gemm_phase<EpiIn, DenseOrder, true, false>(L + RING_OFF, g, S, E);
        if (BOTH(1)) GRID_BAR();
        STAMP();
    }
    ScanArgs SA{(const bf16*)(ws + WS_XR), (const bf16*)(ws + WS_YG), (bf16*)(ws + WS_RA), args.in[6], args.in[7], (const bf16*)(ws + WS_LRUWT), args.in[9], args.in[11], args.in[12], (float*)(ws + WS_SCANSUM)};
    if (IN(2)) {
        scan_phase<false>(SA, L + RING_OFF, vcu, G);
        if (BOTH(2)) GRID_BAR();
        STAMP();
    }
    if (IN(3)) {
        scan_phase<true>(SA, L + RING_OFF, vcu, G);
        { const int bh = vcu >> 2, sub = vcu & 3, m = sub >> 1, part = sub & 1, b = bh >> 3, h = bh & 7;
          if (bh < NB * 8) {
              const attn2::AttnTensors AT{(const attn2::bf16*)(ws + WS_Q), (const attn2::bf16*)(ws + WS_K), (const attn2::bf16*)(ws + WS_V), (attn2::bf16*)(ws + (m ? WS_O1 : WS_O0))};
              const attn2::SplitOrder AS{b, 2 * h + m, h, part};
              attn2::attn_phase<attn2::SplitOrder>((char*)lds + RING_OFF, AT, AS);
          } }
        if (BOTH(3)) GRID_BAR();
        STAMP();
    }
    if (IN(4)) {
        const float lamq = wave_sum(args.in[13][lane] * args.in[14][lane]), lamq2 = wave_sum(args.in[15][lane] * args.in[16][lane]);
        const float lam = expf(lamq) - expf(lamq2) + LAMBDA_INIT;
        const bf16* O0 = (const bf16*)(ws + WS_O0); const bf16* O1 = (const bf16*)(ws + WS_O1); bf16* ATT = (bf16*)(ws + WS_RA) + D;
        for (int m = gw; m < MA; m += NGW) {
#pragma unroll
            for (int j = 0; j < 2; ++j) { const int c = j * 512 + lane * 8; const v4u a = *(const v4u*)(O0 + (size_t)m * D + c), bq = *(const v4u*)(O1 + (size_t)m * D + c);
                float d[8]; d[0] = bfl(a.x) - lam * bfl(bq.x); d[1] = bfh(a.x) - lam * bfh(bq.x); d[2] = bfl(a.y) - lam * bfl(bq.y); d[3] = bfh(a.y) - lam * bfh(bq.y);
                d[4] = bfl(a.z) - lam * bfl(bq.z); d[5] = bfh(a.z) - lam * bfh(bq.z); d[6] = bfl(a.w) - lam * bfl(bq.w); d[7] = bfh(a.w) - lam * bfh(bq.w);
                float ss = 0.f;
#pragma unroll
                for (int q = 0; q < 8; ++q) ss += d[q] * d[q];
                ss += __shfl_xor(ss, 1); ss += __shfl_xor(ss, 2); ss += __shfl_xor(ss, 4); ss += __shfl_xor(ss, 8);
                const float rs = (1.0f - LAMBDA_INIT) / sqrtf(ss * (1.0f / 128.f) + LN_EPS);
                const int e0 = c & 127; const f32x4 g0 = *(const f32x4*)(args.in[17] + e0), g1 = *(const f32x4*)(args.in[17] + e0 + 4);
                v4u w; w.x = pk2(d[0] * rs * g0.x, d[1] * rs * g0.y); w.y = pk2(d[2] * rs * g0.z, d[3] * rs * g0.w); w.z = pk2(d[4] * rs * g1.x, d[5] * rs * g1.y); w.w = pk2(d[6] * rs * g1.z, d[7] * rs * g1.w);
                *(v4u*)(ATT + (size_t)m * (2 * D) + c) = w; } }
        if (BOTH(4)) GRID_BAR();
        STAMP();
    }
    if (IN(5)) {
        pg8::Gemm g{(const bf16*)(ws + WS_RA), (const bf16*)(ws + WS_WR), 2 * D, 0}; DenseOrder S; S.init(NVALID, D, G, bx, 1);
        EpiGate2 E{(const bf16*)(ws + WS_GR), (const bf16*)(ws + WS_GA), (bf16*)(ws + WS_U)};
        pg8::gemm_phase<EpiGate2, DenseOrder, true, false>(L + RING_OFF, g, S, E);
        if (BOTH(5)) GRID_BAR();
        STAMP();
    }
    if (IN(7)) {
        pg8::Gemm g{(const bf16*)(ws + WS_U), (const bf16*)(ws + WS_WO), D, 0}; DenseOrder S; S.init(NVALID, D, G, bx, 0);
        EpiZ E{x, args.in[2], args.in[3], (const float*)(ws + WS_ROWSTAT), (float*)(ws + WS_Z)};
        pg8::gemm_phase<EpiZ, DenseOrder, true, false>(L + RING_OFF, g, S, E);
        if (BOTH(7)) GRID_BAR();
        STAMP();
    }
    if (IN(8)) {
        for (int m = gw; m < NVALID; m += NGW) ln_row_to_bf16((const float*)(ws + WS_Z) + (size_t)m * D, args.in[21], args.in[22], (bf16*)(ws + WS_H1B) + (size_t)m * D, nullptr, lane);
        if (BOTH(8)) GRID_BAR();
        STAMP();
    }
    if (IN(9)) {
        { pg8::Gemm g{(const bf16*)(ws + WS_H1B), (const bf16*)(ws + WS_WROUT), D, 0}; DenseOrder S; S.init(NVALID, NE, G, bx, 0);
          EpiF32 E{(float*)(ws + WS_LOGITS), NE};
          pg8::gemm_phase<EpiF32, DenseOrder, false, false>(L + RING_OFF, g, S, E); }
        LAS float* scr = (LAS float*)(L + RING_OFF + wave * 16384);
        constexpr int IPE = 128;
        for (int it = gw; it < 257 * 3 * IPE; it += NGW) { const int e = it / (3 * IPE), r = it - e * 3 * IPE, which = r / IPE, i2 = r - which * IPE;
            if (which < 2) { const float* W = (e < NE) ? args.in[25 + which] + (size_t)e * D * DE : args.in[28 + which];
                transpose_item(W, D, DE, (bf16*)(ws + WS_WGU), e * 512 + which * 128, 1, scr, i2, lane); }
            else { const float* W = (e < NE) ? args.in[27] + (size_t)e * DE * D : args.in[30];
                transpose_item(W, DE, D, (bf16*)(ws + WS_WD) + (size_t)e * D * DE, 0, 0, scr, i2, lane); } }
        if (BOTH(9)) GRID_BAR();
        STAMP();
    }
    if (IN(10)) {
        for (int p = gw; p < NVALID; p += NGW) { const int row = p;
            route_token((const float*)(ws + WS_LOGITS), args.in[24], row, (unsigned*)(ctl + CW_CNT), (int*)(ws + WS_LIST), (float*)(ws + WS_TOKW), lane); }
        if (BOTH(10)) GRID_BAR();
        STAMP();
    }
    if (IN(11) || IN(12)) {
        volatile LAS unsigned* TT = (volatile LAS unsigned*)(L + TT_OFF); volatile LAS int* UB = (volatile LAS int*)(L + UB_OFF);
        const unsigned* cnt = (const unsigned*)(ctl + CW_CNT);
        volatile LAS int* CN = (volatile LAS int*)(L + CN_OFF); volatile LAS int* TB = (volatile LAS int*)(L + TB_OFF);
        if (tid <= NE) { int c = (tid == NE) ? NVALID : (int)__hip_atomic_load(cnt + tid, RLX_AGENT); if (c > CAP) c = CAP; CN[tid] = c; }
        __syncthreads();
        if (tid == 0) { int tb = 0, ub = 0;
            for (int e = 0; e <= NE; ++e) { const int c = CN[e]; int ntl = (c + 255) >> 8; if (tb + ntl > MAXTILES) ntl = MAXTILES - tb; UB[e] = ub; TB[e] = tb; ub += c; tb += ntl; }
            TB[NE + 1] = tb; MISC[16] = (unsigned)tb; }
        __syncthreads();
        if (tid <= NE) { const int t0 = TB[tid], t1 = TB[tid + 1]; for (int t = t0; t < t1; ++t) TT[t] = (unsigned)tid | ((unsigned)(t - t0) << 16); }
        __syncthreads();
        const int ntiles = (int)MISC[16];
        if (IN(11)) {
            pg8::Gemm g{(const bf16*)(ws + WS_H1B), (const bf16*)(ws + WS_WGU), D, (size_t)512 * D};
            MoeOrder<2> S{ntiles, G, vcu, TT, UB, CN, (const int*)(ws + WS_LIST), (int*)(ws + WS_TOKSLOT), 1};
            EpiAct E{(bf16*)(ws + WS_ACT)};
            pg8::gemm_phase<EpiAct, MoeOrder<2>, true, true>(L + RING_OFF, g, S, E);
            if (BOTH(11)) GRID_BAR();
            STAMP();
        STAMP();
        }
        if (IN(12)) {
            pg8::Gemm g{(const bf16*)(ws + WS_ACT), (const bf16*)(ws + WS_WD), DE, (size_t)D * DE};
            MoeOrder<4> S{ntiles, G, vcu, TT, UB, CN, (const int*)(ws + WS_LIST), (int*)(ws + WS_TOKSLOT), 0};
            EpiY E{(unsigned char*)(ws + WS_Y)};
            pg8::gemm_phase<EpiY, MoeOrder<4>, true, false>(L + RING_OFF, g, S, E);
            if (BOTH(12)) GRID_BAR();
            STAMP();
        STAMP();
        }
    }
    if (IN(13)) {
        const bf16* H1 = (const bf16*)(ws + WS_H1B); const unsigned char* Y = (const unsigned char*)(ws + WS_Y); const int* tokslot = (const int*)(ws + WS_TOKSLOT); const float* tokw = (const float*)(ws + WS_TOKW);
        unsigned poison = __hip_atomic_load(ctl + CW_BAR + XB_TMO, RLX_AGENT) != 0u;
        typedef float f32x2q __attribute__((ext_vector_type(2)));
        for (int p = gw; p < NVALID; p += NGW) { const int row = p; const int c = lane * 16;
            float z[16];
            { const v4u a = *(const v4u*)(H1 + (size_t)row * D + c), a2 = *(const v4u*)(H1 + (size_t)row * D + c + 8);
              z[0] = ALPHA * bfl(a.x); z[1] = ALPHA * bfh(a.x); z[2] = ALPHA * bfl(a.y); z[3] = ALPHA * bfh(a.y); z[4] = ALPHA * bfl(a.z); z[5] = ALPHA * bfh(a.z); z[6] = ALPHA * bfl(a.w); z[7] = ALPHA * bfh(a.w);
              z[8] = ALPHA * bfl(a2.x); z[9] = ALPHA * bfh(a2.x); z[10] = ALPHA * bfl(a2.y); z[11] = ALPHA * bfh(a2.y); z[12] = ALPHA * bfl(a2.z); z[13] = ALPHA * bfh(a2.z); z[14] = ALPHA * bfl(a2.w); z[15] = ALPHA * bfh(a2.w); }
            v4u yv[TOPK + 1]; float wv[TOPK + 1];
#pragma unroll
            for (int k = 0; k <= TOPK; ++k) { const int yr = (k < TOPK) ? tokslot[(size_t)row * 16 + k] : YSHARED + p; wv[k] = ((k < TOPK) ? tokw[(size_t)row * 16 + k] : 1.0f) * (1.0f / YSCALE);
                yv[k] = *(const v4u*)(Y + (size_t)yr * D + c); }
#pragma unroll
            for (int k = 0; k <= TOPK; ++k) { const float w = wv[k]; const unsigned q[4] = {yv[k].x, yv[k].y, yv[k].z, yv[k].w};
#pragma unroll
                for (int i = 0; i < 4; ++i) { const f32x2q lo = __builtin_amdgcn_cvt_pk_f32_fp8(q[i], false), hi2 = __builtin_amdgcn_cvt_pk_f32_fp8(q[i], true);
                    z[4 * i] += w * lo.x; z[4 * i + 1] += w * lo.y; z[4 * i + 2] += w * hi2.x; z[4 * i + 3] += w * hi2.y; } }
            float s = 0.f;
#pragma unroll
            for (int q = 0; q < 16; ++q) s += z[q];
            const float mean = wave_sum(s) * (1.f / D); float s2 = 0.f;
#pragma unroll
            for (int q = 0; q < 16; ++q) { z[q] -= mean; s2 += z[q] * z[q]; }
            const float rstd = 1.f / sqrtf(wave_sum(s2) * (1.f / D) + LN_EPS);
            float* orow = args.out + (size_t)p * D + c;
#pragma unroll
            for (int q4 = 0; q4 < 4; ++q4) { const f32x4 gg = *(const f32x4*)(args.in[31] + c + 4 * q4), bb = *(const f32x4*)(args.in[32] + c + 4 * q4);
                f32x4 o; o.x = z[4 * q4] * rstd * gg.x + bb.x; o.y = z[4 * q4 + 1] * rstd * gg.y + bb.y; o.z = z[4 * q4 + 2] * rstd * gg.z + bb.z; o.w = z[4 * q4 + 3] * rstd * gg.w + bb.w;
                if (poison) o = (f32x4){__builtin_nanf(""), __builtin_nanf(""), __builtin_nanf(""), __builtin_nanf("")};
                *(f32x4*)(orow + 4 * q4) = o; } }
    }
#if MK_DIAG
    GRID_BAR(); STAMP();
    if (blockIdx.x == 0 && tid == 0) { const unsigned long long* ts = (const unsigned long long*)(ctl + CW_DIAG);
      const unsigned long long a0 = __hip_atomic_load(ts + MK_DIAG_S1, RLX_AGENT), a1 = __hip_atomic_load(ts + MK_DIAG_S1 + 1, RLX_AGENT);
      args.out[0] = 40.0f + (float)(a1 - a0) * 0.01f; }
#endif
#undef IN
#undef BOTH
#undef GRID_BAR
}

extern "C" void kernel_launch(void* const* d_in, const int* in_sizes, int n_in, void* d_out, int out_size, void* d_ws, size_t ws_size, hipStream_t stream) {
    static int grid = 0;
    if (grid == 0) {
        if (n_in != 33 || in_sizes[0] != NB * SEQ * D || out_size != NB * SEQ * D || ws_size < WS_END) { fprintf(stderr, "kernel_launch: unexpected shapes / workspace (n_in %d, in0 %d, out %d, ws %zu < %zu); nothing launched\n", n_in, n_in > 0 ? in_sizes[0] : -1, out_size, ws_size, (size_t)WS_END); grid = -1; return; }
        int dev = 0, cus = 0;
        if (hipGetDevice(&dev) != hipSuccess || hipDeviceGetAttribute(&cus, hipDeviceAttributeMultiprocessorCount, dev) != hipSuccess) { grid = -1; return; }
        if (hipFuncSetAttribute((const void*)mega_fwd, hipFuncAttributeMaxDynamicSharedMemorySize, LDS_BYTES) != hipSuccess) { fprintf(stderr, "kernel_launch: hipFuncSetAttribute failed\n"); grid = -1; return; }
        int per_cu = 0;
        if (hipOccupancyMaxActiveBlocksPerMultiprocessor(&per_cu, (const void*)mega_fwd, NWAVES * 64, LDS_BYTES) != hipSuccess || per_cu < 1) fprintf(stderr, "kernel_launch: occupancy query says %d\n", per_cu);
        (void)hipGetLastError();
        grid = cus;
    }
    if (grid < 0) return;
    if (hipMemsetAsync((char*)d_ws + WS_CTL, 0, CTL_ZERO_BYTES, stream) != hipSuccess) return;
    Args a{};
    for (int i = 0; i < 33; ++i) a.in[i] = (const float*)d_in[i];
    a.out = (float*)d_out; a.ws = (unsigned char*)d_ws;
    if (N_LAUNCHES == 1) { a.ph_lo = 0; a.ph_hi = NPHASE; a.li = 0; hipLaunchKernelGGL(mega_fwd, dim3(grid), dim3(NWAVES * 64), LDS_BYTES, stream, a); }
    else for (int li = 0; li < NPHASE; ++li) { a.ph_lo = li; a.ph_hi = li + 1; a.li = li; for (int rep = 0; rep < (((MK_REPEAT_MASK) >> li) & 1) + 1; ++rep) hipLaunchKernelGGL(mega_fwd, dim3(grid), dim3(NWAVES * 64), LDS_BYTES, stream, a); }
}
```

```cpp
#include <hip/hip_runtime.h>
#include <hip/hip_bf16.h>
#include <cstdio>
#include <cstdint>
#include <cmath>
namespace pg8 {
#define PG8_LAS __attribute__((address_space(3)))
typedef unsigned short bf16_t;
typedef short bf16x8 __attribute__((ext_vector_type(8)));
typedef float f32x4 __attribute__((ext_vector_type(4)));
typedef float f32x2 __attribute__((ext_vector_type(2)));
typedef unsigned u32x4 __attribute__((ext_vector_type(4)));
constexpr int BM = 256, BK = 64, HALF = 128, HTB = HALF * BK * 2  , STAGE_BYTES = 8 * HTB;

__host__ __device__ __forceinline__ int lds_byte(int r, int c) { const int st = (r >> 4) * 2 + (c >> 5), rr = r & 15, cc = c & 31, ob = rr * 64 + cc * 2; return st * 1024 + (ob ^ (((ob >> 9) & 1) << 5)); }
__host__ __device__ __forceinline__ void stage_rc(int b, int& R, int& C) { const int st = b / 1024, sb = b % 1024, swz = sb ^ (((sb >> 9) & 1) << 5); R = (st >> 1) * 16 + swz / 64; C = (st & 1) * 32 + (swz % 64) / 2; }
__host__ __device__ __forceinline__ int perm32(int rho) { const int n = rho >> 4, i = rho & 15; return 8 * (i >> 2) + 4 * n + (i & 3); }

struct Unit { int pm, pn, e, mt, nv, aux, ar; };
struct Gemm { const bf16_t* A; const bf16_t* Bt; int K; size_t b_estride; };

__device__ __forceinline__ unsigned cvt_pk_bf16(float lo, float hi) { unsigned r; asm volatile("v_cvt_pk_bf16_f32 %0, %1, %2" : "=v"(r) : "v"(lo), "v"(hi)); return r; }
__device__ __forceinline__ float bf_lo(unsigned w) { return __builtin_bit_cast(float, w << 16); }
__device__ __forceinline__ float bf_hi(unsigned w) { return __builtin_bit_cast(float, w & 0xffff0000u); }
__device__ __forceinline__ float fast_sigmoid(float x) { return __builtin_amdgcn_rcpf(1.0f + __builtin_amdgcn_exp2f(-1.4426950408889634f * x)); }
__device__ __forceinline__ float gelu_tanh(float v) { const float y = 1.5957691216057308f * (v + 0.044715f * v * v * v); return v * fast_sigmoid(y); }

template <class Epi, class Sched, bool ALIGN_EPI, bool GATHER>
__device__ __forceinline__ void gemm_phase(PG8_LAS unsigned char* lds, const Gemm g, const Sched& S, const Epi& E) {
    const int tid = threadIdx.x, wid = __builtin_amdgcn_readfirstlane(tid >> 6), lane = tid & 63, wr = wid >> 2, wc = wid & 3, fr = lane & 15, fq = lane >> 4;
    const int K = g.K, nt = K / BK;
    unsigned voffA[2], voffB[2]; int RA[2]; unsigned CA2[2];
#pragma unroll
    for (int i = 0; i < 2; ++i) { int R, C; stage_rc(tid * 16 + i * 8192, R, C); const int Rb = Epi::PERM ? ((R & ~31) + perm32(R & 31)) : R;
        voffA[i] = (unsigned)(R * K + C) * 2u; voffB[i] = (unsigned)(Rb * K + C) * 2u; RA[i] = R; CA2[i] = (unsigned)C * 2u; }
    const size_t kstep = (size_t)(BK * 2);
    const size_t hstep = (size_t)HALF * K * 2;
    const size_t tstep = 2 * hstep;
    const unsigned ldsw = (unsigned)wid * 1024u;
    const int aoff = lds_byte(wr * 64 + fr, fq * 8), boff = lds_byte(wc * 32 + fr, fq * 8);
#define PG8_SA(b, h) (((b) * 2 + (h)) * HTB)
#define PG8_SB(b, h) ((4 + (b) * 2 + (h)) * HTB)
#define PG8_STAGE2(bufoff, gbase, v0, v1) do { \
        __builtin_amdgcn_global_load_lds((const unsigned*)((const char*)(gbase) + (v0)), (PG8_LAS unsigned*)(lds + (bufoff) + ldsw), 16, 0, 0); \
        __builtin_amdgcn_global_load_lds((const unsigned*)((const char*)(gbase) + (v1)), (PG8_LAS unsigned*)(lds + (bufoff) + ldsw + 8192), 16, 0, 0); } while (0)
#define PG8_STAGEB(bufoff, gbase) PG8_STAGE2(bufoff, gbase, voffB[0], voffB[1])
#define PG8_LDA(dst, b, h) do { _Pragma("unroll") for (int m = 0; m < 4; ++m) _Pragma("unroll") for (int k = 0; k < 2; ++k) dst[m][k] = *(const PG8_LAS bf16x8*)(lds + PG8_SA(b, h) + aoff + m * 2048 + k * 1024); } while (0)
#define PG8_LDB(dst, b, h) do { _Pragma("unroll") for (int n = 0; n < 2; ++n) _Pragma("unroll") for (int k = 0; k < 2; ++k) dst[n][k] = *(const PG8_LAS bf16x8*)(lds + PG8_SB(b, h) + boff + n * 2048 + k * 1024); } while (0)
#define PG8_MMA(ai, bj, At, Bt) do { __builtin_amdgcn_s_setprio(1); _Pragma("unroll") for (int m = 0; m < 4; ++m) _Pragma("unroll") for (int n = 0; n < 2; ++n) _Pragma("unroll") for (int k = 0; k < 2; ++k) \
        acc[ai][bj][m][n] = __builtin_amdgcn_mfma_f32_16x16x32_bf16(Bt[n][k], At[m][k], acc[ai][bj][m][n], 0, 0, 0); __builtin_amdgcn_s_setprio(0); } while (0)
#define PG8_WAIT_V(n) asm volatile("s_waitcnt vmcnt(" #n ")" ::: "memory")
#define PG8_WAIT_L(n) asm volatile("s_waitcnt lgkmcnt(" #n ")" ::: "memory")
#define PG8_BAR __builtin_amdgcn_s_barrier()
#define PG8_SCHED __builtin_amdgcn_sched_barrier(0)
    Unit cur, nxt; int ui = 0;
    if (!S.next(0, cur)) return;
    f32x4 acc[2][2][4][2];
#pragma unroll
    for (int a = 0; a < 2; ++a)
#pragma unroll
        for (int b = 0; b < 2; ++b)
#pragma unroll
            for (int m = 0; m < 4; ++m)
#pragma unroll
                for (int n = 0; n < 2; ++n) acc[a][b][m][n] = (f32x4){0.f, 0.f, 0.f, 0.f};
    bf16x8 At[4][2], B0[2][2], B1[2][2];
    const char* const gA = (const char*)g.A;
    unsigned roC[2][2], roN[2][2];
    const char* cA; const char* cB = (const char*)g.Bt + ((size_t)cur.e * g.b_estride) * 2 + (size_t)cur.pn * tstep;
    if constexpr (GATHER) {
#pragma unroll
        for (int h = 0; h < 2; ++h)
#pragma unroll
            for (int i = 0; i < 2; ++i) roC[h][i] = (unsigned)S.row_of(cur, h * HALF + RA[i]) * (unsigned)(K * 2) + CA2[i];
        cA = gA;
    } else {
#pragma unroll
        for (int h = 0; h < 2; ++h)
#pragma unroll
            for (int i = 0; i < 2; ++i) roC[h][i] = voffA[i] + (unsigned)(h * hstep);
        cA = gA + (size_t)cur.ar * (size_t)(K * 2);
    }
    S.a_ready(cur);
    PG8_STAGEB(PG8_SB(0, 0), cB); PG8_STAGEB(PG8_SB(0, 1), cB + hstep); PG8_STAGE2(PG8_SA(0, 0), cA, roC[0][0], roC[0][1]); PG8_STAGE2(PG8_SA(0, 1), cA, roC[1][0], roC[1][1]);
    if (wr == 1) PG8_BAR;
    PG8_WAIT_V(2); PG8_BAR;
    PG8_STAGEB(PG8_SB(1, 0), cB + kstep); PG8_STAGE2(PG8_SA(1, 0), cA + kstep, roC[0][0], roC[0][1]); PG8_STAGEB(PG8_SB(1, 1), cB + hstep + kstep);
    PG8_WAIT_V(6); PG8_BAR;
    for (;;) {
        const bool has_next = S.next(ui + 1, nxt);
        const char* nA; const char* nB = has_next ? (const char*)g.Bt + ((size_t)nxt.e * g.b_estride) * 2 + (size_t)nxt.pn * tstep : cB;
        if constexpr (GATHER) {
            nA = gA;
            if (has_next) {
#pragma unroll
                for (int h = 0; h < 2; ++h)
#pragma unroll
                    for (int i = 0; i < 2; ++i) roN[h][i] = (unsigned)S.row_of(nxt, h * HALF + RA[i]) * (unsigned)(K * 2) + CA2[i];
            } else {
#pragma unroll
                for (int h = 0; h < 2; ++h)
#pragma unroll
                    for (int i = 0; i < 2; ++i) roN[h][i] = roC[h][i];
            }
        } else {
            nA = has_next ? gA + (size_t)nxt.ar * (size_t)(K * 2) : cA;
        }
#pragma clang loop unroll(disable)
        for (int t = 0; t < nt; t += 2) {
            const bool last = (t == nt - 2);
            const char* a1 = cA + (size_t)(t + 1) * kstep;
            const char* a2 = last ? nA : cA + (size_t)(t + 2) * kstep; const char* b2 = last ? nB : cB + (size_t)(t + 2) * kstep;
            const char* a3 = a2 + kstep; const char* b3 = b2 + kstep;
            unsigned s00, s01, s10, s11;
            if constexpr (GATHER) { s00 = last ? roN[0][0] : roC[0][0]; s01 = last ? roN[0][1] : roC[0][1]; s10 = last ? roN[1][0] : roC[1][0]; s11 = last ? roN[1][1] : roC[1][1]; }
            else { s00 = roC[0][0]; s01 = roC[0][1]; s10 = roC[1][0]; s11 = roC[1][1]; }
            if (last && has_next) S.a_ready(nxt);
            if constexpr (Epi::MIDK > 0) { if (t == Epi::MIDK) E.mid(acc, cur, wr, wc, fr, fq); }
            PG8_LDB(B0, 0, 0); PG8_LDB(B1, 0, 1); PG8_SCHED; PG8_LDA(At, 0, 0); PG8_STAGE2(PG8_SA(1, 1), a1, roC[1][0], roC[1][1]);
            PG8_WAIT_V(8); PG8_WAIT_L(0); PG8_BAR; PG8_MMA(0, 0, At, B0); PG8_MMA(0, 1, At, B1); PG8_BAR; PG8_SCHED;
            PG8_LDA(At, 0, 1); PG8_STAGEB(PG8_SB(0, 0), b2); PG8_STAGEB(PG8_SB(0, 1), b2 + hstep); PG8_STAGE2(PG8_SA(0, 0), a2, s00, s01);
            PG8_WAIT_V(8); PG8_WAIT_L(0); PG8_BAR; PG8_MMA(1, 0, At, B0); PG8_MMA(1, 1, At, B1); PG8_BAR; PG8_SCHED;
            PG8_LDB(B0, 1, 0); PG8_LDB(B1, 1, 1); PG8_SCHED; PG8_LDA(At, 1, 0); PG8_STAGE2(PG8_SA(0, 1), a2, s10, s11);
            PG8_WAIT_V(8); PG8_WAIT_L(0); PG8_BAR; PG8_MMA(0, 0, At, B0); PG8_MMA(0, 1, At, B1); PG8_BAR; PG8_SCHED;
            PG8_LDA(At, 1, 1); PG8_STAGEB(PG8_SB(1, 0), b3); PG8_STAGEB(PG8_SB(1, 1), b3 + hstep); PG8_STAGE2(PG8_SA(1, 0), a3, s00, s01);
            PG8_WAIT_V(8); PG8_WAIT_L(0); PG8_BAR; PG8_MMA(1, 0, At, B0); PG8_MMA(1, 1, At, B1); PG8_BAR; PG8_SCHED;
        }
        if constexpr (ALIGN_EPI) { if (wr == 0) PG8_BAR; }
        E(acc, cur, wr, wc, fr, fq); S.done(cur);
        if (!has_next) break;
#pragma unroll
        for (int a = 0; a < 2; ++a)
#pragma unroll
            for (int b = 0; b < 2; ++b)
#pragma unroll
                for (int m = 0; m < 4; ++m)
#pragma unroll
                    for (int n = 0; n < 2; ++n) acc[a][b][m][n] = (f32x4){0.f, 0.f, 0.f, 0.f};
        cur = nxt; cA = nA; cB = nB; ++ui;
        if constexpr (GATHER) {
#pragma unroll
            for (int h = 0; h < 2; ++h)
#pragma unroll
                for (int i = 0; i < 2; ++i) roC[h][i] = roN[h][i];
        }
        if constexpr (ALIGN_EPI) { if (wr == 1) PG8_BAR; }
    }
    PG8_WAIT_V(0);
    if constexpr (!ALIGN_EPI) { if (wr == 0) PG8_BAR; }
    PG8_BAR;
#undef PG8_SA
#undef PG8_SB
#undef PG8_STAGE2
#undef PG8_STAGEB
#undef PG8_LDA
#undef PG8_LDB
#undef PG8_MMA
#undef PG8_WAIT_V
#undef PG8_WAIT_L
#undef PG8_BAR
#undef PG8_SCHED
}
}
namespace attn2 {
using bf16=__hip_bfloat16;
using bf16x8=__attribute__((ext_vector_type(8)))short;
using s16x4=__attribute__((ext_vector_type(4)))short;
using f32x16=__attribute__((ext_vector_type(16)))float;
using u32x4=__attribute__((ext_vector_type(4)))unsigned;
constexpr int BATCH=8,NHEAD=16,SEQ=4352,D=64,DM=NHEAD*D;
constexpr int NW=8,QBLK=32,QB=QBLK*NW,KVBLK=64,NQB=SEQ/QB;
constexpr int ATTN_PITCH=DM, ATTN_UNIT_ROWS=QB;
__device__ __forceinline__ int crow(int r,int hi){return (r&3)+8*(r>>2)+4*hi;}
#define SBAR() __builtin_amdgcn_sched_barrier(0)
__device__ __forceinline__ void cmask(f32x16&p0,f32x16&p1,int jb,int qrel,int hi){
  const float NEG=-INFINITY; int kb=64*jb+4*hi;
  #pragma unroll
  for(int r=0;r<16;++r){int kv=kb+(r&3)+8*(r>>2); if(kv>qrel)p0[r]=NEG; if(kv+32>qrel)p1[r]=NEG;}
}

constexpr int NSLOT=3, SLOTB=8192, QPW=4608;
constexpr int LDS_K=0, LDS_V=NSLOT*SLOTB, LDS_WS=3*NSLOT*SLOTB, LDS_QP=LDS_WS+NW*64*4, LDS_BYTES=LDS_QP+NW*QPW;
constexpr float C2=0.125f*1.4426950408889634f;
__device__ __forceinline__ void glds16(const void*gsrc,unsigned lds_dst){unsigned keep;
  asm volatile("s_mov_b32 %0, m0\n\ts_mov_b32 m0, %2\n\ts_nop 0\n\tglobal_load_lds_dwordx4 %1, off\n\ts_mov_b32 m0, %0":"=&s"(keep):"v"(gsrc),"s"(lds_dst):"memory");}
__device__ __forceinline__ float max3f(float a,float b,float c){float r;asm("v_max3_f32 %0, %1, %2, %3":"=v"(r):"v"(a),"v"(b),"v"(c));return r;}
__device__ __forceinline__ float max2f(float a,float b){float r;asm("v_max_f32_e32 %0, %1, %2":"=v"(r):"v"(a),"v"(b));return r;}
__device__ __forceinline__ float fadd_s(float a,float b){float r;asm("v_add_f32_e32 %0, %1, %2":"=v"(r):"v"(a),"v"(b));return r;}
__device__ __forceinline__ float fsub_s(float a,float b){float r;asm("v_sub_f32_e32 %0, %1, %2":"=v"(r):"v"(a),"v"(b));return r;}
typedef float f32x2_t __attribute__((ext_vector_type(2))); typedef __bf16 bf16x2_t __attribute__((ext_vector_type(2)));
__device__ __forceinline__ unsigned cvtpk_s(float lo,float hi){f32x2_t v={lo,hi};bf16x2_t b=__builtin_convertvector(v,bf16x2_t);return __builtin_bit_cast(unsigned,b);}
#define WAIT_BAR(N) asm volatile("s_waitcnt vmcnt(" #N ") lgkmcnt(0)\n\ts_barrier":::"memory")

__device__ __forceinline__ void qkt(f32x16&p0,f32x16&p1,const char*Kslot,const bf16x8*qr,int r32,int hi){ const f32x16 negm=f32x16{};
  const char*kb=Kslot+hi*1024+r32*16;
  #pragma unroll
  for(int d0=0;d0<4;++d0){
    const bf16x8 b0=*reinterpret_cast<const bf16x8*>(kb+d0*2048);
    const bf16x8 b1=*reinterpret_cast<const bf16x8*>(kb+d0*2048+512);
    if(d0==0){p0=__builtin_amdgcn_mfma_f32_32x32x16_bf16(b0,qr[0],negm,0,0,0);p1=__builtin_amdgcn_mfma_f32_32x32x16_bf16(b1,qr[0],negm,0,0,0);}
    else{p0=__builtin_amdgcn_mfma_f32_32x32x16_bf16(b0,qr[d0],p0,0,0,0);p1=__builtin_amdgcn_mfma_f32_32x32x16_bf16(b1,qr[d0],p1,0,0,0);}}
}
typedef __attribute__((address_space(3))) const char* lds_cptr;
typedef short v4i16_t __attribute__((ext_vector_type(4)));
__device__ __forceinline__ void kload8(bf16x8*kf,lds_cptr kp){
  kf[0]=*(const __attribute__((address_space(3))) bf16x8*)(kp);      kf[1]=*(const __attribute__((address_space(3))) bf16x8*)(kp+512);
  kf[2]=*(const __attribute__((address_space(3))) bf16x8*)(kp+2048); kf[3]=*(const __attribute__((address_space(3))) bf16x8*)(kp+2560);
  kf[4]=*(const __attribute__((address_space(3))) bf16x8*)(kp+4096); kf[5]=*(const __attribute__((address_space(3))) bf16x8*)(kp+4608);
  kf[6]=*(const __attribute__((address_space(3))) bf16x8*)(kp+6144); kf[7]=*(const __attribute__((address_space(3))) bf16x8*)(kp+6656);
}
__device__ __forceinline__ void kload2(bf16x8*kf,lds_cptr kp,int j){ kf[2*j]=*(const __attribute__((address_space(3))) bf16x8*)(kp+j*2048); kf[2*j+1]=*(const __attribute__((address_space(3))) bf16x8*)(kp+j*2048+512); }
__device__ __forceinline__ s16x4 vtr(lds_cptr p){ return __builtin_bit_cast(s16x4,__builtin_amdgcn_ds_read_tr16_b64_v4i16((__attribute__((address_space(3))) v4i16_t*)p)); }
__device__ __forceinline__ float rowmax(const f32x16&p0,const f32x16&p1){
  float a=max3f(p0[0],p0[1],p1[0]),b=max3f(p0[2],p0[3],p1[1]);a=max3f(a,p1[2],p1[3]);
  #pragma unroll
  for(int r=4;r<16;r+=4){a=max3f(a,p0[r],p0[r+1]);b=max3f(b,p0[r+2],p0[r+3]);a=max3f(a,p1[r],p1[r+1]);b=max3f(b,p1[r+2],p1[r+3]);}
  const float m=max2f(a,b);
  auto rr=__builtin_amdgcn_permlane32_swap(__float_as_uint(m),__float_as_uint(m),false,false);
  return max2f(__uint_as_float(rr[0]),__uint_as_float(rr[1]));
}
__device__ __forceinline__ void pv(f32x16*o,int vb,bf16x8 pa0,bf16x8 pa1,bf16x8 pa2,bf16x8 pa3){
  #pragma unroll
  for(int d0=0;d0<4;++d0){s16x4 lo[4],hi[4];
    #pragma unroll
    for(int ks=0;ks<4;++ks){
      asm volatile("ds_read_b64_tr_b16 %0,%1 offset:%c2":"=&v"(lo[ks]):"v"(vb),"i"(d0*4096+ks*1024):"memory");
      asm volatile("ds_read_b64_tr_b16 %0,%1 offset:%c2":"=&v"(hi[ks]):"v"(vb),"i"(d0*4096+ks*1024+512):"memory");}
    asm volatile("s_waitcnt lgkmcnt(0)":::"memory");SBAR();
    #define PK(k) (bf16x8){lo[k][0],lo[k][1],lo[k][2],lo[k][3],hi[k][0],hi[k][1],hi[k][2],hi[k][3]}
    o[d0]=__builtin_amdgcn_mfma_f32_32x32x16_bf16(pa0,PK(0),o[d0],0,0,0);
    o[d0]=__builtin_amdgcn_mfma_f32_32x32x16_bf16(pa1,PK(1),o[d0],0,0,0);
    o[d0]=__builtin_amdgcn_mfma_f32_32x32x16_bf16(pa2,PK(2),o[d0],0,0,0);
    o[d0]=__builtin_amdgcn_mfma_f32_32x32x16_bf16(pa3,PK(3),o[d0],0,0,0);
    #undef PK
  }
}

#ifndef ATTN_STORE16
#define ATTN_STORE16(p,v) (*(u32x4*)(p)=(v))
#endif
template<int THRL> __device__ __forceinline__ void attn_unit(int b,int h,int hv,int qb,const bf16*Q,const bf16*__restrict__ K,const bf16*__restrict__ V,bf16*O,char*shm){
  const int tid=threadIdx.x,lane=tid&63,r32=lane&31,hi=lane>>5; const int wid=__builtin_amdgcn_readfirstlane(tid>>6);
  const long rowbase=(long)b*SEQ; const int q0=qb*QB;
  const bf16*Qw=Q+(rowbase+q0+wid*QBLK)*DM+h*D;
  const bf16*Kh=K+rowbase*DM+h*D,*Vh=V+rowbase*DM+hv*128;
  const unsigned lds0=(unsigned)(uintptr_t)shm;
  float*wsf=(float*)(shm+LDS_WS)+wid*64;
  const bf16*ksrc=Kh+(long)lane*DM+wid*8;
  const bf16*vsrc=Vh+(long)(16*(wid&3)+(lane>>2))*DM+(wid>>2)*32+(lane&3)*8;
  const unsigned kdst=lds0+LDS_K+wid*1024, vdst=lds0+LDS_V+wid*1024;
  #define DMA_K(t,slot) glds16(ksrc+(long)(t)*KVBLK*DM,(unsigned)__builtin_amdgcn_readfirstlane(kdst+(slot)))
  #define DMA_V(t,slot) do{ glds16(vsrc+(long)(t)*KVBLK*DM,(unsigned)__builtin_amdgcn_readfirstlane(vdst+2*(slot))); glds16(vsrc+64+(long)(t)*KVBLK*DM,(unsigned)__builtin_amdgcn_readfirstlane(vdst+2*(slot)+8192)); }while(0)
  const int vb0=(int)(lds0+LDS_V)+((lane>>4)&1)*32+(lane&3)*8+(4*hi+((lane&15)>>2))*64;
  const char*Kbase=shm+LDS_K; bf16x8 kf[8];
  const lds_cptr shm3=(lds_cptr)shm; const lds_cptr kp0=shm3+LDS_K+hi*1024+r32*16; const lds_cptr vp0=shm3+LDS_V+((lane>>4)&1)*32+(lane&3)*8+(4*hi+((lane&15)>>2))*64;
  const int NT=(q0+QB)/KVBLK;
  DMA_K(0,0);DMA_V(0,0);DMA_K(1,SLOTB);
  typedef __attribute__((address_space(3))) bf16x8* lds_q8; const lds_q8 qpl=(lds_q8)((__attribute__((address_space(3))) char*)shm3+LDS_QP+wid*QPW+r32*144+hi*16);
  { bf16x8 qr[4];
  #pragma unroll
  for(int d0=0;d0<4;++d0)qr[d0]=*reinterpret_cast<const bf16x8*>(&Qw[(long)r32*DM+d0*16+hi*8]);
  #pragma unroll
  for(int d0=0;d0<4;++d0)qpl[2*d0]=qr[d0]; }
  float mhat=0.f,l_reg=0.f;f32x16 o[4];o[0]=f32x16{};o[1]=f32x16{};o[2]=f32x16{};o[3]=f32x16{};
  const int qrel=wid*QBLK+r32;
  #define CMASK(P0,P1,t) do{int jb_=(t)-(NT-4); if(jb_>=0)cmask(P0,P1,jb_,qrel,hi);}while(0)
  bool resc=false;
  #define START(P0,P1) do{ const float rm=rowmax(P0,P1); resc=false; mhat=rm; \
    _Pragma("unroll") for(int r=0;r<16;++r)P0[r]=__builtin_amdgcn_exp2f(P0[r]-mhat); }while(0)
  #define RESC() do{ if(resc){ asm volatile("s_waitcnt lgkmcnt(0)":::"memory"); \
      _Pragma("unroll") for(int d_=0;d_<4;++d_) _Pragma("unroll") for(int r=0;r<16;++r)o[d_][r]*=wsf[crow(r,hi)]; } }while(0)
  f32x16 pA0,pA1,pB0,pB1;
  int sl_prev=0,sl_cur=0,sl_next=SLOTB;
  #define ROT() do{sl_prev=sl_cur;sl_cur=sl_next;sl_next=(sl_next==(NSLOT-1)*SLOTB)?0:sl_next+SLOTB;}while(0)
  DMA_K(2,2*SLOTB);
  WAIT_BAR(4);
  { bf16x8 qf[4]; _Pragma("unroll") for(int d0=0;d0<4;++d0)qf[d0]=qpl[2*d0]; qkt(pA0,pA1,Kbase,qf,r32,hi); } asm volatile("s_nop 15\n\ts_nop 7":"+v"(pA0),"+v"(pA1));CMASK(pA0,pA1,0);
  START(pA0,pA1);
  _Pragma("unroll") for(int r=0;r<16;++r)pA1[r]=__builtin_amdgcn_exp2f(pA1[r]-mhat);
  WAIT_BAR(0);
  DMA_K(3,0);DMA_V(1,SLOTB);
  ROT();
  kload8(kf,kp0+sl_cur);
  WAIT_BAR(3);
  s16x4 vlo[8],vhi[8],wlo[8],whi[8]; u32x4 pw0,pw1,pw2,pw3; const f32x16 zero16=f32x16{};
  #define PKW(P,B) cvtpk_s(P[B],P[B+1])
  #define PAF(k) __builtin_bit_cast(bf16x8,pw##k)
  #define VFR(i) (bf16x8){vlo[i][0],vlo[i][1],vlo[i][2],vlo[i][3],vhi[i][0],vhi[i][1],vhi[i][2],vhi[i][3]}
  #define PIN(x) asm volatile("":"+v"(x))
  #define MX3(a,b,c) __builtin_fmaxf(__builtin_fmaxf((a),(b)),(c))
  #define GAPA(MF,A0,A1,A2,A3,W0,W1,PW) do{ MF; sacc+=A0; sacc+=A1; sacc+=A2; sacc+=A3; PIN(sacc); W0; W1; PIN(PW); SBAR(); }while(0)
  #define EX(v) __builtin_amdgcn_exp2f(v)
  #define EXM(v) __builtin_amdgcn_exp2f((v)-mhat)
  #define GAPB2(MF,X,B) do{ MF; X[B]=EXM(X[B]); X[B+1]=EXM(X[B+1]); PIN(X); SBAR(); }while(0)
  #define VRD2(i) do{ wlo[i]=vtr(vp_+((((i)>>2)+2)*4096+((i)&3)*1024)); whi[i]=vtr(vp_+((((i)>>2)+2)*4096+((i)&3)*1024+512)); }while(0)
  #define WFR(i) (bf16x8){wlo[i][0],wlo[i][1],wlo[i][2],wlo[i][3],whi[i][0],whi[i][1],whi[i][2],whi[i][3]}
  #define VRD(i) do{ vlo[i]=vtr(vp_+(((i)>>2)*4096+((i)&3)*1024)); vhi[i]=vtr(vp_+(((i)>>2)*4096+((i)&3)*1024+512)); }while(0)
  #define KRD(G,j) do{ if(G){ kload2(kf,kp0+sl_next,j); SBAR(); } }while(0)
  #define STEP(C0,C1,P0,P1,t,GK,GV,GL) do{ SBAR(); \
    const lds_cptr vp_=vp0+2*sl_prev; const bf16x8 qf0=qpl[0],qf1=qpl[2],qf2=qpl[4],qf3=qpl[6]; \
    VRD(0); SBAR(); float sacc=(P0[0]+P0[1]); \
    GAPA(C0=__builtin_amdgcn_mfma_f32_32x32x16_bf16(kf[0],qf0,zero16,0,0,0), P0[2],P0[3],P0[4],P0[5],     pw0[0]=PKW(P0,0), pw0[1]=PKW(P0,2), pw0); \
    VRD(4); SBAR(); GAPA(C1=__builtin_amdgcn_mfma_f32_32x32x16_bf16(kf[1],qf0,zero16,0,0,0), P0[6],P0[7],P0[8],P0[9],     pw0[2]=PKW(P0,4), pw0[3]=PKW(P0,6), pw0); \
    VRD(1); SBAR(); GAPA(C0=__builtin_amdgcn_mfma_f32_32x32x16_bf16(kf[2],qf1,C0,0,0,0),   P0[10],P0[11],P0[12],P0[13], pw1[0]=PKW(P0,8), pw1[1]=PKW(P0,10), pw1); \
    VRD(5); SBAR(); GAPA(C1=__builtin_amdgcn_mfma_f32_32x32x16_bf16(kf[3],qf1,C1,0,0,0),   P0[14],P0[15],P1[0],P1[1],   pw1[2]=PKW(P0,12),pw1[3]=PKW(P0,14), pw1); \
    VRD(2); SBAR(); GAPA(C0=__builtin_amdgcn_mfma_f32_32x32x16_bf16(kf[4],qf2,C0,0,0,0),   P1[2],P1[3],P1[4],P1[5],     pw2[0]=PKW(P1,0), pw2[1]=PKW(P1,2), pw2); \
    VRD(6); SBAR(); GAPA(C1=__builtin_amdgcn_mfma_f32_32x32x16_bf16(kf[5],qf2,C1,0,0,0),   P1[6],P1[7],P1[8],P1[9],     pw2[2]=PKW(P1,4), pw2[3]=PKW(P1,6), pw2); \
    VRD(3); SBAR(); GAPA(C0=__builtin_amdgcn_mfma_f32_32x32x16_bf16(kf[6],qf3,C0,0,0,0),   P1[10],P1[11],P1[12],P1[13], pw3[0]=PKW(P1,8), pw3[1]=PKW(P1,10), pw3); \
    VRD(7); SBAR(); GAPA(C1=__builtin_amdgcn_mfma_f32_32x32x16_bf16(kf[7],qf3,C1,0,0,0),   P1[14],P1[15],0.f,0.f,       pw3[2]=PKW(P1,12),pw3[3]=PKW(P1,14), pw3); \
    l_reg+=sacc; \
    if(GK){DMA_K((t)+3,sl_cur);} if(GV){DMA_V((t)+1,sl_next);} \
    CMASK(C0,C1,t); \
    { float a=MX3(C0[0],C0[1],C1[0]),b=MX3(C0[2],C0[3],C1[1]); a=MX3(a,C1[2],C1[3]); \
      _Pragma("unroll") for(int r=4;r<16;r+=4){a=MX3(a,C0[r],C0[r+1]);b=MX3(b,C0[r+2],C0[r+3]);a=MX3(a,C1[r],C1[r+1]);b=MX3(b,C1[r+2],C1[r+3]);} \
      float rm=__builtin_fmaxf(a,b); { auto rr=__builtin_amdgcn_permlane32_swap(__float_as_uint(rm),__float_as_uint(rm),false,false); rm=__builtin_fmaxf(__uint_as_float(rr[0]),__uint_as_float(rr[1])); } \
      rm-=mhat; resc=false; \
      if(__builtin_expect(__any(rm>(float)THRL),0)){ const float dl=__builtin_fmaxf(rm,0.f); mhat+=dl; \
        const float f=__builtin_amdgcn_exp2f(-dl); l_reg*=f; if(hi==0)wsf[r32]=f; resc=true; } } \
    SBAR(); \
    VRD2(0); SBAR(); GAPB2(o[0]=__builtin_amdgcn_mfma_f32_32x32x16_bf16(PAF(0),VFR(0),o[0],0,0,0), C0,0); \
    VRD2(4); SBAR(); GAPB2(o[1]=__builtin_amdgcn_mfma_f32_32x32x16_bf16(PAF(0),VFR(4),o[1],0,0,0), C0,2); \
    KRD(GL,0); VRD2(1); SBAR(); GAPB2(o[0]=__builtin_amdgcn_mfma_f32_32x32x16_bf16(PAF(1),VFR(1),o[0],0,0,0), C0,4); \
    KRD(GL,1); VRD2(5); SBAR(); GAPB2(o[1]=__builtin_amdgcn_mfma_f32_32x32x16_bf16(PAF(1),VFR(5),o[1],0,0,0), C0,6); \
    KRD(GL,2); VRD2(2); SBAR(); GAPB2(o[0]=__builtin_amdgcn_mfma_f32_32x32x16_bf16(PAF(2),VFR(2),o[0],0,0,0), C0,8); \
    KRD(GL,3); VRD2(6); SBAR(); GAPB2(o[1]=__builtin_amdgcn_mfma_f32_32x32x16_bf16(PAF(2),VFR(6),o[1],0,0,0), C0,10); \
    VRD2(3); SBAR(); GAPB2(o[0]=__builtin_amdgcn_mfma_f32_32x32x16_bf16(PAF(3),VFR(3),o[0],0,0,0), C0,12); \
    VRD2(7); SBAR(); GAPB2(o[1]=__builtin_amdgcn_mfma_f32_32x32x16_bf16(PAF(3),VFR(7),o[1],0,0,0), C0,14); \
    GAPB2(o[2]=__builtin_amdgcn_mfma_f32_32x32x16_bf16(PAF(0),WFR(0),o[2],0,0,0), C1,0); \
    GAPB2(o[3]=__builtin_amdgcn_mfma_f32_32x32x16_bf16(PAF(0),WFR(4),o[3],0,0,0), C1,2); \
    GAPB2(o[2]=__builtin_amdgcn_mfma_f32_32x32x16_bf16(PAF(1),WFR(1),o[2],0,0,0), C1,4); \
    GAPB2(o[3]=__builtin_amdgcn_mfma_f32_32x32x16_bf16(PAF(1),WFR(5),o[3],0,0,0), C1,6); \
    GAPB2(o[2]=__builtin_amdgcn_mfma_f32_32x32x16_bf16(PAF(2),WFR(2),o[2],0,0,0), C1,8); \
    GAPB2(o[3]=__builtin_amdgcn_mfma_f32_32x32x16_bf16(PAF(2),WFR(6),o[3],0,0,0), C1,10); \
    GAPB2(o[2]=__builtin_amdgcn_mfma_f32_32x32x16_bf16(PAF(3),WFR(3),o[2],0,0,0), C1,12); \
    GAPB2(o[3]=__builtin_amdgcn_mfma_f32_32x32x16_bf16(PAF(3),WFR(7),o[3],0,0,0), C1,14); \
    }while(0)
  int t=1;
  #undef CMASK
  #define CMASK(P0,P1,t) do{}while(0)
  for(;t+5<NT;t+=2){
    STEP(pB0,pB1,pA0,pA1,t,true,true,true);     WAIT_BAR(3); RESC(); ROT();
    STEP(pA0,pA1,pB0,pB1,t+1,true,true,true);   WAIT_BAR(3); RESC(); ROT();
  }
  #undef CMASK
  #define CMASK(P0,P1,t) do{int jb_=(t)-(NT-4); if(jb_>=0)cmask(P0,P1,jb_,qrel,hi);}while(0)
  #define ENDW(tt) do{ if((tt)+3<NT){WAIT_BAR(3);} else if((tt)+2<NT){WAIT_BAR(2);} else {WAIT_BAR(0);} }while(0)
  for(;t+1<NT;t+=2){
    STEP(pB0,pB1,pA0,pA1,t,(t+3<NT),(t+1<NT),(t+1<NT));       ENDW(t);   RESC(); ROT();
    STEP(pA0,pA1,pB0,pB1,t+1,(t+4<NT),(t+2<NT),(t+2<NT));     ENDW(t+1); RESC(); ROT();
  }
  STEP(pB0,pB1,pA0,pA1,NT-1,false,false,false); RESC();
  { float sacc=pB0[0]+pB0[1]; _Pragma("unroll") for(int r=2;r<16;++r)sacc+=pB0[r]; _Pragma("unroll") for(int r=0;r<16;++r)sacc+=pB1[r]; l_reg+=sacc;
    pw0=(u32x4){PKW(pB0,0),PKW(pB0,2),PKW(pB0,4),PKW(pB0,6)};pw1=(u32x4){PKW(pB0,8),PKW(pB0,10),PKW(pB0,12),PKW(pB0,14)};pw2=(u32x4){PKW(pB1,0),PKW(pB1,2),PKW(pB1,4),PKW(pB1,6)};pw3=(u32x4){PKW(pB1,8),PKW(pB1,10),PKW(pB1,12),PKW(pB1,14)};
    SBAR(); pv(o,vb0+2*sl_cur,PAF(0),PAF(1),PAF(2),PAF(3)); }
  #undef PKW
  #undef PAF
  #undef VFR
  #undef PIN
  #undef MX3
  #undef GAPA
  #undef GAPB2
  #undef EXM
  #undef VRD2
  #undef WFR
  #undef EX
  #undef VRD
  #undef KRD
  #undef STEP
  #undef ENDW
  {auto rr=__builtin_amdgcn_permlane32_swap(__float_as_uint(l_reg),__float_as_uint(l_reg),false,false);l_reg=__uint_as_float(rr[0])+__uint_as_float(rr[1]);}
  if(hi==0)wsf[32+r32]=l_reg;asm volatile("s_waitcnt lgkmcnt(0)":::"memory");
  float rli[16];
  #pragma unroll
  for(int r=0;r<16;++r)rli[r]=__builtin_amdgcn_rcpf(wsf[32+crow(r,hi)]);
  bf16*Ow=O+(rowbase+q0+wid*QBLK)*DM+hv*128;
  asm volatile("s_waitcnt lgkmcnt(0)\n\ts_barrier":::"memory");
  { bf16*stg=(bf16*)(shm)+wid*4096;
    int r32e=(int)(threadIdx.x&31u); asm volatile("":"+v"(r32e));
    #pragma unroll
    for(int r=0;r<16;++r){const int orow=crow(r,hi);
      #pragma unroll
      for(int d0=0;d0<4;++d0)stg[orow*128+d0*32+r32e]=__float2bfloat16(o[d0][r]*rli[r]);}
    asm volatile("s_waitcnt lgkmcnt(0)":::"memory");
    #pragma unroll
    for(int i=0;i<8;++i){const int row=i*4+(lane>>4),ch=lane&15; const u32x4 v=*(const u32x4*)(stg+row*128+ch*8); ATTN_STORE16(Ow+(long)row*DM+ch*8,v);} }
  asm volatile("s_waitcnt lgkmcnt(0)\n\ts_barrier":::"memory");
  #undef DMA_K
  #undef DMA_V
  #undef CMASK
  #undef START
  #undef RESC
  #undef ROT
}
constexpr int ATTN_LDS_BYTES=LDS_BYTES;
struct AttnTensors { const bf16* Q; const bf16* K; const bf16* V; bf16* O; };
struct AttnUnit { int b; int hq; int hv; int qb; };
struct SplitOrder {
  int b, hq, hv, part;
  __device__ __forceinline__ bool next(int i,AttnUnit&u)const{ if(i>=9-part)return false; u.b=b; u.hq=hq; u.hv=hv; u.qb=16-2*i-((i&1)^part); return true; }
};
template<class Sched,int THRL=8> __device__ __forceinline__ void attn_phase(char*lds,const AttnTensors&T,const Sched&S){
  AttnUnit u;
  for(int i=0;S.next(i,u);++i){ attn_unit<THRL>(u.b,u.hq,u.hv,u.qb,T.Q,T.K,T.V,T.O,lds); }
}
#undef SBAR
#undef WAIT_BAR
}

constexpr int NWAVES = 8;
#ifndef MK_N_LAUNCHES
#define MK_N_LAUNCHES 1
#endif
#ifndef MK_DIAG
#define MK_DIAG 0
#endif
constexpr int NPHASE = 14;
constexpr int N_LAUNCHES = MK_N_LAUNCHES;

constexpr int NB = 8, SEQ = 4096, NMETA = 16, TV = NMETA + SEQ, TA = 4352, MA = NB * TA, D = 1024;
constexpr int NIN = 7168, NE = 256, TOPK = 8, DE = 256;
constexpr int NCHUNK = 33;
constexpr float LN_EPS = 1e-5f, ALPHA = 1.189207115002721f;
constexpr float ROUTED_SCALE = 2.5f, LAMBDA_INIT = 0.2f, YSCALE = 16.0f;
constexpr int CAP = 32768;
constexpr int NVALID = NB * SEQ;
constexpr int YSHARED = NVALID * TOPK, YDUMMY = NVALID * (TOPK + 1);

constexpr size_t MiB = 1u << 20;
constexpr size_t SLOTB = 68 * MiB;
static_assert((size_t)MA * D * 2 == SLOTB, "slot size");
constexpr size_t WS_CTL = 0, CTL_ZERO_BYTES = 1 * MiB;
constexpr size_t WS_ROWSTAT = 1 * MiB;
constexpr size_t WS_SCANSUM = 1 * MiB + 320 * 1024;
constexpr size_t WS_LRUWT = 4 * MiB - 512 * 1024;
constexpr size_t WS_S0 = 26 * MiB;
#define WS_SLOT(i) (WS_S0 + (size_t)(i) * SLOTB)
constexpr size_t WS_XN = WS_SLOT(0), WS_XR = WS_SLOT(1), WS_YG = WS_SLOT(2), WS_Q = WS_SLOT(3), WS_K = WS_SLOT(4), WS_V = WS_SLOT(5), WS_GR = WS_SLOT(6), WS_GA = WS_SLOT(7),
                 WS_RA = WS_SLOT(8)  , WS_O0 = WS_SLOT(10), WS_O1 = WS_SLOT(11);
constexpr size_t WS_T1 = WS_SLOT(0), WS_U = WS_SLOT(1), WS_Z = WS_SLOT(2)  , WS_LOGITS = WS_SLOT(5);
constexpr size_t WS_LIST = 262 * MiB;
constexpr size_t WS_WGU = 4 * MiB;
constexpr size_t WS_WD = 596 * MiB;
constexpr size_t WS_ACT = 725 * MiB;
constexpr size_t WS_H1B = 905 * MiB;
constexpr size_t WS_TOKSLOT = 973 * MiB;
constexpr size_t WS_TOKW = 975 * MiB + 256 * 1024;
constexpr size_t WS_WIN = 978 * MiB, WS_WR = 992 * MiB, WS_WA = 994 * MiB, WS_WO = 996 * MiB, WS_WROUT = 998 * MiB;
constexpr size_t WS_Y = 4 * MiB;
constexpr size_t WS_END = 1000 * MiB;
constexpr int MAXTILES = 1408;
static_assert(WS_Y + ((size_t)NVALID * 9 + 1) * D * 2 <= WS_WD && WS_WD + (size_t)257 * 1024 * 256 * 2 <= WS_ACT && WS_ACT + (size_t)MAXTILES * 256 * 256 * 2 <= WS_H1B, "moe map");
static_assert(WS_WGU + (size_t)257 * 512 * 1024 * 2 <= WS_LIST && WS_LIST + (size_t)NE * CAP * 4 <= WS_SLOT(4), "moe map 2");
static_assert(WS_SLOT(12) <= WS_H1B && WS_TOKW + (size_t)MA * 16 * 4 <= WS_WIN, "map 3");
constexpr int CW_TMO = 0, CW_CODE = 1;
constexpr int CW_BAR = 4096;
constexpr int CW_CNT = 16384;
constexpr int CW_DIAG = 20480;
constexpr int CW_QUEUE = 24576;

constexpr int RING_OFF = 0, RING_BYTES = 131072;
constexpr int LDSCTL_OFF = RING_BYTES, MISC_OFF = LDSCTL_OFF + 320;
constexpr int TT_OFF = LDSCTL_OFF + 1024;
constexpr int UB_OFF = TT_OFF + MAXTILES * 4;
constexpr int LDS_BYTES = 147456;
constexpr int CN_OFF = UB_OFF + 260 * 4, TB_OFF = CN_OFF + 260 * 4;
static_assert(TB_OFF + 260 * 4 <= LDS_BYTES, "LDS map");

#define GAS __attribute__((address_space(1)))
#define LAS __attribute__((address_space(3)))
typedef unsigned short bf16;
typedef unsigned v4u __attribute__((ext_vector_type(4)));
typedef float f32x4 __attribute__((ext_vector_type(4)));
typedef short bf16x8 __attribute__((ext_vector_type(8)));
typedef GAS unsigned gu32;
typedef GAS unsigned long long gu64;
#define RLX_AGENT __ATOMIC_RELAXED, __HIP_MEMORY_SCOPE_AGENT
#define LDS_WAIT() asm volatile("s_waitcnt lgkmcnt(0)" ::: "memory")
#define VM_WAIT() asm volatile("s_waitcnt vmcnt(0)" ::: "memory")
__device__ __forceinline__ unsigned long long rt() { return __builtin_amdgcn_s_memrealtime(); }
typedef float pkf2_t __attribute__((ext_vector_type(2))); typedef __bf16 pkb2_t __attribute__((ext_vector_type(2)));
__device__ __forceinline__ unsigned pk2(float lo, float hi) { pkf2_t v = {lo, hi}; pkb2_t b = __builtin_convertvector(v, pkb2_t); return __builtin_bit_cast(unsigned, b); }
__device__ __forceinline__ unsigned f2bf(float f) { return pk2(f, 0.f) & 0xffffu; }

#define XB_TMO      128
#define XB_XCNT(j)  (256  + 64 * (j))
#define XB_XSUB(j)  (1280 + 64 * (j))
#define XB_XGEN(j)  (2304 + 64 * (j))
#define XB_TOP      3328
#define XB_TOPGEN   3392
#define XCD_BAR_WORDS 3456
#define XB_SPIN_CAP (1u << 18)

__device__ __forceinline__ unsigned xb_ld(unsigned* p)              { return __hip_atomic_load(p, __ATOMIC_RELAXED, __HIP_MEMORY_SCOPE_AGENT); }
__device__ __forceinline__ unsigned xb_add(unsigned* p, unsigned v) { return __hip_atomic_fetch_add(p, v, __ATOMIC_RELAXED, __HIP_MEMORY_SCOPE_AGENT); }
__device__ __forceinline__ unsigned xb_xcc_id() { return (unsigned)__builtin_amdgcn_s_getreg((3 << 11) | 20) & 0xFu; }
#define XB_SPIN(cond, bar) do { unsigned _sp = 0; while (cond) { __builtin_amdgcn_s_sleep(1); \
    if ((++_sp & 255u) == 0u) { if (xb_ld(&(bar)[XB_TMO])) break; if (_sp > XB_SPIN_CAP) { atomicAdd(&(bar)[XB_TMO], 1u); break; } } } } while (0)

struct XcdBarrier {
    unsigned* bar; unsigned x;
    volatile LAS unsigned* st;
};

__device__ __forceinline__ XcdBarrier xcd_barrier_post(unsigned* bar, volatile LAS unsigned* st) {
    XcdBarrier b; b.bar = bar; b.x = xb_xcc_id(); b.st = st;
    if (threadIdx.x == 0) (void)xb_add(&bar[XB_XCNT(b.x)], 1u);
    return b;
}
__device__ __forceinline__ void xcd_barrier_complete(unsigned* bar, unsigned x, unsigned& nloc, unsigned& nx) {
    const unsigned G = gridDim.x * gridDim.y * gridDim.z;
    unsigned sum, cnt, mine, sp = 0u;
    for (;;) {
        sum = 0u; cnt = 0u; mine = 0u;
#pragma unroll
        for (unsigned j = 0; j < 16; ++j) { const unsigned c = xb_ld(&bar[XB_XCNT(j)]); sum += c; cnt += (c > 0u) ? 1u : 0u; mine = (j == x) ? c : mine; }
        if (sum == G) break;
        __builtin_amdgcn_s_sleep(1);
        if ((++sp & 255u) == 0u) { if (xb_ld(&bar[XB_TMO])) break; if (sp > XB_SPIN_CAP) { atomicAdd(&bar[XB_TMO], 1u); break; } }
    }
    nloc = mine > 0u ? mine : 1u; nx = cnt > 0u ? cnt : 1u;
}

__device__ __forceinline__ void xcd_barrier(const XcdBarrier& b) {
    asm volatile("s_waitcnt vmcnt(0)" ::: "memory");
    __syncthreads();
    if (threadIdx.x == 0) {
        unsigned* bar = b.bar;
        __builtin_amdgcn_s_waitcnt(0);
        unsigned nloc = b.st[0], nx = b.st[1];
        if (nloc == 0u) { xcd_barrier_complete(bar, b.x, nloc, nx); b.st[0] = nloc; b.st[1] = nx; }
        const unsigned old = xb_add(&bar[XB_XSUB(b.x)], 1u);
        const unsigned gen = old / nloc;
        if (old + 1u == (gen + 1u) * nloc) {
            __builtin_amdgcn_fence(__ATOMIC_RELEASE, "agent");
            asm volatile("s_waitcnt vmcnt(0)" ::: "memory");
            const unsigned og = xb_add(&bar[XB_TOP], 1u);
            const unsigned tg = og / nx;
            if (og + 1u == (tg + 1u) * nx) xb_add(&bar[XB_TOPGEN], 1u);
            else XB_SPIN(xb_ld(&bar[XB_TOPGEN]) == tg, bar);
            __builtin_amdgcn_fence(__ATOMIC_ACQUIRE, "agent");
            xb_add(&bar[XB_XGEN(b.x)], 1u);
            asm volatile("s_waitcnt vmcnt(0)" ::: "memory");
        } else {
            XB_SPIN(xb_ld(&bar[XB_XGEN(b.x)]) == gen, bar);
            __builtin_amdgcn_fence(__ATOMIC_ACQUIRE, "agent");
            asm volatile("s_waitcnt vmcnt(0)" ::: "memory");
        }
    }
    __syncthreads();
}


__device__ __forceinline__ float wave_sum(float v) {
#pragma unroll
    for (int o = 1; o < 64; o <<= 1) v += __shfl_xor(v, o);
    return v;
}
__device__ __forceinline__ float bfl(unsigned w) { return __builtin_bit_cast(float, w << 16); }
__device__ __forceinline__ float bfh(unsigned w) { return __builtin_bit_cast(float, w & 0xffff0000u); }
__device__ __forceinline__ float bf1(bf16 h) { return __builtin_bit_cast(float, (unsigned)h << 16); }

struct DenseOrder {
    int nM, nN, nwg, G, c, valid;
    __device__ void init(int M, int N, int G_, int c_, int valid_ = 0) { nM = M / 256; nN = N / 256; nwg = nM * nN; G = G_; c = c_; valid = valid_; }
    __device__ bool next(int i, pg8::Unit& u) const {
        const long L = (long)i * G + c; if (L >= nwg) return false;
        int wgid = (int)L; { const int q = nwg / 8, r = nwg % 8, xcd = wgid % 8, off = wgid / 8; wgid = (xcd < r ? xcd * (q + 1) : r * (q + 1) + (xcd - r) * q) + off; }
        const int WGM = 4; const int nig = WGM * nN, gid = wgid / nig, fm = gid * WGM, gsz = (nM - fm) < WGM ? (nM - fm) : WGM;
        u.pm = fm + ((wgid % nig) % gsz); u.pn = (wgid % nig) / gsz; u.e = 0; u.mt = 0; u.nv = 256; u.aux = 0;
        u.ar = valid ? (u.pm >> 4) * TA + NMETA + (u.pm & 15) * 256 : u.pm * 256; return true;
    }
    __device__ __forceinline__ int row_of(const pg8::Unit&, int) const { return 0; }
    __device__ __forceinline__ void a_ready(const pg8::Unit&) const {}
    __device__ __forceinline__ void done(const pg8::Unit&) const {}
};
template <int NPN> struct MoeOrder {
    int ntiles, G, vcu; volatile LAS unsigned* TT; volatile LAS int* UB; volatile LAS int* CN; const int* list; int* tokslot; int write_slots;
    __device__ bool next(int i, pg8::Unit& u) const {
        const long L = (long)i * G + vcu; if (L >= (long)ntiles * NPN) return false;
        const int tile = (int)(L / NPN); u.pn = (int)(L % NPN); u.pm = tile;
        const unsigned tt = __builtin_amdgcn_readfirstlane(TT[tile]); u.e = (int)(tt & 0xffffu); u.mt = (int)(tt >> 16);
        const int ce = __builtin_amdgcn_readfirstlane(CN[u.e]);
        const int rem = ce - u.mt * 256; u.nv = rem < 256 ? rem : 256;
        u.aux = __builtin_amdgcn_readfirstlane(UB[u.e]) + u.mt * 256; u.ar = tile * 256; return true;
    }
    __device__ __forceinline__ int row_of(const pg8::Unit& u, int r) const {
        if (u.e == NE) return u.mt * 256 + r;
        return (r < u.nv) ? (list[(size_t)u.e * CAP + u.mt * 256 + r] >> 4) : 0;
    }
    __device__ __forceinline__ void a_ready(const pg8::Unit&) const {}
    __device__ __forceinline__ void done(const pg8::Unit& u) const {
        if (write_slots && u.pn == 0 && u.e < NE) { const int r = threadIdx.x; if (r < u.nv) { const int en = list[(size_t)u.e * CAP + u.mt * 256 + r]; tokslot[(size_t)(en >> 4) * 16 + (en & 15)] = u.aux + r; } }
    }
};

using pg8::u32x4;
typedef unsigned u32x2v __attribute__((ext_vector_type(2)));
typedef float f32x2v __attribute__((ext_vector_type(2)));
struct EpiIn {
    static constexpr bool PERM = true; static constexpr int MIDK = 0;
    bf16* base0; const float* b_gate; float qscale;
    __device__ __forceinline__ void operator()(const f32x4 (&acc)[2][2][4][2], const pg8::Unit& u, int wr, int wc, int fr, int fq) const {
        const int colt = u.pn * 256, t = colt >> 10, colw = colt & 1023;
        bf16* base = base0 + (size_t)t * (SLOTB / 2);
        const int row0 = u.pm * 256 + wr * 64 + fr, col0 = colw + wc * 32 + 8 * fq;
        f32x4 bv[2][2];
#pragma unroll
        for (int bj = 0; bj < 2; ++bj)
#pragma unroll
            for (int n = 0; n < 2; ++n) bv[bj][n] = (t >= 5) ? *(const f32x4*)(b_gate + (t - 5) * 1024 + col0 + bj * 128 + 4 * n) : (f32x4){0.f, 0.f, 0.f, 0.f};
#pragma unroll
        for (int ai = 0; ai < 2; ++ai)
#pragma unroll
            for (int m = 0; m < 4; ++m) { bf16* rowp = base + (size_t)(row0 + ai * 128 + m * 16) * D + col0;
#pragma unroll
                for (int bj = 0; bj < 2; ++bj) { f32x4 v0 = acc[ai][bj][m][0], v1 = acc[ai][bj][m][1];
                    if (t == 1) {
#pragma unroll
                        for (int j = 0; j < 4; ++j) { v0[j] = pg8::gelu_tanh(v0[j]); v1[j] = pg8::gelu_tanh(v1[j]); }
                    } else if (t == 2) { v0 = v0 * qscale; v1 = v1 * qscale; }
                    else if (t >= 5) { v0 = v0 + bv[bj][0]; v1 = v1 + bv[bj][1];
#pragma unroll
                        for (int j = 0; j < 4; ++j) { v0[j] = pg8::fast_sigmoid(v0[j]); v1[j] = pg8::fast_sigmoid(v1[j]); } }
                    u32x4 w; w.x = pg8::cvt_pk_bf16(v0[0], v0[1]); w.y = pg8::cvt_pk_bf16(v0[2], v0[3]); w.z = pg8::cvt_pk_bf16(v1[0], v1[1]); w.w = pg8::cvt_pk_bf16(v1[2], v1[3]);
                    *(u32x4*)(rowp + bj * 128) = w; } }
    }
};
struct EpiGate {
    static constexpr bool PERM = true; static constexpr int MIDK = 0;
    const bf16* gate; const bf16* add; bf16* out;
    __device__ __forceinline__ void operator()(const f32x4 (&acc)[2][2][4][2], const pg8::Unit& u, int wr, int wc, int fr, int fq) const {
        const int rl = wr * 64 + fr, col0 = u.pn * 256 + wc * 32 + 8 * fq;
#pragma unroll
        for (int ai = 0; ai < 2; ++ai)
#pragma unroll
            for (int m = 0; m < 4; ++m) { const int r = rl + ai * 128 + m * 16; const size_t off = (size_t)(u.pm * 256 + r) * D + col0, goff = (size_t)(u.ar + r) * D + col0;
#pragma unroll
                for (int bj = 0; bj < 2; ++bj) { const f32x4 a0 = acc[ai][bj][m][0], a1 = acc[ai][bj][m][1];
                    const u32x4 gw = *(const u32x4*)(gate + goff + bj * 128);
                    u32x4 aw = (u32x4){0u, 0u, 0u, 0u}; if (add) aw = *(const u32x4*)(add + off + bj * 128);
                    const float r0 = bfl(aw.x) + bfl(gw.x) * a0[0], r1 = bfh(aw.x) + bfh(gw.x) * a0[1], r2 = bfl(aw.y) + bfl(gw.y) * a0[2], r3 = bfh(aw.y) + bfh(gw.y) * a0[3];
                    const float r4 = bfl(aw.z) + bfl(gw.z) * a1[0], r5 = bfh(aw.z) + bfh(gw.z) * a1[1], r6 = bfl(aw.w) + bfl(gw.w) * a1[2], r7 = bfh(aw.w) + bfh(gw.w) * a1[3];
                    u32x4 w; w.x = pg8::cvt_pk_bf16(r0, r1); w.y = pg8::cvt_pk_bf16(r2, r3); w.z = pg8::cvt_pk_bf16(r4, r5); w.w = pg8::cvt_pk_bf16(r6, r7);
                    *(u32x4*)(out + off + bj * 128) = w; } }
    }
};
struct EpiGate2 {
    static constexpr bool PERM = true; static constexpr int MIDK = 16;
    const bf16* gr; const bf16* ga; bf16* out;
    __device__ __forceinline__ void mid(f32x4 (&acc)[2][2][4][2], const pg8::Unit& u, int wr, int wc, int fr, int fq) const {
        int rl = wr * 64 + fr; asm volatile("" : "+v"(rl));
        const int col0 = u.pn * 256 + wc * 32 + 8 * fq;
#pragma unroll
        for (int ai = 0; ai < 2; ++ai)
#pragma unroll
            for (int m = 0; m < 4; ++m) { const size_t goff = (size_t)(u.ar + rl + ai * 128 + m * 16) * D + col0;
#pragma unroll
                for (int bj = 0; bj < 2; ++bj) { const u32x4 a = *(const u32x4*)(gr + goff + bj * 128), b = *(const u32x4*)(ga + goff + bj * 128);
                    f32x4 r0, r1;
                    r0[0] = bfl(a.x) * __builtin_amdgcn_rcpf(bfl(b.x)); r0[1] = bfh(a.x) * __builtin_amdgcn_rcpf(bfh(b.x)); r0[2] = bfl(a.y) * __builtin_amdgcn_rcpf(bfl(b.y)); r0[3] = bfh(a.y) * __builtin_amdgcn_rcpf(bfh(b.y));
                    r1[0] = bfl(a.z) * __builtin_amdgcn_rcpf(bfl(b.z)); r1[1] = bfh(a.z) * __builtin_amdgcn_rcpf(bfh(b.z)); r1[2] = bfl(a.w) * __builtin_amdgcn_rcpf(bfl(b.w)); r1[3] = bfh(a.w) * __builtin_amdgcn_rcpf(bfh(b.w));
                    acc[ai][bj][m][0] = acc[ai][bj][m][0] * r0; acc[ai][bj][m][1] = acc[ai][bj][m][1] * r1; }
                asm volatile("" ::: "memory"); }
    }
    __device__ __forceinline__ void operator()(const f32x4 (&acc)[2][2][4][2], const pg8::Unit& u, int wr, int wc, int fr, int fq) const {
        const int rl = wr * 64 + fr, col0 = u.pn * 256 + wc * 32 + 8 * fq;
#pragma unroll
        for (int ai = 0; ai < 2; ++ai)
#pragma unroll
            for (int m = 0; m < 4; ++m) { const int r = rl + ai * 128 + m * 16; const size_t off = (size_t)(u.pm * 256 + r) * D + col0, goff = (size_t)(u.ar + r) * D + col0;
#pragma unroll
                for (int bj = 0; bj < 2; ++bj) { const f32x4 a0 = acc[ai][bj][m][0], a1 = acc[ai][bj][m][1]; const u32x4 gw = *(const u32x4*)(ga + goff + bj * 128);
                    u32x4 w; w.x = pg8::cvt_pk_bf16(bfl(gw.x) * a0[0], bfh(gw.x) * a0[1]); w.y = pg8::cvt_pk_bf16(bfl(gw.y) * a0[2], bfh(gw.y) * a0[3]);
                    w.z = pg8::cvt_pk_bf16(bfl(gw.z) * a1[0], bfh(gw.z) * a1[1]); w.w = pg8::cvt_pk_bf16(bfl(gw.w) * a1[2], bfh(gw.w) * a1[3]);
                    *(u32x4*)(out + off + bj * 128) = w; } }
    }
};
struct EpiZ {
    static constexpr bool PERM = false; static constexpr int MIDK = 0;
    const float* x; const float* g0; const float* b0; const float* rowstat; float* Z;
    __device__ __forceinline__ void operator()(const f32x4 (&acc)[2][2][4][2], const pg8::Unit& u, int wr, int wc, int fr, int fq) const {
        const int col0 = u.pn * 256 + wc * 32 + 4 * fq;
        f32x4 gv[2][2], bv[2][2];
#pragma unroll
        for (int bj = 0; bj < 2; ++bj)
#pragma unroll
            for (int n = 0; n < 2; ++n) { gv[bj][n] = *(const f32x4*)(g0 + col0 + bj * 128 + n * 16); bv[bj][n] = *(const f32x4*)(b0 + col0 + bj * 128 + n * 16); }
#pragma unroll
        for (int ai = 0; ai < 2; ++ai)
#pragma unroll
            for (int m = 0; m < 4; ++m) { const int r = ai * 128 + wr * 64 + m * 16 + fr; const int p = u.pm * 256 + r, rt = (p >> 12) * TA + NMETA + (p & 4095);
                const float* xr = x + (size_t)p * D; const float mean = rowstat[2 * rt], rstd = rowstat[2 * rt + 1];
#pragma unroll
                for (int bj = 0; bj < 2; ++bj)
#pragma unroll
                    for (int n = 0; n < 2; ++n) { const int c = col0 + bj * 128 + n * 16; const f32x4 xv = *(const f32x4*)(xr + c);
                        const f32x4 h0 = (xv - mean) * rstd * gv[bj][n] + bv[bj][n];
                        *(f32x4*)(Z + (size_t)p * D + c) = h0 * ALPHA + acc[ai][bj][m][n]; } }
    }
};
struct EpiF32 {
    static constexpr bool PERM = false; static constexpr int MIDK = 0;
    float* out; int ldc;
    __device__ __forceinline__ void operator()(const f32x4 (&acc)[2][2][4][2], const pg8::Unit& u, int wr, int wc, int fr, int fq) const {
        const int col0 = u.pn * 256 + wc * 32 + 4 * fq;
#pragma unroll
        for (int ai = 0; ai < 2; ++ai)
#pragma unroll
            for (int m = 0; m < 4; ++m) { const int row = u.pm * 256 + ai * 128 + wr * 64 + m * 16 + fr;
#pragma unroll
                for (int bj = 0; bj < 2; ++bj)
#pragma unroll
                    for (int n = 0; n < 2; ++n) *(f32x4*)(out + (size_t)row * ldc + col0 + bj * 128 + n * 16) = acc[ai][bj][m][n]; }
    }
};
struct EpiAct {
    static constexpr bool PERM = true; static constexpr int MIDK = 0;
    bf16* act;
    __device__ __forceinline__ void operator()(const f32x4 (&acc)[2][2][4][2], const pg8::Unit& u, int wr, int wc, int fr, int fq) const {
        const int row0 = u.pm * 256 + wr * 64 + fr, col0 = u.pn * 128 + wc * 32 + 8 * fq;
#pragma unroll
        for (int ai = 0; ai < 2; ++ai)
#pragma unroll
            for (int m = 0; m < 4; ++m) { float r[8];
#pragma unroll
                for (int n = 0; n < 2; ++n)
#pragma unroll
                    for (int j = 0; j < 4; ++j) { const float gte = acc[ai][0][m][n][j], up = acc[ai][1][m][n][j]; r[n * 4 + j] = gte * pg8::fast_sigmoid(gte) * up; }
                u32x4 w; w.x = pg8::cvt_pk_bf16(r[0], r[1]); w.y = pg8::cvt_pk_bf16(r[2], r[3]); w.z = pg8::cvt_pk_bf16(r[4], r[5]); w.w = pg8::cvt_pk_bf16(r[6], r[7]);
                *(u32x4*)(act + (size_t)(row0 + ai * 128 + m * 16) * DE + col0) = w; }
    }
};
struct EpiY {
    static constexpr bool PERM = true; static constexpr int MIDK = 0;
    unsigned char* Y;
    __device__ __forceinline__ void operator()(const f32x4 (&acc)[2][2][4][2], const pg8::Unit& u, int wr, int wc, int fr, int fq) const {
        const int r0 = wr * 64 + fr, col0 = u.pn * 256 + wc * 32 + 8 * fq;
#pragma unroll
        for (int ai = 0; ai < 2; ++ai)
#pragma unroll
            for (int m = 0; m < 4; ++m) { const int r = r0 + ai * 128 + m * 16; const int yr = (r < u.nv) ? (u.aux + r) : YDUMMY;
                unsigned char* rowp = Y + (size_t)yr * D + col0;
#pragma unroll
                for (int bj = 0; bj < 2; ++bj) { const f32x4 v0 = acc[ai][bj][m][0] * YSCALE, v1 = acc[ai][bj][m][1] * YSCALE;
                    unsigned w0 = 0u, w1 = 0u;
                    w0 = __builtin_amdgcn_cvt_pk_fp8_f32(v0[0], v0[1], w0, false); w0 = __builtin_amdgcn_cvt_pk_fp8_f32(v0[2], v0[3], w0, true);
                    w1 = __builtin_amdgcn_cvt_pk_fp8_f32(v1[0], v1[1], w1, false); w1 = __builtin_amdgcn_cvt_pk_fp8_f32(v1[2], v1[3], w1, true);
                    *(u32x2v*)(rowp + bj * 128) = (u32x2v){w0, w1}; } }
    }
};

__device__ __forceinline__ void transpose_item(const float* W, int K, int N, bf16* WT, int row_base, int gu, LAS float* scr, int item, int lane, int ldk = 0, int koff = 0) {
    if (ldk == 0) ldk = K;
    const int nblk = N / 32, kb = item / nblk, nb = item % nblk, k0 = 64 * kb, n0 = 32 * nb;
    const int r0 = row_base + (gu ? ((n0 >> 7) * 256 + (n0 & 127)) : n0);
    float tv[32];
#pragma unroll
    for (int i = 0; i < 32; ++i) { const int kk = 2 * i + (lane >> 5); tv[i] = W[(size_t)(k0 + kk) * N + n0 + (lane & 31)]; }
#pragma unroll
    for (int i = 0; i < 32; ++i) { const int kk = 2 * i + (lane >> 5); scr[kk * 33 + (lane & 31)] = tv[i]; }
    LDS_WAIT(); asm volatile("" ::: "memory");
    const int c = lane & 7;
#pragma unroll
    for (int j = 0; j < 4; ++j) { const int n = (lane >> 3) + 8 * j; const LAS float* s = scr + (8 * c) * 33 + n;
        v4u o; o.x = pk2(s[0 * 33], s[1 * 33]); o.y = pk2(s[2 * 33], s[3 * 33]); o.z = pk2(s[4 * 33], s[5 * 33]); o.w = pk2(s[6 * 33], s[7 * 33]);
        *(GAS v4u*)(WT + (size_t)(r0 + n) * ldk + koff + k0 + 8 * c) = o; }
    LDS_WAIT(); asm volatile("" ::: "memory");
}
__device__ __forceinline__ void ln_row_to_bf16(const float* xrow, const float* g, const float* b, bf16* orow, float* stat, int lane) {
    const GAS f32x4* xr = (const GAS f32x4*)xrow + lane;
    f32x4 v[4]; float s = 0.f;
#pragma unroll
    for (int j = 0; j < 4; ++j) { v[j] = xr[64 * j]; s += (v[j].x + v[j].y) + (v[j].z + v[j].w); }
    const float mean = wave_sum(s) * (1.f / D); float s2 = 0.f;
#pragma unroll
    for (int j = 0; j < 4; ++j) { v[j] = v[j] - mean; s2 += (v[j].x * v[j].x + v[j].y * v[j].y) + (v[j].z * v[j].z + v[j].w * v[j].w); }
    const float rstd = 1.f / sqrtf(wave_sum(s2) * (1.f / D) + LN_EPS);
    if (stat && lane == 0) { stat[0] = mean; stat[1] = rstd; }
    GAS unsigned long long* o8 = (GAS unsigned long long*)orow + lane;
#pragma unroll
    for (int j = 0; j < 4; ++j) { const f32x4 gg = *((const f32x4*)g + lane + 64 * j), bb = *((const f32x4*)b + lane + 64 * j); const f32x4 y = v[j] * rstd * gg + bb;
        o8[64 * j] = (unsigned long long)pk2(y.x, y.y) | ((unsigned long long)pk2(y.z, y.w) << 32); }
}

__device__ __forceinline__ int crow16(int r, int hi) { return (r & 3) + 8 * (r >> 2) + 4 * hi; }
typedef float f32x16 __attribute__((ext_vector_type(16)));
struct ScanArgs { const bf16* XR; const bf16* YG; bf16* REC; const float* conv_w; const float* conv_b; const bf16* lruwt; const float* b_a; const float* b_i; const float* lam; float* scansum; };
__device__ __forceinline__ float xlane32(float v) { return __shfl_xor(v, 32); }
template <bool FINAL>
__device__ __forceinline__ void scan_phase(const ScanArgs& A, LAS unsigned char* lds, int vcu, int G) {
    const int tid = threadIdx.x, lane = tid & 63, wave = __builtin_amdgcn_readfirstlane(tid >> 6);
    const int nb = vcu & 7, cun = vcu >> 3, nslots = (G >> 3) * 8;
    const int cc = lane & 15, rg = lane >> 4;
    const int l31 = lane & 31, hi = lane >> 5;
#pragma unroll
    for (int i = 0; i < 8; ++i) { const int idx = tid + 512 * i, n = idx >> 4, ch = idx & 15; const int gt = n >> 7, col = n & 127;
        const v4u w = *(const v4u*)(A.lruwt + ((size_t)((gt * 8 + nb) * 128 + col)) * 128 + ch * 8);
        *(LAS v4u*)(lds + n * 272 + ch * 16) = w; }
    __syncthreads();
    constexpr int SPW = 272;
    LAS unsigned char* TL = lds + (wave < 7 ? 256 * SPW + wave * 32 * SPW : LDSCTL_OFF + 1024);
    LAS unsigned char* const WLb = lds + l31 * SPW + hi * 16;
    LAS unsigned char* const TLa = TL + l31 * SPW + hi * 16;
    LAS unsigned char* const TLx = TL + hi * (4 * SPW) + l31 * 2;
    LAS unsigned char* const TLs = TL + rg * (8 * SPW) + cc * 16;
    LAS float* CWL = (LAS float*)(lds + LDSCTL_OFF + 1024 + 32 * SPW);
    if (tid < 160) { const int k = tid >> 5, c4 = (tid & 31) * 4; const f32x4 w = (k < 4) ? *(const f32x4*)(A.conv_w + k * D + nb * 128 + c4) : *(const f32x4*)(A.conv_b + nb * 128 + c4); *(LAS f32x4*)(CWL + k * 128 + c4) = w; }
    __syncthreads();
    float gba[4], gbi[4], gk8[4];
#pragma unroll
    for (int q = 0; q < 4; ++q) { const int C = nb * 128 + 32 * q + l31; gba[q] = A.b_a[C]; gbi[q] = A.b_i[C]; const float lm = A.lam[C];
        const float sp = (-lm > 20.f) ? -lm : log1pf(__expf(-lm)); gk8[q] = -8.0f * sp * 1.4426950408889634f; }
    for (int wv = cun * 8 + wave; wv < 256; wv += nslots) {
        const int b = wv >> 5, ri = wv & 31; const int sb0 = ri == 0 ? 0 : 4 * ri + 1, nsb = ri == 0 ? 5 : 4;
        const size_t rowb = (size_t)b * TA;
        float hc[4], Ac[4];
#pragma unroll
        for (int q = 0; q < 4; ++q) { hc[q] = 0.f; Ac[q] = 1.f; }
        if (FINAL) {
            float h0 = 0.f, h1 = 0.f;
#pragma unroll 1
            for (int j0 = 0; j0 < ri; j0 += 8) { f32x4 s[8];
#pragma unroll
                for (int i = 0; i < 8; ++i) { const int j = j0 + i; const int jc = j < ri ? j : 0; s[i] = *(const f32x4*)(A.scansum + ((size_t)(b * 32 + jc) * D + nb * 128 + 2 * lane) * 2); if (j >= ri) s[i] = (f32x4){1.f, 0.f, 1.f, 0.f}; }
#pragma unroll
                for (int i = 0; i < 8; ++i) { h0 = s[i].x * h0 + s[i].y; h1 = s[i].z * h1 + s[i].w; } }
            ((LAS float*)TL)[2 * lane] = h0; ((LAS float*)TL)[2 * lane + 1] = h1;
            asm volatile("s_waitcnt lgkmcnt(0)" ::: "memory");
#pragma unroll
            for (int q = 0; q < 4; ++q) hc[q] = ((LAS float*)TL)[32 * q + l31];
            asm volatile("s_waitcnt lgkmcnt(0)" ::: "memory");
        }
#pragma unroll 1
        for (int s = 0; s < nsb; ++s) {
            const int t0 = 32 * (sb0 + s);
            v4u xv[11];
#pragma unroll
            for (int i = 0; i < 11; ++i) { int tt = t0 + 8 * rg - 3 + i; const bool neg = tt < 0; tt = neg ? 0 : tt; xv[i] = *(const v4u*)(A.XR + (rowb + tt) * D + nb * 128 + cc * 8); if (i < 3 && neg) xv[i] = (v4u){0u, 0u, 0u, 0u}; }
            { f32x4 w0[4], w1[4];
#pragma unroll
              for (int k = 0; k < 4; ++k) { w0[k] = *(const LAS f32x4*)(CWL + k * 128 + cc * 8); w1[k] = *(const LAS f32x4*)(CWL + k * 128 + cc * 8 + 4); }
              const f32x4 cb0 = *(const LAS f32x4*)(CWL + 4 * 128 + cc * 8), cb1 = *(const LAS f32x4*)(CWL + 4 * 128 + cc * 8 + 4);
#pragma unroll
              for (int i = 0; i < 8; ++i) { float o[8]; o[0] = cb0.x; o[1] = cb0.y; o[2] = cb0.z; o[3] = cb0.w; o[4] = cb1.x; o[5] = cb1.y; o[6] = cb1.z; o[7] = cb1.w;
#pragma unroll
                for (int k = 0; k < 4; ++k) { const v4u x4 = xv[i + k]; const f32x4 a0 = w0[k], a1 = w1[k];
                    o[0] += a0.x * bfl(x4.x); o[1] += a0.y * bfh(x4.x); o[2] += a0.z * bfl(x4.y); o[3] += a0.w * bfh(x4.y);
                    o[4] += a1.x * bfl(x4.z); o[5] += a1.y * bfh(x4.z); o[6] += a1.z * bfl(x4.w); o[7] += a1.w * bfh(x4.w); }
                v4u w; w.x = pk2(o[0], o[1]); w.y = pk2(o[2], o[3]); w.z = pk2(o[4], o[5]); w.w = pk2(o[6], o[7]);
                *(LAS v4u*)(TLs + i * SPW) = w; } }
            asm volatile("s_waitcnt lgkmcnt(0)" ::: "memory");
            bf16x8 af[8];
#pragma unroll
            for (int k8 = 0; k8 < 8; ++k8) af[k8] = *(const LAS bf16x8*)(TLa + k8 * 32);
#pragma unroll
            for (int hh = 0; hh < 2; ++hh) {
                f32x16 acc[2][2];
#pragma unroll
                for (int gt = 0; gt < 2; ++gt)
#pragma unroll
                    for (int cb = 0; cb < 2; ++cb) acc[gt][cb] = f32x16{};
#pragma unroll
                for (int k8 = 0; k8 < 8; ++k8) {
#pragma unroll
                    for (int gt = 0; gt < 2; ++gt)
#pragma unroll
                        for (int cb = 0; cb < 2; ++cb) {
                            const bf16x8 bfv = *(const LAS bf16x8*)(WLb + (gt * 128 + 64 * hh + 32 * cb) * SPW + k8 * 32);
                            acc[gt][cb] = __builtin_amdgcn_mfma_f32_32x32x16_bf16(af[k8], bfv, acc[gt][cb], 0, 0, 0); }
                }
#pragma unroll
                for (int cb = 0; cb < 2; ++cb) { const int q = 2 * hh + cb, c = 32 * q + l31;
                    float av[16], bt[16];
#pragma unroll
                    for (int rr = 0; rr < 16; ++rr) { const int row = crow16(rr, hi);
                        const float rgt = pg8::fast_sigmoid(acc[0][cb][rr] + gba[q]), igt = pg8::fast_sigmoid(acc[1][cb][rr] + gbi[q]);
                        const float a = __builtin_amdgcn_exp2f(gk8[q] * rgt); float mult = __builtin_amdgcn_sqrtf(fmaxf(1.0f - a * a, 0.f));
                        if (rr == 0 && t0 == 0 && hi == 0) mult = 1.0f;
                        const float xc = bf1(*(const LAS bf16*)(TLx + crow16(rr, 0) * SPW + q * 64));
                        av[rr] = a; bt[rr] = mult * igt * xc; }
                    float Ao[4], Bo[4], Ap[4], Bp[4];
#pragma unroll
                    for (int j = 0; j < 4; ++j) { float Ag = av[4 * j], Bg = bt[4 * j];
#pragma unroll
                        for (int k = 1; k < 4; ++k) { Bg = av[4 * j + k] * Bg + bt[4 * j + k]; Ag *= av[4 * j + k]; }
                        Ao[j] = Ag; Bo[j] = Bg; Ap[j] = xlane32(Ag); Bp[j] = xlane32(Bg); }
                    float h = hc[q]; float hin[4];
#pragma unroll
                    for (int j = 0; j < 4; ++j) {
                        const float Ae = hi ? Ap[j] : Ao[j], Be = hi ? Bp[j] : Bo[j], Aod = hi ? Ao[j] : Ap[j], Bod = hi ? Bo[j] : Bp[j];
                        const float h_even_in = h; const float h_odd_in = Ae * h + Be; h = Aod * h_odd_in + Bod;
                        hin[j] = hi ? h_odd_in : h_even_in; Ac[q] *= Ae * Aod; }
                    hc[q] = h;
                    if (FINAL) {
#pragma unroll
                        for (int j = 0; j < 4; ++j) { float hh2 = hin[j];
#pragma unroll
                            for (int k = 0; k < 4; ++k) { const int rr = 4 * j + k, row = crow16(rr, hi); hh2 = av[rr] * hh2 + bt[rr];
                                *(LAS bf16*)(TLx + crow16(rr, 0) * SPW + q * 64) = (bf16)f2bf(hh2); } } }
                }
            }
            if (FINAL) {
                v4u yv[8];
#pragma unroll
                for (int i = 0; i < 8; ++i) yv[i] = *(const v4u*)(A.YG + (rowb + t0 + 8 * rg + i) * D + nb * 128 + cc * 8);
                asm volatile("s_waitcnt lgkmcnt(0)" ::: "memory");
#pragma unroll
                for (int i = 0; i < 8; ++i) { const int row = 8 * rg + i; const v4u hv = *(const LAS v4u*)(TLs + i * SPW); const v4u y = yv[i];
                    v4u o; o.x = pk2(bfl(hv.x) * bfl(y.x), bfh(hv.x) * bfh(y.x)); o.y = pk2(bfl(hv.y) * bfl(y.y), bfh(hv.y) * bfh(y.y)); o.z = pk2(bfl(hv.z) * bfl(y.z), bfh(hv.z) * bfh(y.z)); o.w = pk2(bfl(hv.w) * bfl(y.w), bfh(hv.w) * bfh(y.w));
                    *(v4u*)(A.REC + (rowb + t0 + row) * (2 * D) + nb * 128 + cc * 8) = o; }
                asm volatile("s_waitcnt lgkmcnt(0)" ::: "memory");
            }
        }
        if (!FINAL && hi == 0) {
#pragma unroll
            for (int q = 0; q < 4; ++q) { float* sm = A.scansum + ((size_t)(b * 32 + ri) * D + nb * 128 + 32 * q + l31) * 2; sm[0] = Ac[q]; sm[1] = hc[q]; } }
    }
    __syncthreads();
}

__device__ __forceinline__ void route_token(const float* logits, const float* rbias, int row, unsigned* cnt, int* list, float* tokw, int lane) {
    const f32x4 lg = *((const f32x4*)(logits + (size_t)row * NE) + lane); const f32x4 rb = *((const f32x4*)rbias + lane);
    float sc[4], sel[4];
#pragma unroll
    for (int j = 0; j < 4; ++j) { sc[j] = 1.0f / (1.0f + expf(-lg[j])); sel[j] = sc[j] + rb[j]; }
    float m1 = fmaxf(sel[0], sel[1]), m2 = fminf(sel[0], sel[1]);
#pragma unroll
    for (int j = 2; j < 4; ++j) { const float v = sel[j]; m2 = fmaxf(m2, fminf(m1, v)); m1 = fmaxf(m1, v); }
#pragma unroll
    for (int o = 1; o < 8; o <<= 1) { const float o1 = __shfl_xor(m1, o), o2 = __shfl_xor(m2, o); m2 = fmaxf(fminf(m1, o1), fmaxf(m2, o2)); m1 = fmaxf(m1, o1); }
    const float gs = m1 + m2; const int g = lane >> 3; int rank = 0;
#pragma unroll
    for (int gg = 0; gg < 8; ++gg) { const float og = __shfl(gs, gg * 8); rank += (og > gs || (og == gs && gg < g)) ? 1 : 0; }
    const bool gsel = rank < 4;
#pragma unroll
    for (int j = 0; j < 4; ++j) if (!gsel) sel[j] = -INFINITY;
    float wk = 0.f; int ek = 0; float ssum = 0.f;
#pragma unroll 1
    for (int k = 0; k < TOPK; ++k) {
        float bv = sel[0]; int bi = 4 * lane;
#pragma unroll
        for (int j = 1; j < 4; ++j) if (sel[j] > bv) { bv = sel[j]; bi = 4 * lane + j; }
#pragma unroll
        for (int o = 1; o < 64; o <<= 1) { const float ov = __shfl_xor(bv, o); const int oi = __shfl_xor(bi, o); if (ov > bv || (ov == bv && oi < bi)) { bv = ov; bi = oi; } }
        const int own = bi >> 2, jj = bi & 3;
        float s = 0.f;
        if (lane == own) {
#pragma unroll
            for (int j = 0; j < 4; ++j) if (j == jj) { s = sc[j]; sel[j] = -INFINITY; } }
        s = __shfl(s, own);
        ssum += s; if (lane == k) { wk = s; ek = bi; }
    }
    if (lane < TOPK) { const float w = wk / ssum * ROUTED_SCALE; const unsigned pos = atomicAdd(cnt + ek, 1u); if (pos < (unsigned)CAP) list[(size_t)ek * CAP + pos] = (row << 4) | lane; tokw[(size_t)row * 16 + lane] = w; }
}

struct Args { const float* in[33]; float* out; unsigned char* ws; int ph_lo, ph_hi, li, pad; };
__global__ void __launch_bounds__(NWAVES * 64, 2) mega_fwd(Args args) {
    extern __shared__ __attribute__((aligned(16))) unsigned char lds[];
    LAS unsigned char* L = (LAS unsigned char*)lds;
    volatile LAS unsigned* MISC = (volatile LAS unsigned*)(L + MISC_OFF);
    const int tid = threadIdx.x, lane = tid & 63, wave = __builtin_amdgcn_readfirstlane(tid >> 6);
    const int G = gridDim.x; const int bx = blockIdx.x; const int vcu = (G % 8 == 0) ? (bx % 8) * (G / 8) + bx / 8 : bx;
    unsigned char* ws = args.ws;
    gu32* ctl = (gu32*)(ws + WS_CTL);
    for (int u = tid; u < (LDS_BYTES - LDSCTL_OFF) / 4; u += NWAVES * 64) ((LAS unsigned*)(L + LDSCTL_OFF))[u] = 0u;
    __syncthreads();
    XcdBarrier bar; bar.bar = (unsigned*)(ctl + CW_BAR); bar.x = 0; bar.st = nullptr;
    if (N_LAUNCHES == 1) bar = xcd_barrier_post((unsigned*)(ctl + CW_BAR), MISC + 8);
#define GRID_BAR() do { if (N_LAUNCHES == 1) xcd_barrier(bar); } while (0)
#if MK_DIAG
    int n_stamp = 0;
#define STAMP() do { if (blockIdx.x == 0 && tid == 0) { ((unsigned long long*)(ctl + CW_DIAG))[n_stamp] = __builtin_amdgcn_s_memrealtime(); } ++n_stamp; } while (0)
#else
#define STAMP() do {} while (0)
#endif
    STAMP();
    const int lo = args.ph_lo, hi = args.ph_hi;
#ifndef MK_REPEAT_MASK
#define MK_REPEAT_MASK 0
#endif
#ifndef MK_PHASE_MASK
#define MK_PHASE_MASK 0xffff
#endif
#define IN(k) ((((MK_PHASE_MASK) >> (k)) & 1) && lo <= (k) && (k) < hi)
#define BOTH(k) (IN(k) && IN((k) + 1))
    const int gw = vcu * NWAVES + wave, NGW = G * NWAVES;
    const float* x = args.in[0]; const float* meta = args.in[1];

    if (IN(0)) {
        LAS float* scr = (LAS float*)(L + RING_OFF + wave * 16384);
        constexpr int I_IN = 16 * (NIN / 32), I_SQ = 16 * 32, I_RT = 16 * 8, I_LRU = 2 * 8 * 2 * 4;
        constexpr int NITEMS = I_IN + 3 * I_SQ + I_RT + I_LRU;
        for (int it = gw; it < NITEMS; it += NGW) {
            int r = it;
            if (r < I_IN) { transpose_item(args.in[4], D, NIN, (bf16*)(ws + WS_WIN), 0, 0, scr, r, lane); continue; } r -= I_IN;
            if (r < I_SQ) { transpose_item(args.in[18], D, D, (bf16*)(ws + WS_WR), 0, 0, scr, r, lane, 2 * D, 0); continue; } r -= I_SQ;
            if (r < I_SQ) { transpose_item(args.in[19], D, D, (bf16*)(ws + WS_WR), 0, 0, scr, r, lane, 2 * D, D); continue; } r -= I_SQ;
            if (r < I_SQ) { transpose_item(args.in[20], D, D, (bf16*)(ws + WS_WO), 0, 0, scr, r, lane); continue; } r -= I_SQ;
            if (r < I_RT) { transpose_item(args.in[23], D, NE, (bf16*)(ws + WS_WROUT), 0, 0, scr, r, lane); continue; } r -= I_RT;
            { const int m = r >> 3, it2 = r & 7, gt = m >> 3, blk = m & 7;
              transpose_item(args.in[gt ? 10 : 8] + (size_t)blk * 128 * 128, 128, 128, (bf16*)(ws + WS_LRUWT) + (size_t)(gt * 8 + blk) * 128 * 128, 0, 0, scr, it2, lane); }
        }
        for (int m = gw; m < MA; m += NGW) { const int b = m / TA, t = m - b * TA; bf16* orow = (bf16*)(ws + WS_XN) + (size_t)m * D;
            if (t < TV) { const float* xr = (t < NMETA) ? meta + (size_t)t * D : x + ((size_t)b * SEQ + (t - NMETA)) * D;
                ln_row_to_bf16(xr, args.in[2], args.in[3], orow, (float*)(ws + WS_ROWSTAT) + 2 * (size_t)m, lane); }
            else { GAS unsigned long long* o8 = (GAS unsigned long long*)orow + lane;
#pragma unroll
                for (int j = 0; j < 4; ++j) o8[64 * j] = 0ull; } }
        if (BOTH(0)) GRID_BAR();
        STAMP();
    }
    if (IN(1)) {
        pg8::Gemm g{(const bf16*)(ws + WS_XN), (const bf16*)(ws + WS_WIN), D, 0}; DenseOrder S; S.init(MA, NIN, G, bx);
        EpiIn E{(bf16*)(ws + WS_XR), args.in[5], 0.125f * 1.4426950408889634f};
        pg8::gemm_phase<EpiIn, DenseOrder, true, false>(L + RING_OFF, g, S, E);
        if (BOTH(1)) GRID_BAR();
        STAMP();
    }
    ScanArgs SA{(const bf16*)(ws + WS_XR), (const bf16*)(ws + WS_YG), (bf16*)(ws + WS_RA), args.in[6], args.in[7], (const bf16*)(ws + WS_LRUWT), args.in[9], args.in[11], args.in[12], (float*)(ws + WS_SCANSUM)};
    if (IN(2)) {
        scan_phase<false>(SA, L + RING_OFF, vcu, G);
        if (BOTH(2)) GRID_BAR();
        STAMP();
    }
    if (IN(3)) {
        scan_phase<true>(SA, L + RING_OFF, vcu, G);
        { const int bh = vcu >> 2, sub = vcu & 3, m = sub >> 1, part = sub & 1, b = bh >> 3, h = bh & 7;
          if (bh < NB * 8) {
              const attn2::AttnTensors AT{(const attn2::bf16*)(ws + WS_Q), (const attn2::bf16*)(ws + WS_K), (const attn2::bf16*)(ws + WS_V), (attn2::bf16*)(ws + (m ? WS_O1 : WS_O0))};
              const attn2::SplitOrder AS{b, 2 * h + m, h, part};
              attn2::attn_phase<attn2::SplitOrder>((char*)lds + RING_OFF, AT, AS);
          } }
        if (BOTH(3)) GRID_BAR();
        STAMP();
    }
    if (IN(4)) {
        const float lamq = wave_sum(args.in[13][lane] * args.in[14][lane]), lamq2 = wave_sum(args.in[15][lane] * args.in[16][lane]);
        const float lam = expf(lamq) - expf(lamq2) + LAMBDA_INIT;
        const bf16* O0 = (const bf16*)(ws + WS_O0); const bf16* O1 = (const bf16*)(ws + WS_O1); bf16* ATT = (bf16*)(ws + WS_RA) + D;
        for (int m = gw; m < MA; m += NGW) {
#pragma unroll
            for (int j = 0; j < 2; ++j) { const int c = j * 512 + lane * 8; const v4u a = *(const v4u*)(O0 + (size_t)m * D + c), bq = *(const v4u*)(O1 + (size_t)m * D + c);
                float d[8]; d[0] = bfl(a.x) - lam * bfl(bq.x); d[1] = bfh(a.x) - lam * bfh(bq.x); d[2] = bfl(a.y) - lam * bfl(bq.y); d[3] = bfh(a.y) - lam * bfh(bq.y);
                d[4] = bfl(a.z) - lam * bfl(bq.z); d[5] = bfh(a.z) - lam * bfh(bq.z); d[6] = bfl(a.w) - lam * bfl(bq.w); d[7] = bfh(a.w) - lam * bfh(bq.w);
                float ss = 0.f;
#pragma unroll
                for (int q = 0; q < 8; ++q) ss += d[q] * d[q];
                ss += __shfl_xor(ss, 1); ss += __shfl_xor(ss, 2); ss += __shfl_xor(ss, 4); ss += __shfl_xor(ss, 8);
                const float rs = (1.0f - LAMBDA_INIT) / sqrtf(ss * (1.0f / 128.f) + LN_EPS);
                const int e0 = c & 127; const f32x4 g0 = *(const f32x4*)(args.in[17] + e0), g1 = *(const f32x4*)(args.in[17] + e0 + 4);
                v4u w; w.x = pk2(d[0] * rs * g0.x, d[1] * rs * g0.y); w.y = pk2(d[2] * rs * g0.z, d[3] * rs * g0.w); w.z = pk2(d[4] * rs * g1.x, d[5] * rs * g1.y); w.w = pk2(d[6] * rs * g1.z, d[7] * rs * g1.w);
                *(v4u*)(ATT + (size_t)m * (2 * D) + c) = w; } }
        if (BOTH(4)) GRID_BAR();
        STAMP();
    }
    if (IN(5)) {
        pg8::Gemm g{(const bf16*)(ws + WS_RA), (const bf16*)(ws + WS_WR), 2 * D, 0}; DenseOrder S; S.init(NVALID, D, G, bx, 1);
        EpiGate2 E{(const bf16*)(ws + WS_GR), (const bf16*)(ws + WS_GA), (bf16*)(ws + WS_U)};
        pg8::gemm_phase<EpiGate2, DenseOrder, true, false>(L + RING_OFF, g, S, E);
        if (BOTH(5)) GRID_BAR();
        STAMP();
    }
    if (IN(7)) {
        pg8::Gemm g{(const bf16*)(ws + WS_U), (const bf16*)(ws + WS_WO), D, 0}; DenseOrder S; S.init(NVALID, D, G, bx, 0);
        EpiZ E{x, args.in[2], args.in[3], (const float*)(ws + WS_ROWSTAT), (float*)(ws + WS_Z)};
        pg8::gemm_phase<EpiZ, DenseOrder, true, false>(L + RING_OFF, g, S, E);
        if (BOTH(7)) GRID_BAR();
        STAMP();
    }
    if (IN(8)) {
        for (int m = gw; m < NVALID; m += NGW) ln_row_to_bf16((const float*)(ws + WS_Z) + (size_t)m * D, args.in[21], args.in[22], (bf16*)(ws + WS_H1B) + (size_t)m * D, nullptr, lane);
        if (BOTH(8)) GRID_BAR();
        STAMP();
    }
    if (IN(9)) {
        { pg8::Gemm g{(const bf16*)(ws + WS_H1B), (const bf16*)(ws + WS_WROUT), D, 0}; DenseOrder S; S.init(NVALID, NE, G, bx, 0);
          EpiF32 E{(float*)(ws + WS_LOGITS), NE};
          pg8::gemm_phase<EpiF32, DenseOrder, false, false>(L + RING_OFF, g, S, E);
          VM_WAIT(); __syncthreads();
          pg8::Unit u;
          for (int i = 0; S.next(i, u); ++i)
              for (int r = wave; r < 256; r += NWAVES)
                  route_token((const float*)(ws + WS_LOGITS), args.in[24], u.pm * 256 + r, (unsigned*)(ctl + CW_CNT), (int*)(ws + WS_LIST), (float*)(ws + WS_TOKW), lane); }
        LAS float* scr = (LAS float*)(L + RING_OFF + wave * 16384);
        constexpr int IPE = 128, NIT = 257 * 3 * IPE, CHUNK = 4;
        for (;;) {
            int base = 0; if (lane == 0) base = (int)atomicAdd((unsigned*)(ctl + CW_QUEUE), (unsigned)CHUNK); base = __builtin_amdgcn_readfirstlane(base);
            if (base >= NIT) break;
            for (int it = base; it < base + CHUNK && it < NIT; ++it) { const int e = it / (3 * IPE), r = it - e * 3 * IPE, which = r / IPE, i2 = r - which * IPE;
                if (which < 2) { const float* W = (e < NE) ? args.in[25 + which] + (size_t)e * D * DE : args.in[28 + which];
                    transpose_item(W, D, DE, (bf16*)(ws + WS_WGU), e * 512 + which * 128, 1, scr, i2, lane); }
                else { const float* W = (e < NE) ? args.in[27] + (size_t)e * DE * D : args.in[30];
                    transpose_item(W, DE, D, (bf16*)(ws + WS_WD) + (size_t)e * D * DE, 0, 0, scr, i2, lane); } } }
        if (BOTH(9)) GRID_BAR();
        STAMP();
    }
    if (IN(11) || IN(12)) {
        volatile LAS unsigned* TT = (volatile LAS unsigned*)(L + TT_OFF); volatile LAS int* UB = (volatile LAS int*)(L + UB_OFF);
        const unsigned* cnt = (const unsigned*)(ctl + CW_CNT);
        volatile LAS int* CN = (volatile LAS int*)(L + CN_OFF); volatile LAS int* TB = (volatile LAS int*)(L + TB_OFF);
        if (tid <= NE) { int c = (tid == NE) ? NVALID : (int)__hip_atomic_load(cnt + tid, RLX_AGENT); if (c > CAP) c = CAP; CN[tid] = c; }
        __syncthreads();
        if (tid == 0) { int tb = 0, ub = 0;
            for (int e = 0; e <= NE; ++e) { const int c = CN[e]; int ntl = (c + 255) >> 8; if (tb + ntl > MAXTILES) ntl = MAXTILES - tb; UB[e] = ub; TB[e] = tb; ub += c; tb += ntl; }
            TB[NE + 1] = tb; MISC[16] = (unsigned)tb; }
        __syncthreads();
        if (tid <= NE) { const int t0 = TB[tid], t1 = TB[tid + 1]; for (int t = t0; t < t1; ++t) TT[t] = (unsigned)tid | ((unsigned)(t - t0) << 16); }
        __syncthreads();
        const int ntiles = (int)MISC[16];
        if (IN(11)) {
            pg8::Gemm g{(const bf16*)(ws + WS_H1B), (const bf16*)(ws + WS_WGU), D, (size_t)512 * D};
            MoeOrder<2> S{ntiles, G, vcu, TT, UB, CN, (const int*)(ws + WS_LIST), (int*)(ws + WS_TOKSLOT), 1};
            EpiAct E{(bf16*)(ws + WS_ACT)};
            pg8::gemm_phase<EpiAct, MoeOrder<2>, true, true>(L + RING_OFF, g, S, E);
            if (BOTH(11)) GRID_BAR();
            STAMP();
        STAMP();
        }
        if (IN(12)) {
            pg8::Gemm g{(const bf16*)(ws + WS_ACT), (const bf16*)(ws + WS_WD), DE, (size_t)D * DE};
            MoeOrder<4> S{ntiles, G, vcu, TT, UB, CN, (const int*)(ws + WS_LIST), (int*)(ws + WS_TOKSLOT), 0};
            EpiY E{(unsigned char*)(ws + WS_Y)};
            pg8::gemm_phase<EpiY, MoeOrder<4>, true, false>(L + RING_OFF, g, S, E);
            if (BOTH(12)) GRID_BAR();
            STAMP();
        STAMP();
        }
    }
    if (IN(13)) {
        const bf16* H1 = (const bf16*)(ws + WS_H1B); const unsigned char* Y = (const unsigned char*)(ws + WS_Y); const int* tokslot = (const int*)(ws + WS_TOKSLOT); const float* tokw = (const float*)(ws + WS_TOKW);
        unsigned poison = __hip_atomic_load(ctl + CW_BAR + XB_TMO, RLX_AGENT) != 0u;
        typedef float f32x2q __attribute__((ext_vector_type(2)));
        for (int p = gw; p < NVALID; p += NGW) { const int row = p; const int c = lane * 16;
            float z[16];
            { const v4u a = *(const v4u*)(H1 + (size_t)row * D + c), a2 = *(const v4u*)(H1 + (size_t)row * D + c + 8);
              z[0] = ALPHA * bfl(a.x); z[1] = ALPHA * bfh(a.x); z[2] = ALPHA * bfl(a.y); z[3] = ALPHA * bfh(a.y); z[4] = ALPHA * bfl(a.z); z[5] = ALPHA * bfh(a.z); z[6] = ALPHA * bfl(a.w); z[7] = ALPHA * bfh(a.w);
              z[8] = ALPHA * bfl(a2.x); z[9] = ALPHA * bfh(a2.x); z[10] = ALPHA * bfl(a2.y); z[11] = ALPHA * bfh(a2.y); z[12] = ALPHA * bfl(a2.z); z[13] = ALPHA * bfh(a2.z); z[14] = ALPHA * bfl(a2.w); z[15] = ALPHA * bfh(a2.w); }
            v4u yv[TOPK + 1]; float wv[TOPK + 1];
#pragma unroll
            for (int k = 0; k <= TOPK; ++k) { const int yr = (k < TOPK) ? tokslot[(size_t)row * 16 + k] : YSHARED + p; wv[k] = ((k < TOPK) ? tokw[(size_t)row * 16 + k] : 1.0f) * (1.0f / YSCALE);
                yv[k] = *(const v4u*)(Y + (size_t)yr * D + c); }
#pragma unroll
            for (int k = 0; k <= TOPK; ++k) { const float w = wv[k]; const unsigned q[4] = {yv[k].x, yv[k].y, yv[k].z, yv[k].w};
#pragma unroll
                for (int i = 0; i < 4; ++i) { const f32x2q lo = __builtin_amdgcn_cvt_pk_f32_fp8(q[i], false), hi2 = __builtin_amdgcn_cvt_pk_f32_fp8(q[i], true);
                    z[4 * i] += w * lo.x; z[4 * i + 1] += w * lo.y; z[4 * i + 2] += w * hi2.x; z[4 * i + 3] += w * hi2.y; } }
            float s = 0.f;
#pragma unroll
            for (int q = 0; q < 16; ++q) s += z[q];
            const float mean = wave_sum(s) * (1.f / D); float s2 = 0.f;
#pragma unroll
            for (int q = 0; q < 16; ++q) { z[q] -= mean; s2 += z[q] * z[q]; }
            const float rstd = 1.f / sqrtf(wave_sum(s2) * (1.f / D) + LN_EPS);
            float* orow = args.out + (size_t)p * D + c;
#pragma unroll
            for (int q4 = 0; q4 < 4; ++q4) { const f32x4 gg = *(const f32x4*)(args.in[31] + c + 4 * q4), bb = *(const f32x4*)(args.in[32] + c + 4 * q4);
                f32x4 o; o.x = z[4 * q4] * rstd * gg.x + bb.x; o.y = z[4 * q4 + 1] * rstd * gg.y + bb.y; o.z = z[4 * q4 + 2] * rstd * gg.z + bb.z; o.w = z[4 * q4 + 3] * rstd * gg.w + bb.w;
                if (poison) o = (f32x4){__builtin_nanf(""), __builtin_nanf(""), __builtin_nanf(""), __builtin_nanf("")};
                *(f32x4*)(orow + 4 * q4) = o; } }
    }
#if MK_DIAG
    GRID_BAR(); STAMP();
    if (blockIdx.x == 0 && tid == 0) { const unsigned long long* ts = (const unsigned long long*)(ctl + CW_DIAG);
      const unsigned long long a0 = __hip_atomic_load(ts + MK_DIAG_S1, RLX_AGENT), a1 = __hip_atomic_load(ts + MK_DIAG_S1 + 1, RLX_AGENT);
      args.out[0] = 40.0f + (float)(a1 - a0) * 0.01f; }
#endif
#undef IN
#undef BOTH
#undef GRID_BAR
}

extern "C" void kernel_launch(void* const* d_in, const int* in_sizes, int n_in, void* d_out, int out_size, void* d_ws, size_t ws_size, hipStream_t stream) {
    static int grid = 0;
    if (grid == 0) {
        if (n_in != 33 || in_sizes[0] != NB * SEQ * D || out_size != NB * SEQ * D || ws_size < WS_END) { fprintf(stderr, "kernel_launch: unexpected shapes / workspace (n_in %d, in0 %d, out %d, ws %zu < %zu); nothing launched\n", n_in, n_in > 0 ? in_sizes[0] : -1, out_size, ws_size, (size_t)WS_END); grid = -1; return; }
        int dev = 0, cus = 0;
        if (hipGetDevice(&dev) != hipSuccess || hipDeviceGetAttribute(&cus, hipDeviceAttributeMultiprocessorCount, dev) != hipSuccess) { grid = -1; return; }
        if (hipFuncSetAttribute((const void*)mega_fwd, hipFuncAttributeMaxDynamicSharedMemorySize, LDS_BYTES) != hipSuccess) { fprintf(stderr, "kernel_launch: hipFuncSetAttribute failed\n"); grid = -1; return; }
        int per_cu = 0;
        if (hipOccupancyMaxActiveBlocksPerMultiprocessor(&per_cu, (const void*)mega_fwd, NWAVES * 64, LDS_BYTES) != hipSuccess || per_cu < 1) fprintf(stderr, "kernel_launch: occupancy query says %d\n", per_cu);
        (void)hipGetLastError();
        grid = cus;
    }
    if (grid < 0) return;
    if (hipMemsetAsync((char*)d_ws + WS_CTL, 0, CTL_ZERO_BYTES, stream) != hipSuccess) return;
    Args a{};
    for (int i = 0; i < 33; ++i) a.in[i] = (const float*)d_in[i];
    a.out = (float*)d_out; a.ws = (unsigned char*)d_ws;
    if (N_LAUNCHES == 1) { a.ph_lo = 0; a.ph_hi = NPHASE; a.li = 0; hipLaunchKernelGGL(mega_fwd, dim3(grid), dim3(NWAVES * 64), LDS_BYTES, stream, a); }
    else for (int li = 0; li < NPHASE; ++li) { a.ph_lo = li; a.ph_hi = li + 1; a.li = li; for (int rep = 0; rep < (((MK_REPEAT_MASK) >> li) & 1) + 1; ++rep) hipLaunchKernelGGL(mega_fwd, dim3(grid), dim3(NWAVES * 64), LDS_BYTES, stream, a); }
}
```
